# Optimizing an MI355X kernel written in HIP

```python
import jax, jax.numpy as jnp
from jax import lax
import numpy as np

D_MODEL = 1024
BATCH = 4
SEQ = 4096
DEPTH = 1

N_HEADS_ATTN = 8
HEAD_DIM = 64
ROPE_DIM = HEAD_DIM // 4
ROPE_THETA = 500000.0
N_HEADS_IDX = 8
IDX_DIM = 64
TOPK_MAX = 256
Q_BLOCK = 128
N_POOL_GROUPS = 4
POOL_GROUP_DIM = 64
POOL_WINDOWS = (2, 4, 8, 16)
N_MEM = 256
N_HEADS_MEM = 4
N_BRANCHES = 3
N_EXPERTS = 32
TOP_K = 4
D_EXPERT = D_MODEL
SWIGLU_ALPHA = 1.702
SWIGLU_LIMIT = 7.0
MOE_BLOCK = 128
EPS = 1e-6

ATTN_W = N_HEADS_ATTN * HEAD_DIM
POOL_W = N_POOL_GROUPS * POOL_GROUP_DIM
MEM_W = N_HEADS_MEM * HEAD_DIM
IDXQ_W = N_HEADS_IDX * IDX_DIM
IN_SPLITS = (ATTN_W, ATTN_W, ATTN_W, IDXQ_W, IDX_DIM, N_HEADS_IDX, POOL_W, MEM_W)
IN_W = sum(IN_SPLITS)

kernel_name = "hybrid_dsa_pool_memory_moe_block"


def rmsnorm(x, g):
    xf = x.astype(jnp.float32)
    y = xf * lax.rsqrt(jnp.mean(xf * xf, axis=-1, keepdims=True) + EPS)
    return (y * g.astype(jnp.float32)).astype(x.dtype)


def partial_rope(x, pos):
    half = ROPE_DIM // 2
    inv = jnp.power(jnp.float32(ROPE_THETA), -jnp.arange(half, dtype=jnp.float32) / half)
    ang = pos.astype(jnp.float32)[:, None] * inv[None, :]
    cos = jnp.cos(ang)[None, :, None, :]
    sin = jnp.sin(ang)[None, :, None, :]
    xr = x[..., :ROPE_DIM].astype(jnp.float32)
    x1, x2 = xr[..., :half], xr[..., half:]
    rot = jnp.concatenate([x1 * cos - x2 * sin, x2 * cos + x1 * sin], axis=-1).astype(x.dtype)
    return jnp.concatenate([rot, x[..., ROPE_DIM:]], axis=-1)


def dsa_attention(q, k, v, iq, ik, iw):
    B, S = q.shape[0], q.shape[1]
    n_top = min(TOPK_MAX, S // 4)
    nb = S // Q_BLOCK
    key_pos = jnp.arange(S, dtype=jnp.int32)
    gather = jax.vmap(lambda a, i: a[i])
    ikf = ik.astype(jnp.float32)

    def to_blocks(a):
        return jnp.moveaxis(a.reshape((B, nb, Q_BLOCK) + a.shape[2:]), 1, 0)

    def block(args):
        qb, iqb, iwb, start = args
        q_pos = start + jnp.arange(Q_BLOCK, dtype=jnp.int32)
        causal = key_pos[None, :] <= q_pos[:, None]
        sc = jnp.einsum('bqhd,bsd->bqhs', iqb.astype(jnp.float32), ikf) * (IDX_DIM ** -0.5)
        sc = jnp.einsum('bqhs,bqh->bqs', jax.nn.relu(sc), iwb.astype(jnp.float32))
        sc = jnp.where(causal[None], sc, -jnp.inf)
        _, sel = lax.top_k(sc, n_top)
        k_sel = gather(k, sel)
        v_sel = gather(v, sel)
        logits = jnp.einsum('bqhd,bqkhd->bhqk', qb, k_sel).astype(jnp.float32) * (HEAD_DIM ** -0.5)
        valid = sel <= q_pos[None, :, None]
        logits = jnp.where(valid[:, None], logits, -jnp.inf)
        p = jax.nn.softmax(logits, axis=-1).astype(v.dtype)
        return jnp.einsum('bhqk,bqkhd->bqhd', p, v_sel)

    starts = jnp.arange(nb, dtype=jnp.int32) * Q_BLOCK
    out = lax.map(block, (to_blocks(q), to_blocks(iq), to_blocks(iw), starts))
    return jnp.moveaxis(out, 0, 1).reshape(B, S, -1)


def multiscale_pool(u, w_group, scale):
    B, S = u.shape[0], u.shape[1]
    ug = u.reshape(B, S, N_POOL_GROUPS, POOL_GROUP_DIM)
    cs = jnp.cumsum(ug.astype(jnp.float32), axis=1)
    cs = jnp.concatenate([jnp.zeros_like(cs[:, :1]), cs], axis=1)
    t = jnp.arange(S, dtype=jnp.int32)[:, None]
    win = jnp.array(POOL_WINDOWS, dtype=jnp.int32)[None, :]
    lo = jnp.maximum(t + 1 - win, 0)
    g_idx = jnp.arange(N_POOL_GROUPS, dtype=jnp.int32)[None, :]
    win_sum = cs[:, 1:] - cs[:, lo, g_idx]
    cnt = (t + 1 - lo).astype(jnp.float32)[None, :, :, None]
    pooled = (win_sum / cnt - ug.astype(jnp.float32)).astype(u.dtype)
    mixed = jnp.einsum('bsgc,gcd->bsgd', pooled, w_group)
    return mixed.reshape(B, S, POOL_W) * scale


def memory_attention(qm, mem_n, w_mem_kv):
    B, S = qm.shape[0], qm.shape[1]
    M = mem_n.shape[1]
    kv = mem_n @ w_mem_kv
    km = kv[..., :MEM_W].reshape(B, M, N_HEADS_MEM, HEAD_DIM)
    vm = kv[..., MEM_W:].reshape(B, M, N_HEADS_MEM, HEAD_DIM)
    q = qm.reshape(B, S, N_HEADS_MEM, HEAD_DIM)
    logits = jnp.einsum('bshd,bmhd->bhsm', q, km).astype(jnp.float32) * (HEAD_DIM ** -0.5)
    p = jax.nn.softmax(logits, axis=-1).astype(vm.dtype)
    return jnp.einsum('bhsm,bmhd->bshd', p, vm).reshape(B, S, MEM_W)


def moe(xn, w_router, b_router, w_up, b_up, w_down, b_down):
    B, S, D = xn.shape
    N = B * S
    A = N * TOP_K
    xt = xn.reshape(N, D)
    logits = (xt @ w_router + b_router).astype(jnp.float32)
    top_val, top_idx = lax.top_k(logits, TOP_K)
    gate = jax.nn.softmax(top_val, axis=-1)
    e_flat = top_idx.reshape(A).astype(jnp.int32)
    tok_flat = jnp.repeat(jnp.arange(N, dtype=jnp.int32), TOP_K)
    g_flat = gate.reshape(A)
    order = jnp.argsort(e_flat)
    e_sorted = e_flat[order]
    counts = jnp.bincount(e_flat, length=N_EXPERTS).astype(jnp.int32)
    padded = ((counts + MOE_BLOCK - 1) // MOE_BLOCK) * MOE_BLOCK
    start = jnp.cumsum(counts) - counts
    pend = jnp.cumsum(padded)
    pstart = pend - padded
    dest = pstart[e_sorted] + (jnp.arange(A, dtype=jnp.int32) - start[e_sorted])
    n_rows = A + N_EXPERTS * MOE_BLOCK
    n_blocks = n_rows // MOE_BLOCK
    row_tok = jnp.full((n_rows,), N, jnp.int32).at[dest].set(tok_flat[order])
    row_gate = jnp.zeros((n_rows,), jnp.float32).at[dest].set(g_flat[order])
    block_e = jnp.minimum(
        jnp.searchsorted(pend, jnp.arange(n_blocks, dtype=jnp.int32) * MOE_BLOCK, side='right'),
        N_EXPERTS - 1).astype(jnp.int32)
    x_pad = jnp.concatenate([xt, jnp.zeros((1, D), xt.dtype)], axis=0)

    def expert_block(args):
        rows, e = args
        hb = x_pad[rows] @ w_up[e] + b_up[e]
        glu = jnp.minimum(hb[:, :D_EXPERT], SWIGLU_LIMIT)
        lin = jnp.clip(hb[:, D_EXPERT:], -SWIGLU_LIMIT, SWIGLU_LIMIT)
        act = glu * jax.nn.sigmoid(SWIGLU_ALPHA * glu) * (lin + 1.0)
        return act @ w_down[e] + b_down[e]

    y_rows = lax.map(expert_block, (row_tok.reshape(n_blocks, MOE_BLOCK), block_e)).reshape(n_rows, D)
    y = jnp.zeros((N + 1, D), jnp.float32).at[row_tok].add(row_gate[:, None] * y_rows.astype(jnp.float32))
    return y[:N].reshape(B, S, D).astype(xn.dtype)


def setup_inputs(seed: int = 0) -> dict:
    key = jax.random.key(seed)
    ks = jax.random.split(key, 24)
    f32 = jnp.float32
    L = DEPTH

    def nrm(k, shape, fan_in):
        return jax.random.normal(k, shape, f32) * (fan_in ** -0.5)

    def gain(k, shape):
        return 1.0 + 0.05 * jax.random.normal(k, shape, f32)

    def bias(k, shape, s=0.02):
        return s * jax.random.normal(k, shape, f32)

    return {
        "x": jax.random.normal(ks[0], (BATCH, SEQ, D_MODEL), f32),
        "mem": jax.random.normal(ks[1], (BATCH, N_MEM, D_MODEL), f32),
        "norm_mix_g": gain(ks[2], (L, D_MODEL)),
        "w_in": nrm(ks[3], (L, D_MODEL, IN_W), D_MODEL),
        "w_gate": nrm(ks[4], (L, D_MODEL, N_BRANCHES * D_MODEL), D_MODEL),
        "b_gate": bias(ks[5], (L, N_BRANCHES * D_MODEL)),
        "w_proj_attn": nrm(ks[6], (L, ATTN_W, D_MODEL), ATTN_W),
        "w_proj_pool": nrm(ks[7], (L, POOL_W, D_MODEL), POOL_W),
        "w_proj_mem": nrm(ks[8], (L, MEM_W, D_MODEL), MEM_W),
        "pool_w_group": nrm(ks[9], (L, N_POOL_GROUPS, POOL_GROUP_DIM, POOL_GROUP_DIM), POOL_GROUP_DIM),
        "pool_scale": gain(ks[10], (L, POOL_W)),
        "mem_norm_g": gain(ks[11], (L, D_MODEL)),
        "w_mem_kv": nrm(ks[12], (L, D_MODEL, 2 * MEM_W), D_MODEL),
        "w_out": nrm(ks[13], (L, D_MODEL, D_MODEL), D_MODEL),
        "norm_ffn_g": gain(ks[14], (L, D_MODEL)),
        "w_router": nrm(ks[15], (L, D_MODEL, N_EXPERTS), D_MODEL),
        "b_router": bias(ks[16], (L, N_EXPERTS), 0.01),
        "w_up": nrm(ks[17], (L, N_EXPERTS, D_MODEL, 2 * D_EXPERT), D_MODEL),
        "b_up": bias(ks[18], (L, N_EXPERTS, 2 * D_EXPERT)),
        "w_down": nrm(ks[19], (L, N_EXPERTS, D_EXPERT, D_MODEL), D_EXPERT),
        "b_down": bias(ks[20], (L, N_EXPERTS, D_MODEL)),
        "norm_final_g": gain(ks[21], (D_MODEL,)),
    }


def reference(x, mem, norm_mix_g, w_in, w_gate, b_gate, w_proj_attn, w_proj_pool, w_proj_mem,
              pool_w_group, pool_scale, mem_norm_g, w_mem_kv, w_out, norm_ffn_g,
              w_router, b_router, w_up, b_up, w_down, b_down, norm_final_g):
    B, S, D = x.shape
    pos = jnp.arange(S, dtype=jnp.int32)
    split_points = tuple(int(p) for p in np.cumsum(IN_SPLITS)[:-1])
    h = x
    for l in range(DEPTH):
        xn = rmsnorm(h, norm_mix_g[l])
        proj = xn @ w_in[l]
        q, k, v, iq, ik, iw, u, qm = jnp.split(proj, split_points, axis=-1)
        q = partial_rope(q.reshape(B, S, N_HEADS_ATTN, HEAD_DIM), pos)
        k = partial_rope(k.reshape(B, S, N_HEADS_ATTN, HEAD_DIM), pos)
        v = v.reshape(B, S, N_HEADS_ATTN, HEAD_DIM)
        iq = partial_rope(iq.reshape(B, S, N_HEADS_IDX, IDX_DIM), pos)
        ik = partial_rope(ik.reshape(B, S, 1, IDX_DIM), pos)[:, :, 0]
        iw = iw * (N_HEADS_IDX ** -0.5)
        y_attn = dsa_attention(q, k, v, iq, ik, iw)
        y_pool = multiscale_pool(u, pool_w_group[l], pool_scale[l])
        y_mem = memory_attention(qm, rmsnorm(mem, mem_norm_g[l]), w_mem_kv[l])
        gates = jax.nn.sigmoid(xn @ w_gate[l] + b_gate[l]).reshape(B, S, N_BRANCHES, D)
        merged = (gates[:, :, 0] * (y_attn @ w_proj_attn[l])
                  + gates[:, :, 1] * (y_pool @ w_proj_pool[l])
                  + gates[:, :, 2] * (y_mem @ w_proj_mem[l]))
        h = h + merged @ w_out[l]
        h = h + moe(rmsnorm(h, norm_ffn_g[l]), w_router[l], b_router[l], w_up[l], b_up[l],
                    w_down[l], b_down[l])
    return rmsnorm(h, norm_final_g)
```

```cpp
#include <hip/hip_runtime.h>
#include <hip/hip_bf16.h>
#include <cstdio>
#include <cstdint>

#define GAS __attribute__((address_space(1)))
#define LAS __attribute__((address_space(3)))
typedef unsigned short bf16_t;
typedef short bf16x8 __attribute__((ext_vector_type(8)));
typedef _Float16 half8 __attribute__((ext_vector_type(8)));
typedef float f32x4 __attribute__((ext_vector_type(4)));
typedef float f32x2 __attribute__((ext_vector_type(2)));
typedef float f32x16 __attribute__((ext_vector_type(16)));
typedef unsigned u32x4 __attribute__((ext_vector_type(4)));
typedef unsigned u32x2 __attribute__((ext_vector_type(2)));
typedef GAS unsigned gu32;

constexpr int NB = 4, SEQ = 4096, NTOK = NB * SEQ, DM = 1024;
constexpr int NE = 32, TOPK = 4;
constexpr int N1 = 5888;
constexpr int N1_IN = 2816;
constexpr int MOE_ROWS = 73728;
constexpr float EPS = 1e-6f;
constexpr float C2 = 0.125f * 1.4426950408889634f;

constexpr size_t MiB = 1u << 20;
constexpr size_t WS_CTL = 0, CTL_ZERO_BYTES = 1 * MiB;
constexpr size_t WS_ROPE = 1 * MiB;
constexpr size_t WS_WGT = WS_ROPE + 256 * 1024;
constexpr size_t WS_WRH = WS_WGT + 32 * 1024;
constexpr size_t WS_WRL = WS_WRH + 64 * 1024;
constexpr size_t WS_W1T = 2 * MiB;
constexpr size_t WS_WPA = 14 * MiB, WS_WPP = 15 * MiB, WS_WPM = 15 * MiB + 512 * 1024, WS_WOUT = 16 * MiB, WS_WKV = 18 * MiB;
constexpr size_t WS_MEMN = 19 * MiB, WS_KM = 21 * MiB, WS_VMT = 21 * MiB + 512 * 1024;
constexpr size_t WS_IW = 22 * MiB, WS_IK = 23 * MiB;
constexpr size_t WS_RE = 25 * MiB, WS_RR = WS_RE + 256 * 1024, WS_RG = WS_RR + 256 * 1024, WS_SLOT = WS_RG + 256 * 1024, WS_RSTD = WS_SLOT + 256 * 1024;
constexpr size_t WS_WUP = 32 * MiB, WS_WDN = 160 * MiB, WS_XN = 224 * MiB;
constexpr size_t WS_Q = 256 * MiB, WS_K = 272 * MiB, WS_V = 288 * MiB, WS_IQ = 304 * MiB, WS_U = 320 * MiB, WS_QM = 328 * MiB;
constexpr size_t WS_YPOOL = 336 * MiB, WS_YMEM = 344 * MiB, WS_MASKT = 352 * MiB, WS_MERGED = 360 * MiB, WS_G = 392 * MiB;
constexpr size_t WS_XG = 488 * MiB, WS_ACT = 632 * MiB, WS_END = 776 * MiB;

constexpr int CW_TMO = 0;
constexpr int CW_CNT = 1024;
constexpr int CW_BAR = 4096;

constexpr int RING_BYTES = 131072;
constexpr int LDS_BYTES = 155648;
constexpr int MISC_OFF = LDS_BYTES - 1024;

#define LDS_WAIT() asm volatile("s_waitcnt lgkmcnt(0)" ::: "memory")
#define VM_WAIT() asm volatile("s_waitcnt vmcnt(0)" ::: "memory")

typedef __bf16 bf16x2_cv __attribute__((ext_vector_type(2)));
__device__ __forceinline__ unsigned cvt_pk_bf16(float lo, float hi) { f32x2 v = {lo, hi}; bf16x2_cv b = __builtin_convertvector(v, bf16x2_cv); return __builtin_bit_cast(unsigned, b); }
__device__ __forceinline__ unsigned cvt_pk_bf16_s(float lo, float hi) { return cvt_pk_bf16(lo, hi); }
typedef _Float16 h2_t __attribute__((ext_vector_type(2)));
__device__ __forceinline__ unsigned cvt_pk_f16(float lo, float hi) { h2_t v = {(_Float16)lo, (_Float16)hi}; return __builtin_bit_cast(unsigned, v); }
__device__ __forceinline__ float bf2f(unsigned short b) { return __builtin_bit_cast(float, (unsigned)b << 16); }
__device__ __forceinline__ float bflo(unsigned w) { return __builtin_bit_cast(float, w << 16); }
__device__ __forceinline__ float bfhi(unsigned w) { return __builtin_bit_cast(float, w & 0xffff0000u); }
__device__ __forceinline__ float wave_sum(float v) {
#pragma unroll
    for (int o = 1; o < 64; o <<= 1) v += __shfl_xor(v, o);
    return v;
}
__device__ __forceinline__ float sigmoidf_fast(float x) { return __builtin_amdgcn_rcpf(1.f + __builtin_amdgcn_exp2f(-1.4426950408889634f * x)); }

#ifndef PG8_DMA_AUX
#define PG8_DMA_AUX 0
#endif
namespace pg8 {
constexpr int BM = 256, BK = 64, HALF = 128, HTB = HALF * BK * 2, STAGE_BYTES = 8 * HTB, NXCD = 8, WGM = 8;
__host__ __device__ __forceinline__ int lds_byte(int r, int c) { const int st = (r >> 4) * 2 + (c >> 5), rr = r & 15, cc = c & 31, ob = rr * 64 + cc * 2; return st * 1024 + (ob ^ (((ob >> 9) & 1) << 5)); }
__host__ __device__ __forceinline__ void stage_rc(int b, int& R, int& C) { const int st = b / 1024, sb = b % 1024, swz = sb ^ (((sb >> 9) & 1) << 5); R = (st >> 1) * 16 + swz / 64; C = (st & 1) * 32 + (swz % 64) / 2; }
__host__ __device__ __forceinline__ int perm32(int rho) { const int n = rho >> 4, i = rho & 15; return 8 * (i >> 2) + 4 * n + (i & 3); }

struct Unit { int pm, pn, kind, c0; const char* a; const char* b; };

__device__ __forceinline__ void tile_order(int L, int nM, int nN, int& pm, int& pn) {
    const int nwg = nM * nN; int wgid = L;
    { const int q = nwg / NXCD, r = nwg % NXCD, xcd = wgid % NXCD, off = wgid / NXCD; wgid = (xcd < r ? xcd * (q + 1) : r * (q + 1) + (xcd - r) * q) + off; }
    const int nig = WGM * nN, gid = wgid / nig, fm = gid * WGM, gsz = (nM - fm) < WGM ? (nM - fm) : WGM;
    pm = fm + ((wgid % nig) % gsz); pn = (wgid % nig) / gsz;
}

template <class Epi, class Sched, bool ALIGN_EPI = false, bool SP2 = false>
__device__ __forceinline__ void gemm_phase(LAS unsigned char* lds, const int K, const Sched& S, const Epi& E, const int ktiles = 0) {
    const int tid = threadIdx.x, wid = __builtin_amdgcn_readfirstlane(tid >> 6), lane = tid & 63, wr = wid >> 2, wc = wid & 3, fr = lane & 15, fq = lane >> 4;
    const int nt = ktiles ? ktiles : K / BK;
    unsigned voffA[2], voffB[2];
#pragma unroll
    for (int i = 0; i < 2; ++i) { int R, C; stage_rc(tid * 16 + i * 8192, R, C); const int Rb = Epi::PERM ? ((R & ~31) + perm32(R & 31)) : R;
        voffA[i] = (unsigned)(R * K + C) * 2u; voffB[i] = (unsigned)(Rb * K + C) * 2u; }
    const size_t kstep = (size_t)(BK * 2);
    const size_t hstep = (size_t)HALF * K * 2;
    const unsigned ldsw = (unsigned)wid * 1024u;
    const int aoff = lds_byte(wr * 64 + fr, fq * 8), boff = lds_byte(wc * 32 + fr, fq * 8);
#define PG8_SA(b, h) (((b) * 2 + (h)) * HTB)
#define PG8_SB(b, h) ((4 + (b) * 2 + (h)) * HTB)
#define PG8_STAGE(bufoff, gbase, voff) do { _Pragma("unroll") for (int _i = 0; _i < 2; ++_i) \
        __builtin_amdgcn_global_load_lds((const unsigned*)((const char*)(gbase) + (voff)[_i]), (LAS unsigned*)(lds + (bufoff) + ldsw + _i * 8192), 16, 0, PG8_DMA_AUX); } while (0)
#define PG8_LDA(dst, b, h) do { _Pragma("unroll") for (int m = 0; m < 4; ++m) _Pragma("unroll") for (int k = 0; k < 2; ++k) dst[m][k] = *(const LAS bf16x8*)(lds + PG8_SA(b, h) + aoff + m * 2048 + k * 1024); } while (0)
#define PG8_LDB(dst, b, h) do { _Pragma("unroll") for (int n = 0; n < 2; ++n) _Pragma("unroll") for (int k = 0; k < 2; ++k) dst[n][k] = *(const LAS bf16x8*)(lds + PG8_SB(b, h) + boff + n * 2048 + k * 1024); } while (0)
#define PG8_MMA(ai, bj, At, Bt) do { __builtin_amdgcn_s_setprio(1); _Pragma("unroll") for (int m = 0; m < 4; ++m) _Pragma("unroll") for (int n = 0; n < 2; ++n) _Pragma("unroll") for (int k = 0; k < 2; ++k) \
        acc[ai][bj][m][n] = __builtin_amdgcn_mfma_f32_16x16x32_bf16(Bt[n][k], At[m][k], acc[ai][bj][m][n], 0, 0, 0); __builtin_amdgcn_s_setprio(0); } while (0)
#define PG8_WAIT_V(n) asm volatile("s_waitcnt vmcnt(" #n ")" ::: "memory")
#define PG8_WAIT_L(n) asm volatile("s_waitcnt lgkmcnt(" #n ")" ::: "memory")
#define PG8_BAR __builtin_amdgcn_s_barrier()
#define PG8_SCHED __builtin_amdgcn_sched_barrier(0)
    Unit cur, nxt; int ui = 0;
    if (!S.next(0, cur)) return;
    f32x4 acc[2][2][4][2];
#pragma unroll
    for (int a = 0; a < 2; ++a)
#pragma unroll
        for (int b = 0; b < 2; ++b)
#pragma unroll
            for (int m = 0; m < 4; ++m)
#pragma unroll
                for (int n = 0; n < 2; ++n) acc[a][b][m][n] = (f32x4){0.f, 0.f, 0.f, 0.f};
    bf16x8 At[4][2], B0[2][2], B1[2][2];
    const char* cA = cur.a; const char* cB = cur.b;
    if constexpr (SP2) {
        PG8_STAGE(PG8_SB(0, 0), cB, voffB); PG8_STAGE(PG8_SB(0, 1), cB + hstep, voffB); PG8_STAGE(PG8_SA(0, 0), cA, voffA); PG8_STAGE(PG8_SA(0, 1), cA + hstep, voffA);
        if (wr == 1) PG8_BAR;
        PG8_WAIT_V(2); PG8_BAR;
        PG8_STAGE(PG8_SB(1, 0), cB + kstep, voffB); PG8_STAGE(PG8_SA(1, 0), cA + kstep, voffA); PG8_STAGE(PG8_SB(1, 1), cB + hstep + kstep, voffB);
        PG8_WAIT_V(6); PG8_BAR;
    } else {
        PG8_STAGE(PG8_SB(0, 0), cB, voffB); PG8_STAGE(PG8_SA(0, 0), cA, voffA); PG8_STAGE(PG8_SB(0, 1), cB + hstep, voffB); PG8_STAGE(PG8_SA(0, 1), cA + hstep, voffA);
        if (wr == 1) PG8_BAR;
        PG8_WAIT_V(4); PG8_BAR;
        PG8_STAGE(PG8_SB(1, 0), cB + kstep, voffB); PG8_STAGE(PG8_SA(1, 0), cA + kstep, voffA); PG8_STAGE(PG8_SB(1, 1), cB + hstep + kstep, voffB);
        PG8_WAIT_V(6); PG8_BAR;
    }
    for (;;) {
        const bool has_next = S.next(ui + 1, nxt);
        const char* nA = has_next ? nxt.a : cA; const char* nB = has_next ? nxt.b : cB;
        for (int t = 0; t < nt; t += 2) {
            const bool last = (t == nt - 2);
            const char* a1 = cA + (size_t)(t + 1) * kstep;
            const char* a2 = last ? nA : cA + (size_t)(t + 2) * kstep; const char* b2 = last ? nB : cB + (size_t)(t + 2) * kstep;
            const char* a3 = a2 + kstep; const char* b3 = b2 + kstep;
            if constexpr (SP2) {
            PG8_LDB(B0, 0, 0); PG8_LDB(B1, 0, 1); PG8_SCHED; PG8_LDA(At, 0, 0); PG8_STAGE(PG8_SA(1, 1), a1 + hstep, voffA);
            PG8_WAIT_V(8); PG8_WAIT_L(0); PG8_BAR; PG8_MMA(0, 0, At, B0); PG8_MMA(0, 1, At, B1); PG8_BAR; PG8_SCHED;
            PG8_LDA(At, 0, 1); PG8_STAGE(PG8_SB(0, 0), b2, voffB); PG8_STAGE(PG8_SB(0, 1), b2 + hstep, voffB); PG8_STAGE(PG8_SA(0, 0), a2, voffA);
            PG8_WAIT_V(8); PG8_WAIT_L(0); PG8_BAR; PG8_MMA(1, 0, At, B0); PG8_MMA(1, 1, At, B1); PG8_BAR; PG8_SCHED;
            PG8_LDB(B0, 1, 0); PG8_LDB(B1, 1, 1); PG8_SCHED; PG8_LDA(At, 1, 0); PG8_STAGE(PG8_SA(0, 1), a2 + hstep, voffA);
            PG8_WAIT_V(8); PG8_WAIT_L(0); PG8_BAR; PG8_MMA(0, 0, At, B0); PG8_MMA(0, 1, At, B1); PG8_BAR; PG8_SCHED;
            PG8_LDA(At, 1, 1); PG8_STAGE(PG8_SB(1, 0), b3, voffB); PG8_STAGE(PG8_SB(1, 1), b3 + hstep, voffB); PG8_STAGE(PG8_SA(1, 0), a3, voffA);
            PG8_WAIT_V(8); PG8_WAIT_L(0); PG8_BAR; PG8_MMA(1, 0, At, B0); PG8_MMA(1, 1, At, B1); PG8_BAR; PG8_SCHED;
            } else {
            PG8_LDB(B0, 0, 0); PG8_SCHED; PG8_LDA(At, 0, 0); PG8_STAGE(PG8_SA(1, 1), a1 + hstep, voffA);
            PG8_WAIT_L(8); PG8_BAR; PG8_WAIT_L(0); PG8_MMA(0, 0, At, B0); PG8_BAR; PG8_SCHED;
            PG8_LDB(B1, 0, 1); PG8_STAGE(PG8_SB(0, 0), b2, voffB);
            PG8_BAR; PG8_WAIT_L(0); PG8_MMA(0, 1, At, B1); PG8_BAR;
            PG8_LDA(At, 0, 1); PG8_STAGE(PG8_SA(0, 0), a2, voffA);
            PG8_BAR; PG8_WAIT_L(0); PG8_MMA(1, 0, At, B0); PG8_BAR; PG8_SCHED;
            PG8_STAGE(PG8_SB(0, 1), b2 + hstep, voffB);
            PG8_WAIT_V(6); PG8_BAR; PG8_MMA(1, 1, At, B1); PG8_BAR;
            PG8_LDB(B0, 1, 0); PG8_SCHED; PG8_LDA(At, 1, 0); PG8_STAGE(PG8_SA(0, 1), a2 + hstep, voffA);
            PG8_WAIT_L(8); PG8_BAR; PG8_WAIT_L(0); PG8_MMA(0, 0, At, B0); PG8_BAR; PG8_SCHED;
            PG8_LDB(B1, 1, 1); PG8_STAGE(PG8_SB(1, 0), b3, voffB);
            PG8_BAR; PG8_WAIT_L(0); PG8_MMA(0, 1, At, B1); PG8_BAR;
            PG8_LDA(At, 1, 1); PG8_STAGE(PG8_SA(1, 0), a3, voffA);
            PG8_BAR; PG8_WAIT_L(0); PG8_MMA(1, 0, At, B0); PG8_BAR; PG8_SCHED;
            PG8_STAGE(PG8_SB(1, 1), b3 + hstep, voffB);
            PG8_WAIT_V(6); PG8_BAR; PG8_MMA(1, 1, At, B1); PG8_BAR;
            }
        }
        if constexpr (ALIGN_EPI) { if (wr == 0) PG8_BAR; }
        E(acc, cur, wr, wc, fr, fq);
        if (!has_next) break;
#pragma unroll
        for (int a = 0; a < 2; ++a)
#pragma unroll
            for (int b = 0; b < 2; ++b)
#pragma unroll
                for (int m = 0; m < 4; ++m)
#pragma unroll
                    for (int n = 0; n < 2; ++n) acc[a][b][m][n] = (f32x4){0.f, 0.f, 0.f, 0.f};
        cur = nxt; cA = nA; cB = nB; ++ui;
        if constexpr (ALIGN_EPI) { if (wr == 1) PG8_BAR; }
    }
    PG8_WAIT_V(0);
    if constexpr (!ALIGN_EPI) { if (wr == 0) PG8_BAR; }
    PG8_BAR;
#undef PG8_SA
#undef PG8_SB
#undef PG8_STAGE
#undef PG8_LDA
#undef PG8_LDB
#undef PG8_MMA
#undef PG8_WAIT_V
#undef PG8_WAIT_L
#undef PG8_BAR
#undef PG8_SCHED
}
}
using pg8::Unit;
constexpr bool K_ALIGN = true, K_SP2 = true;
#ifndef P4_ALIGN
#define P4_ALIGN true
#endif
#ifndef P4_SP2
#define P4_SP2 true
#endif

enum { KQ = 0, KK = 1, KV = 2, KIQ = 3, KU = 4, KQM = 5, KIKW = 6, KG = 7, KKM = 8, KVMT = 9 };
struct EpiP1 {
    static constexpr bool PERM = true;
    bf16_t *Q, *K, *V, *U, *QM, *G, *KM, *VMT; unsigned short *IQ, *IK; float* IW; const float* bgate; const float* rope;
    __device__ __forceinline__ static void rope4(f32x4& v, const f32x4 cs) {
        const float a1 = v[0] * cs[0] - v[1] * cs[1], a2 = v[1] * cs[0] + v[0] * cs[1];
        const float b1 = v[2] * cs[2] - v[3] * cs[3], b2 = v[3] * cs[2] + v[2] * cs[3];
        v = (f32x4){a1, a2, b1, b2};
    }
    template <int KIND> __device__ __forceinline__ void run(const f32x4 (&acc)[2][2][4][2], const Unit& u, int wr, int wc, int fr, int fq) const {
        const int row0 = u.pm * 256 + wr * 64 + fr;
        constexpr bool ROPE = (KIND == KQ || KIND == KK || KIND == KIQ || KIND == KIKW);
#pragma unroll
        for (int ai = 0; ai < 2; ++ai)
#pragma unroll
            for (int m = 0; m < 4; ++m) {
                const int row = row0 + ai * 128 + m * 16;
                f32x4 cs0 = (f32x4){1.f, 0.f, 1.f, 0.f}, cs1 = cs0;
                const bool ropelane = ROPE && ((wc & 1) == 0) && (fq < 2);
                if (ROPE) { if (ropelane) { const float* rp = rope + (size_t)(row & (SEQ - 1)) * 16 + 8 * fq; cs0 = *(const f32x4*)rp; cs1 = *(const f32x4*)(rp + 4); } }
#pragma unroll
                for (int bj = 0; bj < 2; ++bj) {
                    f32x4 v0 = acc[ai][bj][m][0], v1 = acc[ai][bj][m][1];
                    const int lc = bj * 128 + wc * 32 + 8 * fq;
                    if constexpr (KIND == KQ || KIND == KK || KIND == KIQ) { if (ropelane) { rope4(v0, cs0); rope4(v1, cs1); } }
                    if constexpr (KIND == KIKW) { if (ropelane && bj == 0 && wc == 0) { rope4(v0, cs0); rope4(v1, cs1); } }
                    if constexpr (KIND == KQ || KIND == KQM) { v0 = v0 * C2; v1 = v1 * C2; }
                    if constexpr (KIND == KIQ) { v0 = v0 * 0.125f; v1 = v1 * 0.125f; }
                    if constexpr (KIND == KG) {
                        const float* bp = bgate + u.c0 + lc; const f32x4 b0 = *(const f32x4*)bp, b1 = *(const f32x4*)(bp + 4);
#pragma unroll
                        for (int i = 0; i < 4; ++i) { v0[i] = sigmoidf_fast(v0[i] + b0[i]); v1[i] = sigmoidf_fast(v1[i] + b1[i]); }
                    }
                    if constexpr (KIND == KIQ) {
                        u32x4 w; w.x = cvt_pk_f16(v0[0], v0[1]); w.y = cvt_pk_f16(v0[2], v0[3]); w.z = cvt_pk_f16(v1[0], v1[1]); w.w = cvt_pk_f16(v1[2], v1[3]);
                        *(u32x4*)(IQ + (size_t)row * 512 + u.c0 + lc) = w;
                    } else if constexpr (KIND == KIKW) {
                        if (lc < 64) { u32x4 w; w.x = cvt_pk_f16(v0[0], v0[1]); w.y = cvt_pk_f16(v0[2], v0[3]); w.z = cvt_pk_f16(v1[0], v1[1]); w.w = cvt_pk_f16(v1[2], v1[3]);
                            *(u32x4*)(IK + (size_t)row * 64 + lc) = w; }
                        else if (lc == 64) { const float s = 0.35355339059327373f; float* p = IW + (size_t)row * 8; *(f32x4*)p = v0 * s; *(f32x4*)(p + 4) = v1 * s; }
                    } else if constexpr (KIND == KVMT) {
                        const int b = row >> 8, key = row & 255;
                        const float vv[8] = {v0[0], v0[1], v0[2], v0[3], v1[0], v1[1], v1[2], v1[3]};
#pragma unroll
                        for (int i = 0; i < 8; ++i) { const int c = lc + i, hm = c >> 6, d = c & 63; VMT[((size_t)(b * 4 + hm) * 64 + d) * 256 + key] = (bf16_t)(cvt_pk_bf16(vv[i], 0.f) & 0xffffu); }
                    } else {
                        u32x4 w; w.x = cvt_pk_bf16(v0[0], v0[1]); w.y = cvt_pk_bf16(v0[2], v0[3]); w.z = cvt_pk_bf16(v1[0], v1[1]); w.w = cvt_pk_bf16(v1[2], v1[3]);
                        bf16_t* dst;
                        if constexpr (KIND == KQ) dst = Q + (size_t)row * 512;
                        else if constexpr (KIND == KK) dst = K + (size_t)row * 512;
                        else if constexpr (KIND == KV) dst = V + (size_t)row * 512;
                        else if constexpr (KIND == KU) dst = U + (size_t)row * 256;
                        else if constexpr (KIND == KQM) dst = QM + (size_t)row * 256;
                        else if constexpr (KIND == KG) dst = G + (size_t)row * 3072;
                        else dst = KM + (size_t)row * 256;
                        *(u32x4*)(dst + u.c0 + lc) = w;
                    }
                }
            }
    }
    __device__ __forceinline__ void operator()(const f32x4 (&acc)[2][2][4][2], const Unit& u, int wr, int wc, int fr, int fq) const {
        switch (u.kind) {
            case KQ: run<KQ>(acc, u, wr, wc, fr, fq); break;
            case KK: run<KK>(acc, u, wr, wc, fr, fq); break;
            case KV: run<KV>(acc, u, wr, wc, fr, fq); break;
            case KIQ: run<KIQ>(acc, u, wr, wc, fr, fq); break;
            case KU: run<KU>(acc, u, wr, wc, fr, fq); break;
            case KQM: run<KQM>(acc, u, wr, wc, fr, fq); break;
            case KIKW: run<KIKW>(acc, u, wr, wc, fr, fq); break;
            case KG: run<KG>(acc, u, wr, wc, fr, fq); break;
            case KKM: run<KKM>(acc, u, wr, wc, fr, fq); break;
            default: run<KVMT>(acc, u, wr, wc, fr, fq); break;
        }
    }
};
struct Sched1 {
    const char *XN, *W1T, *MEMN, *WKV; int G, c;
    __device__ __forceinline__ bool next(int i, Unit& u) const {
        const int L = i * G + c;
        if (L < 64 * 23) {
            pg8::tile_order(L, 64, 23, u.pm, u.pn);
            u.a = XN + (size_t)u.pm * 256 * 2048; u.b = W1T + (size_t)u.pn * 256 * 2048;
            const int pn = u.pn;
            if (pn < 2) { u.kind = KQ; u.c0 = pn * 256; } else if (pn < 4) { u.kind = KK; u.c0 = (pn - 2) * 256; } else if (pn < 6) { u.kind = KV; u.c0 = (pn - 4) * 256; }
            else if (pn < 8) { u.kind = KIQ; u.c0 = (pn - 6) * 256; } else if (pn == 8) { u.kind = KU; u.c0 = 0; } else if (pn == 9) { u.kind = KQM; u.c0 = 0; }
            else if (pn == 10) { u.kind = KIKW; u.c0 = 0; } else { u.kind = KG; u.c0 = (pn - 11) * 256; }
            return true;
        }
        const int j = L - 64 * 23;
        if (j < 8) { u.pm = j >> 1; u.pn = j & 1; u.a = MEMN + (size_t)u.pm * 256 * 2048; u.b = WKV + (size_t)u.pn * 256 * 2048; u.kind = (u.pn == 0) ? KKM : KVMT; u.c0 = 0; return true; }
        return false;
    }
};
template <int MODE> struct EpiGate {
    static constexpr bool PERM = true;
    const bf16_t* G; const bf16_t* PREV; bf16_t* OUT; int br;
    __device__ __forceinline__ void operator()(const f32x4 (&acc)[2][2][4][2], const Unit& u, int wr, int wc, int fr, int fq) const {
        const int row0 = u.pm * 256 + wr * 64 + fr, col0 = u.pn * 256 + wc * 32 + 8 * fq;
#pragma unroll
        for (int ai = 0; ai < 2; ++ai)
#pragma unroll
            for (int m = 0; m < 4; ++m) {
                const int row = row0 + ai * 128 + m * 16;
#pragma unroll
                for (int bj = 0; bj < 2; ++bj) {
                    const int col = col0 + bj * 128;
                    const u32x4 g = *(const u32x4*)(G + (size_t)row * 3072 + br * 1024 + col);
                    const f32x4 v0 = acc[ai][bj][m][0], v1 = acc[ai][bj][m][1];
                    float o[8] = {v0[0] * bflo(g.x), v0[1] * bfhi(g.x), v0[2] * bflo(g.y), v0[3] * bfhi(g.y), v1[0] * bflo(g.z), v1[1] * bfhi(g.z), v1[2] * bflo(g.w), v1[3] * bfhi(g.w)};
                    if constexpr (MODE != 0) { const u32x4 p = *(const u32x4*)(PREV + (size_t)row * 1024 + col);
                        o[0] += bflo(p.x); o[1] += bfhi(p.x); o[2] += bflo(p.y); o[3] += bfhi(p.y); o[4] += bflo(p.z); o[5] += bfhi(p.z); o[6] += bflo(p.w); o[7] += bfhi(p.w); }
                    u32x4 w; w.x = cvt_pk_bf16(o[0], o[1]); w.y = cvt_pk_bf16(o[2], o[3]); w.z = cvt_pk_bf16(o[4], o[5]); w.w = cvt_pk_bf16(o[6], o[7]);
                    *(u32x4*)(OUT + (size_t)row * 1024 + col) = w;
                }
            }
    }
};
struct SchedSimple {
    const char *A, *B; int nM, nN, G, c; size_t tstep;
    __device__ __forceinline__ bool next(int i, Unit& u) const {
        const int L = i * G + c; if (L >= nM * nN) return false;
        pg8::tile_order(L, nM, nN, u.pm, u.pn); u.a = A + (size_t)u.pm * tstep; u.b = B + (size_t)u.pn * tstep; u.kind = 0; u.c0 = 0; return true;
    }
};
struct EpiRes {
    static constexpr bool PERM = false;
    const float* X; float* H;
    __device__ __forceinline__ void operator()(const f32x4 (&acc)[2][2][4][2], const Unit& u, int wr, int wc, int fr, int fq) const {
        const int row0 = u.pm * 256 + wr * 64 + fr, col0 = u.pn * 256 + wc * 32 + 4 * fq;
#pragma unroll
        for (int ai = 0; ai < 2; ++ai)
#pragma unroll
            for (int m = 0; m < 4; ++m) { const size_t off = (size_t)(row0 + ai * 128 + m * 16) * 1024 + col0;
#pragma unroll
                for (int bj = 0; bj < 2; ++bj)
#pragma unroll
                    for (int n = 0; n < 2; ++n) { const size_t o = off + bj * 128 + n * 16; *(f32x4*)(H + o) = *(const f32x4*)(X + o) + acc[ai][bj][m][n];
#ifdef DBG_DRAIN_ST
                        asm volatile("s_waitcnt vmcnt(0)" ::: "memory");
#endif
                    } }
    }
};
struct SchedMoe {
    const char *A, *W; const volatile LAS int* tpre; int npn, G, c;
    __device__ __forceinline__ bool next(int i, Unit& u) const {
        const int L = i * G + c; const int T = L / npn, pn = L - T * npn;
        if (T >= tpre[32]) return false;
        int e = 0;
#pragma unroll
        for (int j = 1; j < 32; ++j) e += (tpre[j] <= T) ? 1 : 0;
        u.pm = T; u.pn = pn; u.kind = e; u.c0 = 0; u.a = A + (size_t)T * 256 * 2048; u.b = W + ((size_t)e * npn + pn) * 256 * 2048; return true;
    }
};
struct EpiSwiglu {
    static constexpr bool PERM = true;
    const float* bup; bf16_t* ACT;
    __device__ __forceinline__ void operator()(const f32x4 (&acc)[2][2][4][2], const Unit& u, int wr, int wc, int fr, int fq) const {
        const int row0 = u.pm * 256 + wr * 64 + fr, e = u.kind, jc = u.pn * 128 + wc * 32 + 8 * fq;
        const float* bg = bup + (size_t)e * 2048 + jc; const float* bl = bg + 1024;
        const f32x4 bg0 = *(const f32x4*)bg, bg1 = *(const f32x4*)(bg + 4), bl0 = *(const f32x4*)bl, bl1 = *(const f32x4*)(bl + 4);
#pragma unroll
        for (int ai = 0; ai < 2; ++ai)
#pragma unroll
            for (int m = 0; m < 4; ++m) {
                const int row = row0 + ai * 128 + m * 16;
                float o[8];
#pragma unroll
                for (int n = 0; n < 2; ++n) { const f32x4 gv = acc[ai][0][m][n] + (n ? bg1 : bg0), lv = acc[ai][1][m][n] + (n ? bl1 : bl0);
#pragma unroll
                    for (int i = 0; i < 4; ++i) { const float g = fminf(gv[i], 7.f), l = fminf(fmaxf(lv[i], -7.f), 7.f); o[n * 4 + i] = g * sigmoidf_fast(1.702f * g) * (l + 1.f); } }
                u32x4 w; w.x = cvt_pk_bf16(o[0], o[1]); w.y = cvt_pk_bf16(o[2], o[3]); w.z = cvt_pk_bf16(o[4], o[5]); w.w = cvt_pk_bf16(o[6], o[7]);
                *(u32x4*)(ACT + (size_t)row * 1024 + jc) = w;
            }
    }
};
struct EpiDown {
    static constexpr bool PERM = true;
    const float* bdn; bf16_t* Y;
    __device__ __forceinline__ void operator()(const f32x4 (&acc)[2][2][4][2], const Unit& u, int wr, int wc, int fr, int fq) const {
        const int row0 = u.pm * 256 + wr * 64 + fr, e = u.kind, col0 = u.pn * 256 + wc * 32 + 8 * fq;
#pragma unroll
        for (int bj = 0; bj < 2; ++bj) { const float* bp = bdn + (size_t)e * 1024 + col0 + bj * 128; const f32x4 b0 = *(const f32x4*)bp, b1 = *(const f32x4*)(bp + 4);
#pragma unroll
            for (int ai = 0; ai < 2; ++ai)
#pragma unroll
                for (int m = 0; m < 4; ++m) { const int row = row0 + ai * 128 + m * 16; const f32x4 v0 = acc[ai][bj][m][0] + b0, v1 = acc[ai][bj][m][1] + b1;
                    u32x4 w; w.x = cvt_pk_bf16(v0[0], v0[1]); w.y = cvt_pk_bf16(v0[2], v0[3]); w.z = cvt_pk_bf16(v1[0], v1[1]); w.w = cvt_pk_bf16(v1[2], v1[3]);
                    *(u32x4*)(Y + (size_t)row * 1024 + col0 + bj * 128) = w; } }
    }
};

namespace attn_body {
using bf16 = __hip_bfloat16;
using s16x4 = __attribute__((ext_vector_type(4))) short;
constexpr int BATCH = 4, NHEAD = 8, ASEQ = 4096, D = 64, ADM = NHEAD * D;
constexpr int NW = 8, QBLK = 32, QB = QBLK * NW, KVBLK = 64, NQB = ASEQ / QB;
__device__ __forceinline__ int crow(int r, int hi) { return (r & 3) + 8 * (r >> 2) + 4 * hi; }
#define SBAR() __builtin_amdgcn_sched_barrier(0)
constexpr int NSLOT = 3, SLOTB = 8192;
constexpr int LDS_K = 0, LDS_V = NSLOT * SLOTB, LDS_WS = 2 * NSLOT * SLOTB, LDS_OST = LDS_WS + NW * 64 * 4, LDS_BYTES_A = LDS_OST + NW * 4096;
__device__ __forceinline__ void glds16(const void* gsrc, unsigned lds_dst) { unsigned keep;
  asm volatile("s_mov_b32 %0, m0\n\ts_mov_b32 m0, %2\n\ts_nop 0\n\tglobal_load_lds_dwordx4 %1, off\n\ts_mov_b32 m0, %0" : "=&s"(keep) : "v"(gsrc), "s"(lds_dst) : "memory"); }
__device__ __forceinline__ float max3f(float a, float b, float c) { float r; asm("v_max3_f32 %0, %1, %2, %3" : "=v"(r) : "v"(a), "v"(b), "v"(c)); return r; }
__device__ __forceinline__ float max2f(float a, float b) { float r; asm("v_max_f32_e32 %0, %1, %2" : "=v"(r) : "v"(a), "v"(b)); return r; }
__device__ __forceinline__ float fadd_s(float a, float b) { float r; asm("v_add_f32_e32 %0, %1, %2" : "=v"(r) : "v"(a), "v"(b)); return r; }
__device__ __forceinline__ float fsub_s(float a, float b) { float r; asm("v_sub_f32_e32 %0, %1, %2" : "=v"(r) : "v"(a), "v"(b)); return r; }
typedef float f32x2_t __attribute__((ext_vector_type(2))); typedef __bf16 bf16x2_t __attribute__((ext_vector_type(2)));
__device__ __forceinline__ unsigned cvtpk_s(float lo, float hi) { f32x2_t v = {lo, hi}; bf16x2_t b = __builtin_convertvector(v, bf16x2_t); return __builtin_bit_cast(unsigned, b); }
#define WAIT_BAR(N) asm volatile("s_waitcnt vmcnt(" #N ") lgkmcnt(0)\n\ts_barrier" ::: "memory")
__device__ __forceinline__ void qkt(f32x16& p0, f32x16& p1, const char* Kslot, const bf16x8* qr, const f32x16& negm, int r32, int hi) {
  const char* kb = Kslot + hi * 1024 + r32 * 16;
  #pragma unroll
  for (int d0 = 0; d0 < 4; ++d0) {
    const bf16x8 b0 = *reinterpret_cast<const bf16x8*>(kb + d0 * 2048);
    const bf16x8 b1 = *reinterpret_cast<const bf16x8*>(kb + d0 * 2048 + 512);
    if (d0 == 0) { p0 = __builtin_amdgcn_mfma_f32_32x32x16_bf16(b0, qr[0], negm, 0, 0, 0); p1 = __builtin_amdgcn_mfma_f32_32x32x16_bf16(b1, qr[0], negm, 0, 0, 0); }
    else { p0 = __builtin_amdgcn_mfma_f32_32x32x16_bf16(b0, qr[d0], p0, 0, 0, 0); p1 = __builtin_amdgcn_mfma_f32_32x32x16_bf16(b1, qr[d0], p1, 0, 0, 0); } }
}
typedef __attribute__((address_space(3))) const char* lds_cptr;
typedef short v4i16_t __attribute__((ext_vector_type(4)));
__device__ __forceinline__ void kload8(bf16x8* kf, lds_cptr kp) {
  kf[0] = *(const LAS bf16x8*)(kp);        kf[1] = *(const LAS bf16x8*)(kp + 512);
  kf[2] = *(const LAS bf16x8*)(kp + 2048); kf[3] = *(const LAS bf16x8*)(kp + 2560);
  kf[4] = *(const LAS bf16x8*)(kp + 4096); kf[5] = *(const LAS bf16x8*)(kp + 4608);
  kf[6] = *(const LAS bf16x8*)(kp + 6144); kf[7] = *(const LAS bf16x8*)(kp + 6656);
}
__device__ __forceinline__ void kload2(bf16x8* kf, lds_cptr kp, int j) { kf[2 * j] = *(const LAS bf16x8*)(kp + j * 2048); kf[2 * j + 1] = *(const LAS bf16x8*)(kp + j * 2048 + 512); }
__device__ __forceinline__ s16x4 vtr(lds_cptr p) { return __builtin_bit_cast(s16x4, __builtin_amdgcn_ds_read_tr16_b64_v4i16((LAS v4i16_t*)p)); }
__device__ __forceinline__ float rowmax(const f32x16& p0, const f32x16& p1) {
  float a = max3f(p0[0], p0[1], p1[0]), b = max3f(p0[2], p0[3], p1[1]); a = max3f(a, p1[2], p1[3]);
  #pragma unroll
  for (int r = 4; r < 16; r += 4) { a = max3f(a, p0[r], p0[r + 1]); b = max3f(b, p0[r + 2], p0[r + 3]); a = max3f(a, p1[r], p1[r + 1]); b = max3f(b, p1[r + 2], p1[r + 3]); }
  const float m = max2f(a, b);
  auto rr = __builtin_amdgcn_permlane32_swap(__float_as_uint(m), __float_as_uint(m), false, false);
  return max2f(__uint_as_float(rr[0]), __uint_as_float(rr[1]));
}
__device__ __forceinline__ void pv(f32x16* o, int vb, bf16x8 pa0, bf16x8 pa1, bf16x8 pa2, bf16x8 pa3) {
  #pragma unroll
  for (int d0 = 0; d0 < 2; ++d0) { s16x4 lo[4], hi[4];
    #pragma unroll
    for (int ks = 0; ks < 4; ++ks) {
      asm volatile("ds_read_b64_tr_b16 %0,%1 offset:%c2" : "=&v"(lo[ks]) : "v"(vb), "i"(d0 * 4096 + ks * 1024) : "memory");
      asm volatile("ds_read_b64_tr_b16 %0,%1 offset:%c2" : "=&v"(hi[ks]) : "v"(vb), "i"(d0 * 4096 + ks * 1024 + 512) : "memory"); }
    asm volatile("s_waitcnt lgkmcnt(0)" ::: "memory"); SBAR();
    #define PK(k) (bf16x8){lo[k][0], lo[k][1], lo[k][2], lo[k][3], hi[k][0], hi[k][1], hi[k][2], hi[k][3]}
    o[d0] = __builtin_amdgcn_mfma_f32_32x32x16_bf16(pa0, PK(0), o[d0], 0, 0, 0);
    o[d0] = __builtin_amdgcn_mfma_f32_32x32x16_bf16(pa1, PK(1), o[d0], 0, 0, 0);
    o[d0] = __builtin_amdgcn_mfma_f32_32x32x16_bf16(pa2, PK(2), o[d0], 0, 0, 0);
    o[d0] = __builtin_amdgcn_mfma_f32_32x32x16_bf16(pa3, PK(3), o[d0], 0, 0, 0);
    #undef PK
  }
}
typedef const __attribute__((address_space(4))) unsigned long long* mask_cptr;
#define ATTN_STORE16(p, v) (*(u32x4*)(p) = (v))
template <int THRL> __device__ __forceinline__ void attn_unit(int b, int h, int qb, const bf16* Q, const bf16* __restrict__ K, const bf16* __restrict__ V, bf16* O, const unsigned long long* MT, char* shm) {
  int tid = threadIdx.x; asm volatile("" : "+v"(tid));
  const int lane = tid & 63, r32 = lane & 31, hi = lane >> 5; const int wid = __builtin_amdgcn_readfirstlane(tid >> 6);
  const long rowbase = (long)b * ASEQ; const int q0 = qb * QB;
  const bf16* Qw = Q + (rowbase + q0 + wid * QBLK) * ADM + h * D;
  const bf16 *Kh = K + rowbase * ADM + h * D, *Vh = V + rowbase * ADM + h * D;
  const mask_cptr mbase = (mask_cptr)(MT + (size_t)__builtin_amdgcn_readfirstlane((b * 128 + qb * 8 + wid) * 64) * 32);
  const unsigned lds0 = (unsigned)(uintptr_t)shm;
  float* wsf = (float*)(shm + LDS_WS) + wid * 64;
  const bf16* ksrc = Kh + (long)lane * ADM + wid * 8;
  const bf16* vsrc = Vh + (long)(16 * (wid & 3) + (lane >> 2)) * ADM + (wid >> 2) * 32 + (lane & 3) * 8;
  const unsigned kdst = lds0 + LDS_K + wid * 1024, vdst = lds0 + LDS_V + wid * 1024;
  #define DMA_K(t, slot) glds16(ksrc + (long)(t) * KVBLK * ADM, (unsigned)__builtin_amdgcn_readfirstlane(kdst + (slot)))
  #define DMA_V(t, slot) glds16(vsrc + (long)(t) * KVBLK * ADM, (unsigned)__builtin_amdgcn_readfirstlane(vdst + (slot)))
  const int vb0 = (int)(lds0 + LDS_V) + ((lane >> 4) & 1) * 32 + (lane & 3) * 8 + (4 * hi + ((lane & 15) >> 2)) * 64;
  const char* Kbase = shm + LDS_K; bf16x8 kf[8];
  const lds_cptr shm3 = (lds_cptr)shm; const lds_cptr kp0 = shm3 + LDS_K + hi * 1024 + r32 * 16; const lds_cptr vp0 = shm3 + LDS_V + ((lane >> 4) & 1) * 32 + (lane & 3) * 8 + (4 * hi + ((lane & 15) >> 2)) * 64;
  const int NT = (q0 + QB) / KVBLK;
  DMA_K(0, 0); DMA_V(0, 0); DMA_K(1, SLOTB);
  bf16x8 qr[4];
  #pragma unroll
  for (int d0 = 0; d0 < 4; ++d0) qr[d0] = *reinterpret_cast<const bf16x8*>(&Qw[(long)r32 * ADM + d0 * 16 + hi * 8]);
  float mhat = 0.f, l_reg = 0.f; f32x16 o[2]; o[0] = f32x16{}; o[1] = f32x16{}; f32x16 negm = f32x16{}; asm volatile("" : "+v"(negm));
  float NEGV = -INFINITY; asm volatile("" : "+v"(NEGV));
  #define CMASK(P0, P1, t) do { const mask_cptr mp_ = mbase + (size_t)(t) * 32; \
    asm volatile("s_nop 15\n\ts_nop 7" : "+v"(P0), "+v"(P1)); \
    _Pragma("unroll") for (int r_ = 0; r_ < 16; ++r_) { const unsigned long long m0_ = mp_[r_]; \
      asm("v_cndmask_b32_e64 %0, %1, %0, %2" : "+v"(P0[r_]) : "v"(NEGV), "s"(m0_)); } \
    _Pragma("unroll") for (int r_ = 0; r_ < 16; ++r_) { const unsigned long long m1_ = mp_[16 + r_]; \
      asm("v_cndmask_b32_e64 %0, %1, %0, %2" : "+v"(P1[r_]) : "v"(NEGV), "s"(m1_)); } } while (0)
  bool resc = false;
  #define START(P0, P1) do { const float rm = rowmax(P0, P1); resc = false; \
    { const float dl = (rm == -INFINITY) ? 0.f : rm; mhat = fadd_s(mhat, dl); \
      _Pragma("unroll") for (int r = 0; r < 16; ++r) { P0[r] = fsub_s(P0[r], dl); P1[r] = fsub_s(P1[r], dl); } \
      _Pragma("unroll") for (int r = 0; r < 16; ++r) negm[r] = -mhat; asm volatile("" : "+v"(negm)); } \
    _Pragma("unroll") for (int r = 0; r < 16; ++r) P0[r] = __builtin_amdgcn_exp2f(P0[r]); } while (0)
  #define RESC() do { if (resc) { asm volatile("s_waitcnt lgkmcnt(0)" ::: "memory"); \
      _Pragma("unroll") for (int d_ = 0; d_ < 2; ++d_) _Pragma("unroll") for (int r = 0; r < 16; ++r) o[d_][r] *= wsf[crow(r, hi)]; } } while (0)
  f32x16 pA0, pA1, pB0, pB1;
  int sl_prev = 0, sl_cur = 0, sl_next = SLOTB;
  #define ROT() do { sl_prev = sl_cur; sl_cur = sl_next; sl_next = (sl_next == (NSLOT - 1) * SLOTB) ? 0 : sl_next + SLOTB; } while (0)
  DMA_K(2, 2 * SLOTB);
  WAIT_BAR(3);
  qkt(pA0, pA1, Kbase, qr, negm, r32, hi); CMASK(pA0, pA1, 0);
  START(pA0, pA1);
  _Pragma("unroll") for (int r = 0; r < 16; ++r) pA1[r] = __builtin_amdgcn_exp2f(pA1[r]);
  WAIT_BAR(0);
  DMA_K(3, 0); DMA_V(1, SLOTB);
  ROT();
  kload8(kf, kp0 + sl_cur);
  WAIT_BAR(2);
  s16x4 vlo[8], vhi[8]; u32x4 pw0, pw1, pw2, pw3;
  #define PKW(P, B) cvtpk_s(P[B], P[B + 1])
  #define PAF(k) __builtin_bit_cast(bf16x8, pw##k)
  #define VFR(i) (bf16x8){vlo[i][0], vlo[i][1], vlo[i][2], vlo[i][3], vhi[i][0], vhi[i][1], vhi[i][2], vhi[i][3]}
  #define PIN(x) asm volatile("" : "+v"(x))
  #define MX3(a, b, c) __builtin_fmaxf(__builtin_fmaxf((a), (b)), (c))
  #define GAPA(MF, A0, A1, A2, A3, W0, W1, PW) do { MF; sacc += A0; sacc += A1; sacc += A2; sacc += A3; PIN(sacc); W0; W1; PIN(PW); SBAR(); } while (0)
  #define EX(v) __builtin_amdgcn_exp2f(v)
  #define GAPB(MF, X, B) do { MF; X[B] = EX(X[B]); X[B + 1] = EX(X[B + 1]); X[B + 2] = EX(X[B + 2]); X[B + 3] = EX(X[B + 3]); PIN(X); SBAR(); } while (0)
  #define VRD(i) do { vlo[i] = vtr(vp_ + (((i) >> 2) * 4096 + ((i) & 3) * 1024)); vhi[i] = vtr(vp_ + (((i) >> 2) * 4096 + ((i) & 3) * 1024 + 512)); } while (0)
  #define KRD(G, j) do { if (G) { kload2(kf, kp0 + sl_next, j); SBAR(); } } while (0)
  #define STEP(C0, C1, P0, P1, t, GK, GV, GL) do { SBAR(); \
    const lds_cptr vp_ = vp0 + sl_prev; \
    VRD(0); SBAR(); float sacc = (P0[0] + P0[1]); \
    GAPA(C0 = __builtin_amdgcn_mfma_f32_32x32x16_bf16(kf[0], qr[0], negm, 0, 0, 0), P0[2], P0[3], P0[4], P0[5],     pw0[0] = PKW(P0, 0), pw0[1] = PKW(P0, 2), pw0); \
    VRD(4); SBAR(); GAPA(C1 = __builtin_amdgcn_mfma_f32_32x32x16_bf16(kf[1], qr[0], negm, 0, 0, 0), P0[6], P0[7], P0[8], P0[9],     pw0[2] = PKW(P0, 4), pw0[3] = PKW(P0, 6), pw0); \
    VRD(1); SBAR(); GAPA(C0 = __builtin_amdgcn_mfma_f32_32x32x16_bf16(kf[2], qr[1], C0, 0, 0, 0),   P0[10], P0[11], P0[12], P0[13], pw1[0] = PKW(P0, 8), pw1[1] = PKW(P0, 10), pw1); \
    VRD(5); SBAR(); GAPA(C1 = __builtin_amdgcn_mfma_f32_32x32x16_bf16(kf[3], qr[1], C1, 0, 0, 0),   P0[14], P0[15], P1[0], P1[1],   pw1[2] = PKW(P0, 12), pw1[3] = PKW(P0, 14), pw1); \
    VRD(2); SBAR(); GAPA(C0 = __builtin_amdgcn_mfma_f32_32x32x16_bf16(kf[4], qr[2], C0, 0, 0, 0),   P1[2], P1[3], P1[4], P1[5],     pw2[0] = PKW(P1, 0), pw2[1] = PKW(P1, 2), pw2); \
    VRD(6); SBAR(); GAPA(C1 = __builtin_amdgcn_mfma_f32_32x32x16_bf16(kf[5], qr[2], C1, 0, 0, 0),   P1[6], P1[7], P1[8], P1[9],     pw2[2] = PKW(P1, 4), pw2[3] = PKW(P1, 6), pw2); \
    VRD(3); SBAR(); GAPA(C0 = __builtin_amdgcn_mfma_f32_32x32x16_bf16(kf[6], qr[3], C0, 0, 0, 0),   P1[10], P1[11], P1[12], P1[13], pw3[0] = PKW(P1, 8), pw3[1] = PKW(P1, 10), pw3); \
    VRD(7); SBAR(); GAPA(C1 = __builtin_amdgcn_mfma_f32_32x32x16_bf16(kf[7], qr[3], C1, 0, 0, 0),   P1[14], P1[15], 0.f, 0.f,       pw3[2] = PKW(P1, 12), pw3[3] = PKW(P1, 14), pw3); \
    l_reg += sacc; \
    if (GK) { DMA_K((t) + 3, sl_cur); } if (GV) { DMA_V((t) + 1, sl_next); } \
    CMASK(C0, C1, t); \
    { float a = MX3(C0[0], C0[1], C1[0]), b = MX3(C0[2], C0[3], C1[1]); a = MX3(a, C1[2], C1[3]); \
      _Pragma("unroll") for (int r = 4; r < 16; r += 4) { a = MX3(a, C0[r], C0[r + 1]); b = MX3(b, C0[r + 2], C0[r + 3]); a = MX3(a, C1[r], C1[r + 1]); b = MX3(b, C1[r + 2], C1[r + 3]); } \
      float rm = __builtin_fmaxf(a, b); { auto rr = __builtin_amdgcn_permlane32_swap(__float_as_uint(rm), __float_as_uint(rm), false, false); rm = __builtin_fmaxf(__uint_as_float(rr[0]), __uint_as_float(rr[1])); } \
      resc = false; \
      if (__builtin_expect(__any(rm > (float)THRL), 0)) { const float dl = __builtin_fmaxf(rm, 0.f); mhat += dl; \
        _Pragma("unroll") for (int r = 0; r < 16; ++r) { C0[r] -= dl; C1[r] -= dl; } \
        _Pragma("unroll") for (int r = 0; r < 16; ++r) negm[r] = -mhat; asm volatile("" : "+v"(negm)); \
        const float f = __builtin_amdgcn_exp2f(-dl); l_reg *= f; if (hi == 0) wsf[r32] = f; resc = true; } } \
    SBAR(); \
    GAPB(o[0] = __builtin_amdgcn_mfma_f32_32x32x16_bf16(PAF(0), VFR(0), o[0], 0, 0, 0), C0, 0); \
    GAPB(o[1] = __builtin_amdgcn_mfma_f32_32x32x16_bf16(PAF(0), VFR(4), o[1], 0, 0, 0), C0, 4); \
    KRD(GL, 0); GAPB(o[0] = __builtin_amdgcn_mfma_f32_32x32x16_bf16(PAF(1), VFR(1), o[0], 0, 0, 0), C0, 8); \
    KRD(GL, 1); GAPB(o[1] = __builtin_amdgcn_mfma_f32_32x32x16_bf16(PAF(1), VFR(5), o[1], 0, 0, 0), C0, 12); \
    KRD(GL, 2); GAPB(o[0] = __builtin_amdgcn_mfma_f32_32x32x16_bf16(PAF(2), VFR(2), o[0], 0, 0, 0), C1, 0); \
    KRD(GL, 3); GAPB(o[1] = __builtin_amdgcn_mfma_f32_32x32x16_bf16(PAF(2), VFR(6), o[1], 0, 0, 0), C1, 4); \
    GAPB(o[0] = __builtin_amdgcn_mfma_f32_32x32x16_bf16(PAF(3), VFR(3), o[0], 0, 0, 0), C1, 8); \
    GAPB(o[1] = __builtin_amdgcn_mfma_f32_32x32x16_bf16(PAF(3), VFR(7), o[1], 0, 0, 0), C1, 12); \
    } while (0)
  int t = 1;
  for (; t + 5 < NT; t += 2) {
    STEP(pB0, pB1, pA0, pA1, t, true, true, true);     WAIT_BAR(2); RESC(); ROT();
    STEP(pA0, pA1, pB0, pB1, t + 1, true, true, true); WAIT_BAR(2); RESC(); ROT();
  }
  #define ENDW(tt) do { if ((tt) + 3 < NT) { WAIT_BAR(2); } else if ((tt) + 2 < NT) { WAIT_BAR(1); } else { WAIT_BAR(0); } } while (0)
  for (; t + 1 < NT; t += 2) {
    STEP(pB0, pB1, pA0, pA1, t, (t + 3 < NT), (t + 1 < NT), (t + 1 < NT));         ENDW(t);     RESC(); ROT();
    STEP(pA0, pA1, pB0, pB1, t + 1, (t + 4 < NT), (t + 2 < NT), (t + 2 < NT));     ENDW(t + 1); RESC(); ROT();
  }
  STEP(pB0, pB1, pA0, pA1, NT - 1, false, false, false); RESC();
  { float sacc = pB0[0] + pB0[1]; _Pragma("unroll") for (int r = 2; r < 16; ++r) sacc += pB0[r]; _Pragma("unroll") for (int r = 0; r < 16; ++r) sacc += pB1[r]; l_reg += sacc;
    pw0 = (u32x4){PKW(pB0, 0), PKW(pB0, 2), PKW(pB0, 4), PKW(pB0, 6)}; pw1 = (u32x4){PKW(pB0, 8), PKW(pB0, 10), PKW(pB0, 12), PKW(pB0, 14)}; pw2 = (u32x4){PKW(pB1, 0), PKW(pB1, 2), PKW(pB1, 4), PKW(pB1, 6)}; pw3 = (u32x4){PKW(pB1, 8), PKW(pB1, 10), PKW(pB1, 12), PKW(pB1, 14)};
    SBAR(); pv(o, vb0 + sl_cur, PAF(0), PAF(1), PAF(2), PAF(3)); }
  #undef PKW
  #undef PAF
  #undef VFR
  #undef PIN
  #undef MX3
  #undef GAPA
  #undef GAPB
  #undef EX
  #undef VRD
  #undef KRD
  #undef STEP
  #undef ENDW
  { auto rr = __builtin_amdgcn_permlane32_swap(__float_as_uint(l_reg), __float_as_uint(l_reg), false, false); l_reg = __uint_as_float(rr[0]) + __uint_as_float(rr[1]); }
  if (hi == 0) wsf[32 + r32] = l_reg; asm volatile("s_waitcnt lgkmcnt(0)" ::: "memory");
  float rli[16];
  #pragma unroll
  for (int r = 0; r < 16; ++r) rli[r] = __builtin_amdgcn_rcpf(wsf[32 + crow(r, hi)]);
  bf16* Ow = O + (rowbase + q0 + wid * QBLK) * ADM + h * D;
  { bf16* stg = (bf16*)(shm + LDS_OST) + wid * 2048;
    #pragma unroll
    for (int r = 0; r < 16; ++r) { const int orow = crow(r, hi);
      #pragma unroll
      for (int d0 = 0; d0 < 2; ++d0) stg[orow * 64 + d0 * 32 + r32] = __float2bfloat16(o[d0][r] * rli[r]); }
    asm volatile("s_waitcnt lgkmcnt(0)" ::: "memory");
    #pragma unroll
    for (int i = 0; i < 4; ++i) { const int row = i * 8 + (lane >> 3), ch = lane & 7; const u32x4 v = *(const u32x4*)(stg + row * 64 + ch * 8); ATTN_STORE16(Ow + (long)row * ADM + ch * 8, v); } }
  asm volatile("s_waitcnt lgkmcnt(0)\n\ts_barrier" ::: "memory");
  #undef DMA_K
  #undef DMA_V
  #undef CMASK
  #undef START
  #undef RESC
  #undef ROT
}
#undef SBAR
#undef WAIT_BAR
}

#define XB_TMO      128
#define XB_XCNT(j)  (256  + 64 * (j))
#define XB_XSUB(j)  (1280 + 64 * (j))
#define XB_XGEN(j)  (2304 + 64 * (j))
#define XB_TOP      3328
#define XB_TOPGEN   3392
#define XCD_BAR_WORDS 3456
#define XB_SPIN_CAP (1u << 18)
__device__ __forceinline__ unsigned xb_ld(unsigned* p)              { return __hip_atomic_load(p, __ATOMIC_RELAXED, __HIP_MEMORY_SCOPE_AGENT); }
__device__ __forceinline__ unsigned xb_add(unsigned* p, unsigned v) { return __hip_atomic_fetch_add(p, v, __ATOMIC_RELAXED, __HIP_MEMORY_SCOPE_AGENT); }
__device__ __forceinline__ unsigned xb_xcc_id() { return (unsigned)__builtin_amdgcn_s_getreg((3 << 11) | 20) & 0xFu; }
#define XB_SPIN(cond, bar) do { unsigned _sp = 0; while (cond) { __builtin_amdgcn_s_sleep(1); \
    if ((++_sp & 255u) == 0u) { if (xb_ld(&(bar)[XB_TMO])) break; if (_sp > XB_SPIN_CAP) { atomicAdd(&(bar)[XB_TMO], 1u); break; } } } } while (0)
struct XcdBarrier { unsigned* bar; unsigned x; volatile LAS unsigned* st; };
__device__ __forceinline__ XcdBarrier xcd_barrier_post(unsigned* bar, volatile LAS unsigned* st) {
    XcdBarrier b; b.bar = bar; b.x = xb_xcc_id(); b.st = st;
    if (threadIdx.x == 0) (void)xb_add(&bar[XB_XCNT(b.x)], 1u);
    return b;
}
__device__ __forceinline__ void xcd_barrier_complete(unsigned* bar, unsigned x, unsigned& nloc, unsigned& nx) {
    const unsigned G = gridDim.x * gridDim.y * gridDim.z;
    unsigned sum, cnt, mine, sp = 0u;
    for (;;) {
        sum = 0u; cnt = 0u; mine = 0u;
#pragma unroll
        for (unsigned j = 0; j < 16; ++j) { const unsigned c = xb_ld(&bar[XB_XCNT(j)]); sum += c; cnt += (c > 0u) ? 1u : 0u; mine = (j == x) ? c : mine; }
        if (sum == G) break;
        __builtin_amdgcn_s_sleep(1);
        if ((++sp & 255u) == 0u) { if (xb_ld(&bar[XB_TMO])) break; if (sp > XB_SPIN_CAP) { atomicAdd(&bar[XB_TMO], 1u); break; } }
    }
    nloc = mine > 0u ? mine : 1u; nx = cnt > 0u ? cnt : 1u;
}
__device__ __forceinline__ void xcd_barrier(const XcdBarrier& b) {
    asm volatile("s_waitcnt vmcnt(0)" ::: "memory");
    __syncthreads();
    if (threadIdx.x == 0) {
        unsigned* bar = b.bar;
        __builtin_amdgcn_s_waitcnt(0);
        unsigned nloc = b.st[0], nx = b.st[1];
        if (nloc == 0u) { xcd_barrier_complete(bar, b.x, nloc, nx); b.st[0] = nloc; b.st[1] = nx; }
#ifdef DBG_WG_RELEASE
        __builtin_amdgcn_fence(__ATOMIC_RELEASE, "agent"); asm volatile("s_waitcnt vmcnt(0)" ::: "memory");
#endif
        const unsigned old = xb_add(&bar[XB_XSUB(b.x)], 1u);
        const unsigned gen = old / nloc;
        if (old + 1u == (gen + 1u) * nloc) {
            __builtin_amdgcn_fence(__ATOMIC_RELEASE, "agent");
            asm volatile("s_waitcnt vmcnt(0)" ::: "memory");
            const unsigned og = xb_add(&bar[XB_TOP], 1u);
            const unsigned tg = og / nx;
            if (og + 1u == (tg + 1u) * nx) xb_add(&bar[XB_TOPGEN], 1u);
            else XB_SPIN(xb_ld(&bar[XB_TOPGEN]) == tg, bar);
            __builtin_amdgcn_fence(__ATOMIC_ACQUIRE, "agent");
            xb_add(&bar[XB_XGEN(b.x)], 1u);
            asm volatile("s_waitcnt vmcnt(0)" ::: "memory");
        } else {
            XB_SPIN(xb_ld(&bar[XB_XGEN(b.x)]) == gen, bar);
            __builtin_amdgcn_fence(__ATOMIC_ACQUIRE, "agent");
            asm volatile("s_waitcnt vmcnt(0)" ::: "memory");
        }
    }
    __syncthreads();
}

struct Frame {
    LAS unsigned char* lds; volatile LAS unsigned* MISC; unsigned* ctl; unsigned char* ws;
    int tid, lane, wave, vcu, G;
    const float* const* in; float* out;
};
constexpr int NWAVES = 8;

__device__ __forceinline__ void transpose_item(const float* W, int ldw, bf16_t* WT, int K, LAS float* scr, int k0, int n0, int src, int lane, int dk0 = 0) {
#pragma unroll 8
    for (int i = 0; i < 32; ++i) { const int kk = 2 * i + (lane >> 5); scr[kk * 33 + (lane & 31)] = (src >= 0) ? W[(size_t)(k0 + kk) * ldw + src] : 0.f; }
    LDS_WAIT(); asm volatile("" ::: "memory");
    const int c = lane & 7;
#pragma unroll
    for (int j = 0; j < 4; ++j) { const int n = (lane >> 3) + 8 * j; const LAS float* s = scr + (8 * c) * 33 + n;
        u32x4 o; o.x = cvt_pk_bf16(s[0 * 33], s[1 * 33]); o.y = cvt_pk_bf16(s[2 * 33], s[3 * 33]); o.z = cvt_pk_bf16(s[4 * 33], s[5 * 33]); o.w = cvt_pk_bf16(s[6 * 33], s[7 * 33]);
        *(u32x4*)(WT + (size_t)(n0 + n) * K + dk0 + k0 + 8 * c) = o; }
    LDS_WAIT(); asm volatile("" ::: "memory");
}
__device__ __forceinline__ int rope_perm(int p) { return (p < 16) ? ((p >> 1) + 8 * (p & 1)) : p; }
__device__ __forceinline__ int w1_src(int n) {
    if (n < 2048) { const int seg = n >> 9, o = n & 511, h = o >> 6; int p = o & 63; if (seg != 2) p = rope_perm(p); return seg * 512 + h * 64 + p; }
    if (n < 2304) return 2120 + (n - 2048);
    if (n < 2560) return 2376 + (n - 2304);
    const int o = n - 2560;
    if (o < 64) return 2048 + rope_perm(o);
    if (o < 72) return 2112 + (o - 64);
    return -1;
}
__device__ __forceinline__ void rms_row_to_bf16(const float* xrow, const float* g, bf16_t* orow, int lane) {
    const f32x4* xr = (const f32x4*)xrow + lane; const f32x4* gr = (const f32x4*)g + lane;
    f32x4 v[4]; float s = 0.f;
#pragma unroll
    for (int j = 0; j < 4; ++j) { v[j] = xr[64 * j]; s += (v[j].x * v[j].x + v[j].y * v[j].y) + (v[j].z * v[j].z + v[j].w * v[j].w); }
    const float rstd = 1.f / sqrtf(wave_sum(s) * (1.f / 1024.f) + EPS);
    u32x2* o8 = (u32x2*)orow + lane;
#pragma unroll
    for (int j = 0; j < 4; ++j) { const f32x4 gg = gr[64 * j]; u32x2 w; w.x = cvt_pk_bf16(v[j].x * rstd * gg.x, v[j].y * rstd * gg.y); w.y = cvt_pk_bf16(v[j].z * rstd * gg.z, v[j].w * rstd * gg.w); o8[64 * j] = w; }
}
__device__ __forceinline__ void p0_prologue(Frame& F) {
    LAS float* scr = (LAS float*)(F.lds + F.wave * 16384);
    const int gw = F.vcu * NWAVES + F.wave, NGW = F.G * NWAVES, lane = F.lane;
    unsigned char* ws = F.ws;
    constexpr int I_UP = 32 * 16 * 64, I_DN = 32 * 16 * 32, I_IN = 16 * 88, I_GT = 16 * 96, I_PA = 8 * 32, I_PP = 4 * 32, I_PM = 4 * 32, I_OUT = 16 * 32, I_KV = 16 * 16;
    constexpr int NITEMS = I_UP + I_DN + I_IN + I_GT + I_PA + I_PP + I_PM + I_OUT + I_KV;
    for (int it = gw; it < NITEMS; it += NGW) {
        int r = it;
        if (r < I_UP) { const int e = r >> 10, q = r & 1023, kb = q >> 6, nb = q & 63, n = nb * 32 + (lane & 31), tile = n >> 8, o = n & 255;
            const int src = (o < 128) ? tile * 128 + o : 1024 + tile * 128 + (o - 128);
            transpose_item(F.in[17] + (size_t)e * 1024 * 2048, 2048, (bf16_t*)(ws + WS_WUP) + (size_t)e * 2048 * 1024, 1024, scr, kb * 64, nb * 32, src, lane); continue; } r -= I_UP;
        if (r < I_DN) { const int e = r >> 9, q = r & 511, kb = q >> 5, nb = q & 31;
            transpose_item(F.in[19] + (size_t)e * 1024 * 1024, 1024, (bf16_t*)(ws + WS_WDN) + (size_t)e * 1024 * 1024, 1024, scr, kb * 64, nb * 32, nb * 32 + (lane & 31), lane); continue; } r -= I_DN;
        if (r < I_IN) { const int kb = r / 88, nb = r % 88;
            transpose_item(F.in[3], 2632, (bf16_t*)(ws + WS_W1T), 1024, scr, kb * 64, nb * 32, w1_src(nb * 32 + (lane & 31)), lane); continue; } r -= I_IN;
        if (r < I_GT) { const int kb = r / 96, nb = r % 96;
            transpose_item(F.in[4], 3072, (bf16_t*)(ws + WS_W1T) + (size_t)N1_IN * 1024, 1024, scr, kb * 64, nb * 32, nb * 32 + (lane & 31), lane); continue; } r -= I_GT;
        if (r < I_PA) { const int kb = r >> 5, nb = r & 31;
            transpose_item(F.in[6], 1024, (bf16_t*)(ws + WS_WPA), 512, scr, kb * 64, nb * 32, nb * 32 + (lane & 31), lane); continue; } r -= I_PA;
        if (r < I_PP) { const int kb = r >> 5, nb = r & 31;
            transpose_item(F.in[7], 1024, (bf16_t*)(ws + WS_WPP), 256, scr, kb * 64, nb * 32, nb * 32 + (lane & 31), lane); continue; } r -= I_PP;
        if (r < I_PM) { const int kb = r >> 5, nb = r & 31;
            transpose_item(F.in[8], 1024, (bf16_t*)(ws + WS_WPM), 256, scr, kb * 64, nb * 32, nb * 32 + (lane & 31), lane); continue; } r -= I_PM;
        if (r < I_OUT) { const int kb = r >> 5, nb = r & 31;
            transpose_item(F.in[13], 1024, (bf16_t*)(ws + WS_WOUT), 1024, scr, kb * 64, nb * 32, nb * 32 + (lane & 31), lane); continue; } r -= I_OUT;
        { const int kb = r >> 4, nb = r & 15;
            transpose_item(F.in[12], 512, (bf16_t*)(ws + WS_WKV), 1024, scr, kb * 64, nb * 32, nb * 32 + (lane & 31), lane); }
    }
    for (int m = gw; m < NTOK; m += NGW) rms_row_to_bf16(F.in[0] + (size_t)m * 1024, F.in[2], (bf16_t*)(ws + WS_XN) + (size_t)m * 1024, lane);
    for (int m = gw; m < NB * 256; m += NGW) rms_row_to_bf16(F.in[1] + (size_t)m * 1024, F.in[11], (bf16_t*)(ws + WS_MEMN) + (size_t)m * 1024, lane);
    const int gt = gw * 64 + lane, NGT = NGW * 64;
    for (int i = gt; i < SEQ * 8; i += NGT) { const int pos = i >> 3, j = i & 7; const float inv = powf(500000.0f, -(float)j / 8.0f); const float ang = (float)pos * inv; float s, c; sincosf(ang, &s, &c);
        ((f32x2*)(ws + WS_ROPE))[i] = (f32x2){c, s}; }
    for (int i = gt; i < 4 * 64 * 64; i += NGT) { const int g = i >> 12, d = (i >> 6) & 63, c = i & 63;
        ((bf16_t*)(ws + WS_WGT))[i] = (bf16_t)(cvt_pk_bf16(F.in[9][(g * 64 + c) * 64 + d], 0.f) & 0xffffu); }
    for (int i = gt; i < 32 * 1024; i += NGT) { const int e = i >> 10, k = i & 1023; const float w = F.in[14][k] * F.in[15][k * 32 + e];
        const unsigned hb = cvt_pk_bf16(w, 0.f) & 0xffffu; const float lo = w - bf2f((unsigned short)hb);
        ((bf16_t*)(ws + WS_WRH))[i] = (bf16_t)hb; ((bf16_t*)(ws + WS_WRL))[i] = (bf16_t)(cvt_pk_bf16(lo, 0.f) & 0xffffu); }
}

constexpr int SCS = 4112;
constexpr int SEL_MW_OFF = 8 * SCS * 4;
__device__ __forceinline__ unsigned sortable(float s) { const unsigned u = __builtin_bit_cast(unsigned, s); return (u & 0x80000000u) ? ~u : (u | 0x80000000u); }
__device__ __forceinline__ void p2_select(Frame& F) {
    LAS float* SC = (LAS float*)F.lds;
    LAS unsigned long long* MW = (LAS unsigned long long*)(F.lds + SEL_MW_OFF);
    const unsigned short* IQ = (const unsigned short*)(F.ws + WS_IQ); const unsigned short* IK = (const unsigned short*)(F.ws + WS_IK); const float* IW = (const float*)(F.ws + WS_IW);
    unsigned long long* MT = (unsigned long long*)(F.ws + WS_MASKT);
    const int lane = F.lane, wave = F.wave, r = lane & 31, hi = lane >> 5;
    for (int item = F.vcu; item < 256; item += F.G) {
    const int b = item >> 6, jj = item & 63;
    for (int half = 0; half < 2; ++half) {
        const int sg = half ? 127 - jj : jj;
        for (int sub = 0; sub < 4; ++sub) {
            const int t0 = sg * 32 + sub * 8;
            const int KT = (t0 + 8 + 31) >> 5;
            {
                half8 af[2][4]; f32x4 wv[2][4];
                const int ql = 2 * ((r >> 2) & 1) + (r >> 4), head = (r & 3) + 4 * ((r >> 3) & 1);
#pragma unroll
                for (int rt = 0; rt < 2; ++rt) { const size_t qrow = (size_t)b * SEQ + t0 + 4 * rt + ql;
#pragma unroll
                    for (int kk = 0; kk < 4; ++kk) af[rt][kk] = *(const half8*)(IQ + qrow * 512 + head * 64 + 16 * kk + 8 * hi);
                    const float* wp = IW + ((size_t)b * SEQ + t0 + 4 * rt + 2 * hi) * 8;
#pragma unroll
                    for (int i = 0; i < 4; ++i) wv[rt][i] = *(const f32x4*)(wp + 4 * i); }
                half8 bnx[4];
                { const unsigned short* kp = IK + ((size_t)b * SEQ + 32 * wave + r) * 64 + 8 * hi;
#pragma unroll
                    for (int kk = 0; kk < 4; ++kk) bnx[kk] = *(const half8*)(kp + 16 * kk); }
                for (int tile = wave; tile < KT; tile += 8) {
                    const int key = 32 * tile + r;
                    half8 bfr[4];
#pragma unroll
                    for (int kk = 0; kk < 4; ++kk) bfr[kk] = bnx[kk];
                    if (tile + 8 < KT) { const unsigned short* kp = IK + ((size_t)b * SEQ + key + 256) * 64 + 8 * hi;
#pragma unroll
                        for (int kk = 0; kk < 4; ++kk) bnx[kk] = *(const half8*)(kp + 16 * kk); }
#pragma unroll
                    for (int rt = 0; rt < 2; ++rt) { f32x16 acc = f32x16{};
#pragma unroll
                        for (int kk = 0; kk < 4; ++kk) acc = __builtin_amdgcn_mfma_f32_32x32x16_f16(af[rt][kk], bfr[kk], acc, 0, 0, 0);
                        float s0 = 0.f, s1 = 0.f;
#pragma unroll
                        for (int g = 0; g < 8; ++g) { s0 += wv[rt][g >> 2][g & 3] * fmaxf(acc[g], 0.f); s1 += wv[rt][2 + (g >> 2)][g & 3] * fmaxf(acc[8 + g], 0.f); }
                        SC[(4 * rt + 2 * hi) * SCS + key] = s0; SC[(4 * rt + 2 * hi + 1) * SCS + key] = s1; }
                }
            }
            __syncthreads();
            {
                const int t = t0 + wave; const int R = (t >> 6) + 1;
                unsigned key[64];
#pragma unroll
                for (int blk = 0; blk < 8; ++blk) {
                    if (blk * 8 < R) {
#pragma unroll
                        for (int i = 0; i < 8; ++i) { const int rr = blk * 8 + i, kidx = rr * 64 + lane; const float s = SC[wave * SCS + kidx]; key[rr] = (kidx <= t) ? sortable(s) : 0u; }
                    } else {
#pragma unroll
                        for (int i = 0; i < 8; ++i) key[blk * 8 + i] = 0u;
                    }
                }
                LAS unsigned long long* mwq = MW + (sub * 8 + wave) * 64;
                if (t + 1 <= 256) {
#pragma unroll
                    for (int rr = 0; rr < 64; ++rr) { const int rem = t + 1 - rr * 64; const unsigned long long w = rem >= 64 ? ~0ull : (rem <= 0 ? 0ull : ((1ull << rem) - 1ull));
                        if (lane == 0) mwq[rr] = w; }
                } else {
                    unsigned prefix = 0u; bool exact = false;
                    for (int bit = 31; bit >= 0; --bit) {
                        const unsigned cand = prefix | (1u << bit); int cnt = 0;
#pragma unroll
                        for (int blk = 0; blk < 8; ++blk) if (blk * 8 < R) {
#pragma unroll
                            for (int i = 0; i < 8; ++i) cnt += __builtin_popcountll(__ballot(key[blk * 8 + i] >= cand)); __builtin_amdgcn_sched_barrier(0); }
                        if (cnt >= 256) { prefix = cand; if (cnt == 256) { exact = true; break; } }
                    }
                    prefix = __builtin_amdgcn_readfirstlane(prefix); asm volatile("" : "+s"(prefix));
                    if (exact) {
#pragma unroll
                        for (int rr = 0; rr < 64; ++rr) { const unsigned long long w = __ballot(key[rr] >= prefix);
                            if (lane == 0) mwq[rr] = w; if ((rr & 3) == 3) __builtin_amdgcn_sched_barrier(0); }
                    } else {
                        int cgt = 0;
#pragma unroll
                        for (int rr = 0; rr < 64; ++rr) { cgt += __builtin_popcountll(__ballot(key[rr] > prefix)); if ((rr & 7) == 7) __builtin_amdgcn_sched_barrier(0); }
                        int need = 256 - cgt;
                        unsigned p2 = __builtin_amdgcn_readfirstlane(prefix); asm volatile("" : "+s"(p2));
#pragma unroll
                        for (int rr = 0; rr < 64; ++rr) { const unsigned long long gt = __ballot(key[rr] > p2); unsigned long long eq = __ballot(key[rr] == p2); unsigned long long take = 0ull;
                            const int pe = __builtin_popcountll(eq);
                            if (pe <= need) { take = eq; need -= pe; } else { while (need > 0) { const unsigned long long low = eq & (0ull - eq); take |= low; eq ^= low; --need; } }
                            const unsigned long long w = gt | take;
                            if (lane == 0) mwq[rr] = w; __builtin_amdgcn_sched_barrier(0); }
                    }
                }
            }
            __syncthreads();
        }
        {
#ifdef DBG_LAST
            const int NT64 = 64;
#else
            const int NT64 = 4 * (sg >> 3) + 4;
#endif
            for (int T = wave; T < NT64; T += 8) {
                const unsigned long long w = MW[r * 64 + T] >> (4 * hi);
                const unsigned lo = (unsigned)w, hi32 = (unsigned)(w >> 32);
                unsigned long long* mto = MT + ((size_t)(b * 128 + sg) * 64 + T) * 32;
#pragma unroll
                for (int i = 0; i < 32; ++i) { const int r16 = i & 15, bitc = (r16 & 3) + 8 * (r16 >> 2); const unsigned src = (i >> 4) ? hi32 : lo;
                    const unsigned long long bal = __ballot(((src >> bitc) & 1u) != 0u);
                    if (lane == 0) mto[i] = bal; if ((i & 3) == 3) __builtin_amdgcn_sched_barrier(0); }
            }
        }
        __syncthreads();
    }
    }
}

__device__ __forceinline__ void p2_pool_unit(Frame& F, int tb, int g) {
    const bf16_t* U = (const bf16_t*)(F.ws + WS_U); const bf16_t* WGT = (const bf16_t*)(F.ws + WS_WGT); bf16_t* YP = (bf16_t*)(F.ws + WS_YPOOL);
    const int lane = F.lane, r = lane & 31, hi = lane >> 5;
    const int tok = tb * 32 + r, t = tok & (SEQ - 1), w = 2 << g, cnt = (t + 1 < w) ? t + 1 : w;
    const float inv = 1.f / (float)cnt;
    f32x16 acc[2]; acc[0] = f32x16{}; acc[1] = f32x16{};
#pragma unroll
    for (int kk = 0; kk < 4; ++kk) {
        const int c0 = g * 64 + 16 * kk + 8 * hi;
        float s[8], own[8];
#pragma unroll
        for (int j = 0; j < 8; ++j) s[j] = 0.f;
        for (int i = 0; i < w; ++i) {
            if (i < cnt) { const u32x4 v = *(const u32x4*)(U + (size_t)(tok - i) * 256 + c0);
                const float f[8] = {bflo(v.x), bfhi(v.x), bflo(v.y), bfhi(v.y), bflo(v.z), bfhi(v.z), bflo(v.w), bfhi(v.w)};
#pragma unroll
                for (int j = 0; j < 8; ++j) { s[j] += f[j]; if (i == 0) own[j] = f[j]; } }
        }
        u32x4 pb; pb.x = cvt_pk_bf16(s[0] * inv - own[0], s[1] * inv - own[1]); pb.y = cvt_pk_bf16(s[2] * inv - own[2], s[3] * inv - own[3]);
        pb.z = cvt_pk_bf16(s[4] * inv - own[4], s[5] * inv - own[5]); pb.w = cvt_pk_bf16(s[6] * inv - own[6], s[7] * inv - own[7]);
#pragma unroll
        for (int dh = 0; dh < 2; ++dh) { const bf16x8 a = *(const bf16x8*)(WGT + ((size_t)(g * 64 + 32 * dh + r)) * 64 + 16 * kk + 8 * hi);
            acc[dh] = __builtin_amdgcn_mfma_f32_32x32x16_bf16(a, __builtin_bit_cast(bf16x8, pb), acc[dh], 0, 0, 0); }
    }
    const float* sc = F.in[10];
#pragma unroll
    for (int dh = 0; dh < 2; ++dh)
#pragma unroll
        for (int q4 = 0; q4 < 4; ++q4) { const int d = g * 64 + 32 * dh + 8 * q4 + 4 * hi; const f32x4 s4 = *(const f32x4*)(sc + d);
            u32x2 o; o.x = cvt_pk_bf16(acc[dh][4 * q4] * s4[0], acc[dh][4 * q4 + 1] * s4[1]); o.y = cvt_pk_bf16(acc[dh][4 * q4 + 2] * s4[2], acc[dh][4 * q4 + 3] * s4[3]);
            *(u32x2*)(YP + (size_t)tok * 256 + d) = o; }
}
__device__ __forceinline__ void p2_mem_unit(Frame& F, int tb, int hm) {
    const bf16_t* QM = (const bf16_t*)(F.ws + WS_QM); const bf16_t* KM = (const bf16_t*)(F.ws + WS_KM); const bf16_t* VMT = (const bf16_t*)(F.ws + WS_VMT); bf16_t* YM = (bf16_t*)(F.ws + WS_YMEM);
    const int lane = F.lane, r = lane & 31, hi = lane >> 5;
    const int tok = tb * 32 + r, b = tok >> 12;
    bf16x8 qf[4];
#pragma unroll
    for (int kk = 0; kk < 4; ++kk) qf[kk] = *(const bf16x8*)(QM + (size_t)tok * 256 + hm * 64 + 16 * kk + 8 * hi);
    f32x16 sc[8];
#pragma unroll
    for (int kb = 0; kb < 8; ++kb) { sc[kb] = f32x16{};
#pragma unroll
        for (int kk = 0; kk < 4; ++kk) { const bf16x8 a = *(const bf16x8*)(KM + (size_t)(b * 256 + kb * 32 + r) * 256 + hm * 64 + 16 * kk + 8 * hi);
            sc[kb] = __builtin_amdgcn_mfma_f32_32x32x16_bf16(a, qf[kk], sc[kb], 0, 0, 0); } }
    float mx = -INFINITY;
#pragma unroll
    for (int kb = 0; kb < 8; ++kb)
#pragma unroll
        for (int i = 0; i < 16; ++i) mx = fmaxf(mx, sc[kb][i]);
    mx = fmaxf(mx, __shfl_xor(mx, 32));
    float l = 0.f;
#pragma unroll
    for (int kb = 0; kb < 8; ++kb)
#pragma unroll
        for (int i = 0; i < 16; ++i) { const float p = __builtin_amdgcn_exp2f(sc[kb][i] - mx); sc[kb][i] = p; l += p; }
    l += __shfl_xor(l, 32);
    f32x16 o[2]; o[0] = f32x16{}; o[1] = f32x16{};
    const bf16_t* vb = VMT + (size_t)(b * 4 + hm) * 64 * 256;
#pragma unroll
    for (int kb = 0; kb < 8; ++kb)
#pragma unroll
        for (int s = 0; s < 2; ++s) {
            u32x4 pw; pw.x = cvt_pk_bf16(sc[kb][8 * s], sc[kb][8 * s + 1]); pw.y = cvt_pk_bf16(sc[kb][8 * s + 2], sc[kb][8 * s + 3]); pw.z = cvt_pk_bf16(sc[kb][8 * s + 4], sc[kb][8 * s + 5]); pw.w = cvt_pk_bf16(sc[kb][8 * s + 6], sc[kb][8 * s + 7]);
#pragma unroll
            for (int dh = 0; dh < 2; ++dh) {
                const bf16_t* vp = vb + (size_t)(32 * dh + r) * 256 + 32 * kb + 16 * s + 4 * hi;
                const u32x2 a0 = *(const u32x2*)vp, a1 = *(const u32x2*)(vp + 8);
                const u32x4 av = (u32x4){a0.x, a0.y, a1.x, a1.y};
                o[dh] = __builtin_amdgcn_mfma_f32_32x32x16_bf16(__builtin_bit_cast(bf16x8, av), __builtin_bit_cast(bf16x8, pw), o[dh], 0, 0, 0); }
            __builtin_amdgcn_sched_barrier(0);
        }
    const float il = 1.f / l;
#pragma unroll
    for (int dh = 0; dh < 2; ++dh)
#pragma unroll
        for (int q4 = 0; q4 < 4; ++q4) { const int d = hm * 64 + 32 * dh + 8 * q4 + 4 * hi;
            u32x2 ov; ov.x = cvt_pk_bf16(o[dh][4 * q4] * il, o[dh][4 * q4 + 1] * il); ov.y = cvt_pk_bf16(o[dh][4 * q4 + 2] * il, o[dh][4 * q4 + 3] * il);
            *(u32x2*)(YM + (size_t)tok * 256 + d) = ov; }
}

__device__ __forceinline__ void p6_router(Frame& F) {
    const float* H1 = F.out; const bf16_t* WRH = (const bf16_t*)(F.ws + WS_WRH); const bf16_t* WRL = (const bf16_t*)(F.ws + WS_WRL);
    int* RE = (int*)(F.ws + WS_RE); int* RR = (int*)(F.ws + WS_RR); float* RG = (float*)(F.ws + WS_RG); float* RSTD = (float*)(F.ws + WS_RSTD);
    LAS float* RED = (LAS float*)F.lds;
    LAS float* SSQ = (LAS float*)(F.lds + 2 * 4 * 32 * 33 * 4);
    const int lane = F.lane, wave = F.wave, r = lane & 31, hi = lane >> 5, tblk = wave >> 2, kq = wave & 3;
    for (int item = F.vcu; item < NTOK / 64; item += F.G) {
        const int tok = item * 64 + tblk * 32 + r;
        f32x16 acc = f32x16{}; float ssq = 0.f;
        const float* hp = H1 + (size_t)tok * 1024 + 256 * kq + 8 * hi;
        const bf16_t* ah = WRH + (size_t)r * 1024 + 256 * kq + 8 * hi; const bf16_t* al = WRL + (size_t)r * 1024 + 256 * kq + 8 * hi;
#pragma unroll 4
        for (int ks = 0; ks < 16; ++ks) {
            const f32x4 x0 = *(const f32x4*)(hp + 16 * ks), x1 = *(const f32x4*)(hp + 16 * ks + 4);
            ssq += (x0[0] * x0[0] + x0[1] * x0[1]) + (x0[2] * x0[2] + x0[3] * x0[3]) + (x1[0] * x1[0] + x1[1] * x1[1]) + (x1[2] * x1[2] + x1[3] * x1[3]);
            u32x4 bh; bh.x = cvt_pk_bf16_s(x0[0], x0[1]); bh.y = cvt_pk_bf16_s(x0[2], x0[3]); bh.z = cvt_pk_bf16_s(x1[0], x1[1]); bh.w = cvt_pk_bf16_s(x1[2], x1[3]);
            u32x4 bl; bl.x = cvt_pk_bf16_s(x0[0] - bflo(bh.x), x0[1] - bfhi(bh.x)); bl.y = cvt_pk_bf16_s(x0[2] - bflo(bh.y), x0[3] - bfhi(bh.y));
            bl.z = cvt_pk_bf16_s(x1[0] - bflo(bh.z), x1[1] - bfhi(bh.z)); bl.w = cvt_pk_bf16_s(x1[2] - bflo(bh.w), x1[3] - bfhi(bh.w));
            const bf16x8 Ah = *(const bf16x8*)(ah + 16 * ks), Al = *(const bf16x8*)(al + 16 * ks);
            acc = __builtin_amdgcn_mfma_f32_32x32x16_bf16(Ah, __builtin_bit_cast(bf16x8, bh), acc, 0, 0, 0);
            acc = __builtin_amdgcn_mfma_f32_32x32x16_bf16(Ah, __builtin_bit_cast(bf16x8, bl), acc, 0, 0, 0);
            acc = __builtin_amdgcn_mfma_f32_32x32x16_bf16(Al, __builtin_bit_cast(bf16x8, bh), acc, 0, 0, 0);
        }
#pragma unroll
        for (int g = 0; g < 16; ++g) RED[((tblk * 4 + kq) * 32 + attn_body::crow(g, hi)) * 33 + r] = acc[g];
        SSQ[(tblk * 4 + kq) * 64 + lane] = ssq;
        __syncthreads();
        if (F.tid < 64) {
            const int tb2 = F.tid >> 5, rr = F.tid & 31, tk = item * 64 + F.tid;
            float sq = 0.f;
#pragma unroll
            for (int q = 0; q < 4; ++q) sq += SSQ[(tb2 * 4 + q) * 64 + rr] + SSQ[(tb2 * 4 + q) * 64 + 32 + rr];
            const float rstd = 1.f / sqrtf(sq * (1.f / 1024.f) + EPS);
            float lg[32];
#pragma unroll
            for (int e = 0; e < 32; ++e) { float s = 0.f;
#pragma unroll
                for (int q = 0; q < 4; ++q) s += RED[((tb2 * 4 + q) * 32 + e) * 33 + rr];
                lg[e] = s * rstd + F.in[16][e]; }
            float tv[4]; int ti[4];
#pragma unroll
            for (int p = 0; p < 4; ++p) { float best = -INFINITY; int bi = 0;
#pragma unroll
                for (int e = 0; e < 32; ++e) if (lg[e] > best) { best = lg[e]; bi = e; }
                tv[p] = best; ti[p] = bi;
#pragma unroll
                for (int e = 0; e < 32; ++e) lg[e] = (e == bi) ? -INFINITY : lg[e]; }
            float ex[4], den = 0.f;
#pragma unroll
            for (int p = 0; p < 4; ++p) { ex[p] = __expf(tv[p] - tv[0]); den += ex[p]; }
            const float id = 1.f / den;
#pragma unroll
            for (int p = 0; p < 4; ++p) { const int rank = (int)__hip_atomic_fetch_add(F.ctl + CW_CNT + 64 * ti[p], 1u, __ATOMIC_RELAXED, __HIP_MEMORY_SCOPE_AGENT);
                RE[tk * 4 + p] = ti[p]; RR[tk * 4 + p] = rank; RG[tk * 4 + p] = ex[p] * id; }
            RSTD[tk] = rstd;
        }
        __syncthreads();
    }
}
__device__ __forceinline__ int moe_row_offset(Frame& F) {
    const int lane = F.lane; const unsigned c = (lane < 32) ? __hip_atomic_load(F.ctl + CW_CNT + 64 * lane, __ATOMIC_RELAXED, __HIP_MEMORY_SCOPE_AGENT) : 0u;
    const int pad = (int)((c + 255u) & ~255u); int inc = pad;
#pragma unroll
    for (int o = 1; o < 32; o <<= 1) { const int v = __shfl_up(inc, o); if ((lane & 31) >= o) inc += v; }
    return inc - pad;
}
__device__ __forceinline__ void p7_scatter(Frame& F) {
    const float* H1 = F.out; const int* RE = (const int*)(F.ws + WS_RE); const int* RR = (const int*)(F.ws + WS_RR); const float* RSTD = (const float*)(F.ws + WS_RSTD);
    int* SLOT = (int*)(F.ws + WS_SLOT); bf16_t* XG = (bf16_t*)(F.ws + WS_XG);
    const int lane = F.lane, gw = F.vcu * NWAVES + F.wave, NGW = F.G * NWAVES;
    const int off = moe_row_offset(F);
    const f32x4* gr = (const f32x4*)F.in[14] + lane;
    f32x4 gg[4];
#pragma unroll
    for (int j = 0; j < 4; ++j) gg[j] = gr[64 * j];
    for (int tok = gw; tok < NTOK; tok += NGW) {
        const float rstd = RSTD[tok];
        const f32x4* xr = (const f32x4*)(H1 + (size_t)tok * 1024) + lane;
        u32x2 w[4];
#pragma unroll
        for (int j = 0; j < 4; ++j) { const f32x4 v = xr[64 * j]; w[j].x = cvt_pk_bf16(v.x * rstd * gg[j].x, v.y * rstd * gg[j].y); w[j].y = cvt_pk_bf16(v.z * rstd * gg[j].z, v.w * rstd * gg[j].w); }
#pragma unroll
        for (int p = 0; p < 4; ++p) { const int e = RE[tok * 4 + p], rk = RR[tok * 4 + p]; const int slot = __shfl(off, e) + rk;
            u32x2* o8 = (u32x2*)(XG + (size_t)slot * 1024) + lane;
#pragma unroll
            for (int j = 0; j < 4; ++j) o8[64 * j] = w[j];
            if (lane == 0) SLOT[tok * 4 + p] = slot; }
    }
}
__device__ __forceinline__ void moe_tile_table(Frame& F) {
    if (F.wave == 0) { const int off = moe_row_offset(F); const unsigned c = (F.lane < 32) ? __hip_atomic_load(F.ctl + CW_CNT + 64 * F.lane, __ATOMIC_RELAXED, __HIP_MEMORY_SCOPE_AGENT) : 0u;
        if (F.lane < 32) F.MISC[32 + F.lane] = (unsigned)(off >> 8);
        if (F.lane == 31) F.MISC[64] = (unsigned)((off >> 8) + (int)((c + 255u) >> 8)); }
    __syncthreads();
}
__device__ __forceinline__ void p10_final(Frame& F) {
    float* H1 = F.out; const int* SLOT = (const int*)(F.ws + WS_SLOT); const float* RG = (const float*)(F.ws + WS_RG); const bf16_t* Y = (const bf16_t*)(F.ws + WS_XG);
    const int lane = F.lane, gw = F.vcu * NWAVES + F.wave, NGW = F.G * NWAVES;
    const f32x4* gr = (const f32x4*)F.in[21] + lane;
    f32x4 gg[4];
#pragma unroll
    for (int j = 0; j < 4; ++j) gg[j] = gr[64 * j];
    for (int tok = gw; tok < NTOK; tok += NGW) {
        f32x4* xr = (f32x4*)(H1 + (size_t)tok * 1024) + lane;
        f32x4 v[4];
#pragma unroll
        for (int j = 0; j < 4; ++j) v[j] = xr[64 * j];
#pragma unroll
        for (int p = 0; p < 4; ++p) { const int slot = SLOT[tok * 4 + p]; const float gate = RG[tok * 4 + p];
            const u32x2* yr = (const u32x2*)(Y + (size_t)slot * 1024) + lane;
#pragma unroll
            for (int j = 0; j < 4; ++j) { const u32x2 y = yr[64 * j]; v[j].x += gate * bflo(y.x); v[j].y += gate * bfhi(y.x); v[j].z += gate * bflo(y.y); v[j].w += gate * bfhi(y.y); } }
        float s = 0.f;
#pragma unroll
        for (int j = 0; j < 4; ++j) s += (v[j].x * v[j].x + v[j].y * v[j].y) + (v[j].z * v[j].z + v[j].w * v[j].w);
        const float rstd = 1.f / sqrtf(wave_sum(s) * (1.f / 1024.f) + EPS);
#pragma unroll
        for (int j = 0; j < 4; ++j) xr[64 * j] = (f32x4){v[j].x * rstd * gg[j].x, v[j].y * rstd * gg[j].y, v[j].z * rstd * gg[j].z, v[j].w * rstd * gg[j].w};
    }
}

#ifndef MK_N_LAUNCHES
#define MK_N_LAUNCHES 1
#endif
constexpr int N_PHASES = 11;
constexpr int N_LAUNCHES = MK_N_LAUNCHES;
struct Args { const float* in[22]; float* out; unsigned char* ws; int ph_lo, ph_hi, li, pad; };
__global__ void __launch_bounds__(NWAVES * 64, 2) fwd_kernel(Args args) {
    extern __shared__ __attribute__((aligned(16))) unsigned char lds[];
    Frame F;
    F.lds = (LAS unsigned char*)lds; F.MISC = (volatile LAS unsigned*)(F.lds + MISC_OFF);
    F.tid = threadIdx.x; F.lane = F.tid & 63; F.wave = __builtin_amdgcn_readfirstlane(F.tid >> 6);
    F.G = gridDim.x; { const int bx = blockIdx.x; F.vcu = (F.G % 8 == 0) ? (bx % 8) * (F.G / 8) + bx / 8 : bx; }
    F.ws = args.ws; F.ctl = (unsigned*)(args.ws + WS_CTL); F.out = args.out;
    F.in = args.in;
    unsigned char* ws = args.ws;
    for (int u = F.tid; u < 256; u += NWAVES * 64) F.MISC[u] = 0u;
    __syncthreads();
    XcdBarrier bar; bar.bar = F.ctl + CW_BAR; bar.x = 0; bar.st = nullptr;
    if (N_LAUNCHES == 1) bar = xcd_barrier_post(F.ctl + CW_BAR, F.MISC + 8);
#define GRID_BAR() do { if (N_LAUNCHES == 1) xcd_barrier(bar); } while (0)
    const int lo = args.ph_lo, hi = args.ph_hi;
#ifndef PH_MASK
#define PH_MASK 0x7ff
#endif
#ifdef DBG_LAST
#define IN(k) ((k) <= DBG_LAST && (((PH_MASK) >> (k)) & 1) && lo <= (k) && (k) < hi)
#else
#define IN(k) ((((PH_MASK) >> (k)) & 1) && lo <= (k) && (k) < hi)
#endif
#define BOTH(k) (IN(k) && IN((k) + 1))

    if (IN(0)) { p0_prologue(F); if (BOTH(0)) GRID_BAR(); }

    if (IN(1)) {
        Sched1 S{(const char*)(ws + WS_XN), (const char*)(ws + WS_W1T), (const char*)(ws + WS_MEMN), (const char*)(ws + WS_WKV), F.G, (int)blockIdx.x};
        EpiP1 E{(bf16_t*)(ws + WS_Q), (bf16_t*)(ws + WS_K), (bf16_t*)(ws + WS_V), (bf16_t*)(ws + WS_U), (bf16_t*)(ws + WS_QM), (bf16_t*)(ws + WS_G), (bf16_t*)(ws + WS_KM), (bf16_t*)(ws + WS_VMT),
                (unsigned short*)(ws + WS_IQ), (unsigned short*)(ws + WS_IK), (float*)(ws + WS_IW), F.in[5], (const float*)(ws + WS_ROPE)};
        pg8::gemm_phase<EpiP1, Sched1, K_ALIGN, K_SP2>(F.lds, 1024, S, E);
        if (BOTH(1)) GRID_BAR();
    }

    if (IN(2)) {
        p2_select(F);
        const int gw = F.vcu * NWAVES + F.wave, NGW = F.G * NWAVES;
        for (int u = gw; u < 2048; u += NGW) p2_pool_unit(F, u >> 2, u & 3);
        for (int u = gw; u < 2048; u += NGW) p2_mem_unit(F, u >> 2, u & 3);
        if (BOTH(2)) GRID_BAR();
    }

    if (IN(3)) {
        for (int v = F.vcu; v < 256; v += F.G) {
            const int bh = v >> 3, s = v & 7;
#pragma unroll 1
            for (int i = 0; i < 2; ++i) attn_body::attn_unit<8>(bh >> 3, bh & 7, i == 0 ? s : 15 - s, (const attn_body::bf16*)(ws + WS_Q), (const attn_body::bf16*)(ws + WS_K), (const attn_body::bf16*)(ws + WS_V),
                                                                 (attn_body::bf16*)(ws + WS_Q), (const unsigned long long*)(ws + WS_MASKT), (char*)lds);
        }
        if (BOTH(3)) GRID_BAR();
    }

    if (IN(4)) {
        { SchedSimple S{(const char*)(ws + WS_Q), (const char*)(ws + WS_WPA), 64, 4, F.G, (int)blockIdx.x, (size_t)256 * 512 * 2};
          EpiGate<0> E{(const bf16_t*)(ws + WS_G), nullptr, (bf16_t*)(ws + WS_MERGED), 0}; pg8::gemm_phase<EpiGate<0>, SchedSimple, K_ALIGN, K_SP2>(F.lds, 512, S, E); }
        { SchedSimple S{(const char*)(ws + WS_YPOOL), (const char*)(ws + WS_WPP), 64, 4, F.G, (int)blockIdx.x, (size_t)256 * 256 * 2};
          EpiGate<1> E{(const bf16_t*)(ws + WS_G), (const bf16_t*)(ws + WS_MERGED), (bf16_t*)(ws + WS_XN), 1}; pg8::gemm_phase<EpiGate<1>, SchedSimple, K_ALIGN, K_SP2>(F.lds, 256, S, E); }
        { SchedSimple S{(const char*)(ws + WS_YMEM), (const char*)(ws + WS_WPM), 64, 4, F.G, (int)blockIdx.x, (size_t)256 * 256 * 2};
          EpiGate<1> E{(const bf16_t*)(ws + WS_G), (const bf16_t*)(ws + WS_XN), (bf16_t*)(ws + WS_MERGED), 2}; pg8::gemm_phase<EpiGate<1>, SchedSimple, K_ALIGN, K_SP2>(F.lds, 256, S, E); }
        if (BOTH(4)) GRID_BAR();
    }

    if (IN(5)) {
        SchedSimple S{(const char*)(ws + WS_MERGED), (const char*)(ws + WS_WOUT), 64, 4, F.G, (int)blockIdx.x, (size_t)256 * 1024 * 2};
        EpiRes E{F.in[0], F.out}; pg8::gemm_phase<EpiRes, SchedSimple, K_ALIGN, K_SP2>(F.lds, 1024, S, E);
        if (BOTH(5)) GRID_BAR();
    }

    if (IN(6)) { p6_router(F); if (BOTH(6)) GRID_BAR(); }
    if (IN(7)) { p7_scatter(F); if (BOTH(7)) GRID_BAR(); }

    if (IN(8)) {
        moe_tile_table(F);
        SchedMoe S{(const char*)(ws + WS_XG), (const char*)(ws + WS_WUP), (const volatile LAS int*)(F.MISC + 32), 8, F.G, (int)blockIdx.x};
        EpiSwiglu E{F.in[18], (bf16_t*)(ws + WS_ACT)}; pg8::gemm_phase<EpiSwiglu, SchedMoe, K_ALIGN, K_SP2>(F.lds, 1024, S, E);
        if (BOTH(8)) GRID_BAR();
    }
    if (IN(9)) {
        moe_tile_table(F);
        SchedMoe S{(const char*)(ws + WS_ACT), (const char*)(ws + WS_WDN), (const volatile LAS int*)(F.MISC + 32), 4, F.G, (int)blockIdx.x};
        EpiDown E{F.in[20], (bf16_t*)(ws + WS_XG)}; pg8::gemm_phase<EpiDown, SchedMoe, K_ALIGN, K_SP2>(F.lds, 1024, S, E);
        if (BOTH(9)) GRID_BAR();
    }
    if (IN(10)) { p10_final(F); }
#if defined(DBG_LAST) && defined(DBG_SCAN)
    {
        if (N_LAUNCHES == 1) xcd_barrier(bar);
        const unsigned short* base = (const unsigned short*)(ws + DBG_SCAN_OFF);
        const size_t gt = (size_t)blockIdx.x * 512 + threadIdx.x, NGT = (size_t)gridDim.x * 512;
        for (size_t j = gt; j < (size_t)NTOK * DM; j += NGT) { float r = 0.f;
            for (size_t q = j; q < (size_t)DBG_SCAN_ELEMS; q += (size_t)NTOK * DM) { const unsigned v = base[q]; const unsigned e = (v >> 7) & 0xffu, m = v & 0x7fu;
                if (DBG_SCAN == 1 ? (e == 0xffu) : (e == 0u && m != 0u)) r = __builtin_nanf(""); }
            F.out[j] = r; }
    }
#endif
#if defined(DBG_LAST) && defined(DBG_REGIONS)
    {
        if (N_LAUNCHES == 1) xcd_barrier(bar);
        const size_t offs[] = {DBG_REGIONS}; const size_t nreg = sizeof(offs) / sizeof(offs[0]) / 2;
        const size_t gt = (size_t)blockIdx.x * 512 + threadIdx.x, NGT = (size_t)gridDim.x * 512;
        for (size_t j = gt; j < (size_t)NTOK * DM; j += NGT) { float acc = 0.f;
            for (size_t q = 0; q < nreg; ++q) { const unsigned short* base = (const unsigned short*)(ws + offs[2 * q]);
#ifdef DBG_LOWBYTE
                acc += (float)(base[j % (offs[2 * q + 1] / 2)] & 0xffu); }
#else
                acc += (float)base[j % (offs[2 * q + 1] / 2)]; }
#endif
#ifdef DBG_NOISE
            acc += (float)(DBG_NOISE) * (float)((__builtin_amdgcn_s_memrealtime() >> 4) & 1ull) * (float)((j * 2654435761ull >> 13) & 1ull);
#endif
            F.out[j] = acc; }
    }
#endif
#undef IN
#undef BOTH
}

extern "C" void kernel_launch(void* const* d_in, const int* in_sizes, int n_in, void* d_out, int out_size, void* d_ws, size_t ws_size, hipStream_t stream) {
    static int grid = 0;
    if (grid == 0) {
        if (n_in != 22 || in_sizes[0] != NTOK * DM || out_size != NTOK * DM || ws_size < WS_END) { fprintf(stderr, "kernel_launch: unexpected problem shape / workspace (n_in %d, ws %zu < %zu); nothing launched\n", n_in, ws_size, (size_t)WS_END); grid = -1; return; }
        int dev = 0, cus = 0, per_cu = 0;
        if (hipGetDevice(&dev) != hipSuccess || hipDeviceGetAttribute(&cus, hipDeviceAttributeMultiprocessorCount, dev) != hipSuccess) { grid = -1; return; }
        if (hipFuncSetAttribute((const void*)fwd_kernel, hipFuncAttributeMaxDynamicSharedMemorySize, LDS_BYTES) != hipSuccess) { fprintf(stderr, "kernel_launch: hipFuncSetAttribute failed\n"); grid = -1; return; }
        if (hipOccupancyMaxActiveBlocksPerMultiprocessor(&per_cu, (const void*)fwd_kernel, NWAVES * 64, LDS_BYTES) != hipSuccess || per_cu < 1) fprintf(stderr, "kernel_launch: occupancy query reports %d\n", per_cu);
        (void)hipGetLastError();
        grid = cus;
    }
    if (grid < 0) return;
    if (hipMemsetAsync((char*)d_ws + WS_CTL, 0, CTL_ZERO_BYTES, stream) != hipSuccess) return;
    Args a{};
    for (int i = 0; i < 22; ++i) a.in[i] = (const float*)d_in[i];
    a.out = (float*)d_out; a.ws = (unsigned char*)d_ws;
    for (int li = 0; li < N_LAUNCHES; ++li) {
        a.ph_lo = (N_LAUNCHES == 1) ? 0 : li; a.ph_hi = (N_LAUNCHES == 1) ? N_PHASES : li + 1; a.li = li;
        hipLaunchKernelGGL(fwd_kernel, dim3(grid), dim3(NWAVES * 64), LDS_BYTES, stream, a);
        if (hipPeekAtLastError() != hipSuccess) { fprintf(stderr, "kernel_launch: launch %d failed\n", li); break; }
    }
}
```

```cpp
#include <hip/hip_runtime.h>
#include <hip/hip_bf16.h>
#include <cstdio>
#include <cstdint>

#define GAS __attribute__((address_space(1)))
#define LAS __attribute__((address_space(3)))
typedef unsigned short bf16_t;
typedef short bf16x8 __attribute__((ext_vector_type(8)));
typedef _Float16 half8 __attribute__((ext_vector_type(8)));
typedef float f32x4 __attribute__((ext_vector_type(4)));
typedef float f32x2 __attribute__((ext_vector_type(2)));
typedef float f32x16 __attribute__((ext_vector_type(16)));
typedef unsigned u32x4 __attribute__((ext_vector_type(4)));
typedef unsigned u32x2 __attribute__((ext_vector_type(2)));
typedef GAS unsigned gu32;

constexpr int NB = 4, SEQ = 4096, NTOK = NB * SEQ, DM = 1024;
constexpr int NE = 32, TOPK = 4;
constexpr int N1 = 5888;
constexpr int N1_IN = 2816;
constexpr int MOE_ROWS = 73728;
constexpr float EPS = 1e-6f;
constexpr float C2 = 0.125f * 1.4426950408889634f;

constexpr size_t MiB = 1u << 20;
constexpr size_t WS_CTL = 0, CTL_ZERO_BYTES = 1 * MiB;
constexpr size_t WS_ROPE = 1 * MiB;
constexpr size_t WS_WGT = WS_ROPE + 256 * 1024;
constexpr size_t WS_WRH = WS_WGT + 32 * 1024;
constexpr size_t WS_WRL = WS_WRH + 64 * 1024;
constexpr size_t WS_W1T = 2 * MiB;
constexpr size_t WS_WPA = 14 * MiB, WS_WPP = 15 * MiB, WS_WPM = 15 * MiB + 512 * 1024, WS_WOUT = 16 * MiB, WS_WKV = 18 * MiB;
constexpr size_t WS_MEMN = 19 * MiB, WS_KM = 21 * MiB, WS_VMT = 21 * MiB + 512 * 1024;
constexpr size_t WS_IW = 22 * MiB, WS_IK = 23 * MiB;
constexpr size_t WS_RE = 25 * MiB, WS_RR = WS_RE + 256 * 1024, WS_RG = WS_RR + 256 * 1024, WS_SLOT = WS_RG + 256 * 1024, WS_RSTD = WS_SLOT + 256 * 1024;
constexpr size_t WS_WUP = 32 * MiB, WS_WDN = 160 * MiB, WS_XN = 224 * MiB;
constexpr size_t WS_Q = 256 * MiB, WS_K = 272 * MiB, WS_V = 288 * MiB, WS_IQ = 304 * MiB, WS_U = 320 * MiB, WS_QM = 328 * MiB;
constexpr size_t WS_YPOOL = 336 * MiB, WS_YMEM = 344 * MiB, WS_MASKT = 352 * MiB, WS_MERGED = 360 * MiB, WS_G = 392 * MiB;
constexpr size_t WS_XG = 488 * MiB, WS_ACT = 632 * MiB, WS_END = 776 * MiB;
constexpr size_t WS_XNB = WS_MERGED;
constexpr size_t WS_WU = 18 * MiB + 512 * 1024;
constexpr size_t WS_YCAT = WS_XN;
constexpr size_t WS_WCAT = WS_WPA;

constexpr int CW_TMO = 0;
constexpr int CW_CNT = 1024;
constexpr int CW_BAR = 4096;
constexpr int CW_UPDONE = 8192;

constexpr int RING_BYTES = 131072;
constexpr int LDS_BYTES = 155648;
constexpr int MISC_OFF = LDS_BYTES - 1024;

#define LDS_WAIT() asm volatile("s_waitcnt lgkmcnt(0)" ::: "memory")
#define VM_WAIT() asm volatile("s_waitcnt vmcnt(0)" ::: "memory")

typedef __bf16 bf16x2_cv __attribute__((ext_vector_type(2)));
__device__ __forceinline__ unsigned cvt_pk_bf16(float lo, float hi) { f32x2 v = {lo, hi}; bf16x2_cv b = __builtin_convertvector(v, bf16x2_cv); return __builtin_bit_cast(unsigned, b); }
__device__ __forceinline__ unsigned cvt_pk_fp8x4(float a, float b, float c, float d) { int w = 0; w = __builtin_amdgcn_cvt_pk_fp8_f32(a, b, w, false); w = __builtin_amdgcn_cvt_pk_fp8_f32(c, d, w, true); return (unsigned)w; }
__device__ __forceinline__ unsigned cvt_pk_bf16_s(float lo, float hi) { return cvt_pk_bf16(lo, hi); }
typedef _Float16 h2_t __attribute__((ext_vector_type(2)));
__device__ __forceinline__ unsigned cvt_pk_f16(float lo, float hi) { h2_t v = {(_Float16)lo, (_Float16)hi}; return __builtin_bit_cast(unsigned, v); }
__device__ __forceinline__ float bf2f(unsigned short b) { return __builtin_bit_cast(float, (unsigned)b << 16); }
__device__ __forceinline__ float bflo(unsigned w) { return __builtin_bit_cast(float, w << 16); }
__device__ __forceinline__ float bfhi(unsigned w) { return __builtin_bit_cast(float, w & 0xffff0000u); }
__device__ __forceinline__ int lane_id() { int l; asm volatile("v_mbcnt_lo_u32_b32 %0, -1, 0\n\tv_mbcnt_hi_u32_b32 %0, -1, %0" : "=v"(l)); return l; }
__device__ __forceinline__ float wave_sum(float v) {
#pragma unroll
    for (int o = 1; o < 64; o <<= 1) v += __shfl_xor(v, o);
    return v;
}
typedef short s16x2_t __attribute__((ext_vector_type(2)));
__device__ __forceinline__ int wave_sum_i(int v) {
    v += __builtin_amdgcn_update_dpp(0, v, 0xB1, 0xf, 0xf, false);
    v += __builtin_amdgcn_update_dpp(0, v, 0x4E, 0xf, 0xf, false);
    v += __builtin_amdgcn_update_dpp(0, v, 0x141, 0xf, 0xf, false);
    v += __builtin_amdgcn_update_dpp(0, v, 0x140, 0xf, 0xf, false);
    return __builtin_amdgcn_readlane(v, 0) + __builtin_amdgcn_readlane(v, 16) + __builtin_amdgcn_readlane(v, 32) + __builtin_amdgcn_readlane(v, 48);
}
__device__ __forceinline__ float sigmoidf_fast(float x) { return __builtin_amdgcn_rcpf(1.f + __builtin_amdgcn_exp2f(-1.4426950408889634f * x)); }

#ifndef PG8_DMA_AUX
#define PG8_DMA_AUX 0
#endif
namespace pg8 {
constexpr int BM = 256, BK = 64, HALF = 128, HTB = HALF * BK * 2, STAGE_BYTES = 8 * HTB, NXCD = 8, WGM = 8;
__host__ __device__ __forceinline__ int lds_byte(int r, int c) { const int st = (r >> 4) * 2 + (c >> 5), rr = r & 15, cc = c & 31, ob = rr * 64 + cc * 2; return st * 1024 + (ob ^ (((ob >> 9) & 1) << 5)); }
__host__ __device__ __forceinline__ void stage_rc(int b, int& R, int& C) { const int st = b / 1024, sb = b % 1024, swz = sb ^ (((sb >> 9) & 1) << 5); R = (st >> 1) * 16 + swz / 64; C = (st & 1) * 32 + (swz % 64) / 2; }
__host__ __device__ __forceinline__ int perm32(int rho) { const int n = rho >> 4, i = rho & 15; return 8 * (i >> 2) + 4 * n + (i & 3); }

struct Unit { int pm, pn, kind, c0; const char* a; const char* b; };

__device__ __forceinline__ void tile_order(int L, int nM, int nN, int& pm, int& pn) {
    const int nwg = nM * nN; int wgid = L;
    { const int q = nwg / NXCD, r = nwg % NXCD, xcd = wgid % NXCD, off = wgid / NXCD; wgid = (xcd < r ? xcd * (q + 1) : r * (q + 1) + (xcd - r) * q) + off; }
    const int nig = WGM * nN, gid = wgid / nig, fm = gid * WGM, gsz = (nM - fm) < WGM ? (nM - fm) : WGM;
    pm = fm + ((wgid % nig) % gsz); pn = (wgid % nig) / gsz;
}

struct NoHook { template <class A> __device__ __forceinline__ void operator()(A&, const Unit&, int, int, int, int, int) const {} };
typedef int v8i_t __attribute__((ext_vector_type(8)));
template <class Epi, class Sched, bool ALIGN_EPI = false, bool SP2 = false, class Hook = NoHook, int ESZ = 2>
__device__ __forceinline__ void gemm_phase(const int wid, LAS unsigned char* lds, const int K, const Sched& S, const Epi& E, const int ktiles = 0, const Hook& H = Hook()) {
    int lane = lane_id(); asm volatile("" : "+v"(lane));
    const int tid = wid * 64 + lane, wr = wid >> 2, wc = wid & 3, fr = lane & 15, fq = lane >> 4;
    const int nt = ktiles ? ktiles : K * ESZ / 128;
    unsigned voffA[2], voffB[2];
#pragma unroll
    for (int i = 0; i < 2; ++i) { int R, C; stage_rc(tid * 16 + i * 8192, R, C); const int Rb = Epi::PERM ? ((R & ~31) + perm32(R & 31)) : R;
        voffA[i] = (unsigned)(R * K * ESZ + C * 2); voffB[i] = (unsigned)(Rb * K * ESZ + C * 2); }
    const size_t kstep = (size_t)(BK * 2);
    const size_t hstep = (size_t)HALF * K * ESZ;
    const unsigned ldsw = (unsigned)wid * 1024u;
    const int aoff0 = lds_byte(wr * 64 + fr, ESZ == 2 ? fq * 8 : fq * 16), aoff1 = lds_byte(wr * 64 + fr, ESZ == 2 ? fq * 8 + 32 : fq * 16 + 8);
    const int boff0 = lds_byte(wc * 32 + fr, ESZ == 2 ? fq * 8 : fq * 16), boff1 = lds_byte(wc * 32 + fr, ESZ == 2 ? fq * 8 + 32 : fq * 16 + 8);
#define PG8_SA(b, h) (((b) * 2 + (h)) * HTB)
#define PG8_SB(b, h) ((4 + (b) * 2 + (h)) * HTB)
    const unsigned lds0 = (unsigned)(uintptr_t)lds;
#define PG8_STAGE(bufoff, gbase, voff) do { _Pragma("unroll") for (int _i = 0; _i < 2; ++_i) { unsigned keep_; \
        asm volatile("s_mov_b32 %0, m0\n\ts_mov_b32 m0, %3\n\ts_nop 2\n\tglobal_load_lds_dwordx4 %1, %2\n\ts_mov_b32 m0, %0" : "=&s"(keep_) : "v"((voff)[_i]), "s"((const char*)(gbase)), "s"(lds0 + (unsigned)(bufoff) + ldsw + (unsigned)_i * 8192u) : "memory"); } } while (0)
#define PG8_LDA(dst, b, h) do { _Pragma("unroll") for (int m = 0; m < 4; ++m) { dst[m][0] = *(const LAS bf16x8*)(lds + PG8_SA(b, h) + aoff0 + m * 2048); dst[m][1] = *(const LAS bf16x8*)(lds + PG8_SA(b, h) + aoff1 + m * 2048); } } while (0)
#define PG8_LDB(dst, b, h) do { _Pragma("unroll") for (int n = 0; n < 2; ++n) { dst[n][0] = *(const LAS bf16x8*)(lds + PG8_SB(b, h) + boff0 + n * 2048); dst[n][1] = *(const LAS bf16x8*)(lds + PG8_SB(b, h) + boff1 + n * 2048); } } while (0)
#define PG8_CAT(x) __builtin_shufflevector(__builtin_bit_cast(u32x4, (x)[0]), __builtin_bit_cast(u32x4, (x)[1]), 0, 1, 2, 3, 4, 5, 6, 7)
#define PG8_MMA(ai, bj, At, Bt) do { __builtin_amdgcn_s_setprio(1); _Pragma("unroll") for (int m = 0; m < 4; ++m) _Pragma("unroll") for (int n = 0; n < 2; ++n) { \
        if constexpr (ESZ == 2) { _Pragma("unroll") for (int k = 0; k < 2; ++k) acc[ai][bj][m][n] = __builtin_amdgcn_mfma_f32_16x16x32_bf16(Bt[n][k], At[m][k], acc[ai][bj][m][n], 0, 0, 0); } \
        else acc[ai][bj][m][n] = __builtin_amdgcn_mfma_scale_f32_16x16x128_f8f6f4(__builtin_bit_cast(v8i_t, PG8_CAT(Bt[n])), __builtin_bit_cast(v8i_t, PG8_CAT(At[m])), acc[ai][bj][m][n], 0, 0, 0, 0, 0, 0); }        \
        __builtin_amdgcn_s_setprio(0); } while (0)
#define PG8_WAIT_V(n) asm volatile("s_waitcnt vmcnt(" #n ")" ::: "memory")
#define PG8_WAIT_L(n) asm volatile("s_waitcnt lgkmcnt(" #n ")" ::: "memory")
#define PG8_BAR __builtin_amdgcn_s_barrier()
#define PG8_SCHED __builtin_amdgcn_sched_barrier(0)
    Unit cur, nxt; int ui = 0;
    if (!S.next(0, cur)) return;
    f32x4 acc[2][2][4][2];
#pragma unroll
    for (int a = 0; a < 2; ++a)
#pragma unroll
        for (int b = 0; b < 2; ++b)
#pragma unroll
            for (int m = 0; m < 4; ++m)
#pragma unroll
                for (int n = 0; n < 2; ++n) acc[a][b][m][n] = (f32x4){0.f, 0.f, 0.f, 0.f};
    bf16x8 At[4][2], B0[2][2], B1[2][2];
#define PG8_UNI(p) ((const char*)(((unsigned long long)(unsigned)__builtin_amdgcn_readfirstlane((int)(unsigned)((unsigned long long)(p) >> 32)) << 32) | (unsigned)__builtin_amdgcn_readfirstlane((int)(unsigned)(unsigned long long)(p))))
    const char* cA = PG8_UNI(cur.a); const char* cB = PG8_UNI(cur.b);
    if constexpr (SP2) {
        PG8_STAGE(PG8_SB(0, 0), cB, voffB); PG8_STAGE(PG8_SB(0, 1), cB + hstep, voffB); PG8_STAGE(PG8_SA(0, 0), cA, voffA); PG8_STAGE(PG8_SA(0, 1), cA + hstep, voffA);
        if (wr == 1) PG8_BAR;
        PG8_WAIT_V(2); PG8_BAR;
        PG8_STAGE(PG8_SB(1, 0), cB + kstep, voffB); PG8_STAGE(PG8_SA(1, 0), cA + kstep, voffA); PG8_STAGE(PG8_SB(1, 1), cB + hstep + kstep, voffB);
        PG8_WAIT_V(6); PG8_BAR;
    } else {
        PG8_STAGE(PG8_SB(0, 0), cB, voffB); PG8_STAGE(PG8_SA(0, 0), cA, voffA); PG8_STAGE(PG8_SB(0, 1), cB + hstep, voffB); PG8_STAGE(PG8_SA(0, 1), cA + hstep, voffA);
        if (wr == 1) PG8_BAR;
        PG8_WAIT_V(4); PG8_BAR;
        PG8_STAGE(PG8_SB(1, 0), cB + kstep, voffB); PG8_STAGE(PG8_SA(1, 0), cA + kstep, voffA); PG8_STAGE(PG8_SB(1, 1), cB + hstep + kstep, voffB);
        PG8_WAIT_V(6); PG8_BAR;
    }
    for (;;) {
        const bool has_next = S.next(ui + 1, nxt);
        const char* nA = PG8_UNI(has_next ? nxt.a : cA); const char* nB = PG8_UNI(has_next ? nxt.b : cB);
#pragma nounroll
        for (int t = 0; t < nt; t += 2) {
            const bool last = (t == nt - 2);
            H(acc, cur, t, wr, wc, fr, fq);
            const char* a1 = cA + (size_t)(t + 1) * kstep;
            const char* a2 = last ? nA : cA + (size_t)(t + 2) * kstep; const char* b2 = last ? nB : cB + (size_t)(t + 2) * kstep;
            const char* a3 = a2 + kstep; const char* b3 = b2 + kstep;
            if constexpr (SP2) {
            PG8_LDB(B0, 0, 0); PG8_LDB(B1, 0, 1); PG8_SCHED; PG8_LDA(At, 0, 0); PG8_STAGE(PG8_SA(1, 1), a1 + hstep, voffA);
            PG8_WAIT_V(8); PG8_WAIT_L(0); PG8_BAR; PG8_MMA(0, 0, At, B0); PG8_MMA(0, 1, At, B1); PG8_BAR; PG8_SCHED;
            PG8_LDA(At, 0, 1); PG8_STAGE(PG8_SB(0, 0), b2, voffB); PG8_STAGE(PG8_SB(0, 1), b2 + hstep, voffB); PG8_STAGE(PG8_SA(0, 0), a2, voffA);
            PG8_WAIT_V(8); PG8_WAIT_L(0); PG8_BAR; PG8_MMA(1, 0, At, B0); PG8_MMA(1, 1, At, B1); PG8_BAR; PG8_SCHED;
            PG8_LDB(B0, 1, 0); PG8_LDB(B1, 1, 1); PG8_SCHED; PG8_LDA(At, 1, 0); PG8_STAGE(PG8_SA(0, 1), a2 + hstep, voffA);
            PG8_WAIT_V(8); PG8_WAIT_L(0); PG8_BAR; PG8_MMA(0, 0, At, B0); PG8_MMA(0, 1, At, B1); PG8_BAR; PG8_SCHED;
            PG8_LDA(At, 1, 1); PG8_STAGE(PG8_SB(1, 0), b3, voffB); PG8_STAGE(PG8_SB(1, 1), b3 + hstep, voffB); PG8_STAGE(PG8_SA(1, 0), a3, voffA);
            PG8_WAIT_V(8); PG8_WAIT_L(0); PG8_BAR; PG8_MMA(1, 0, At, B0); PG8_MMA(1, 1, At, B1); PG8_BAR; PG8_SCHED;
            } else {
            PG8_LDB(B0, 0, 0); PG8_SCHED; PG8_LDA(At, 0, 0); PG8_STAGE(PG8_SA(1, 1), a1 + hstep, voffA);
            PG8_WAIT_L(8); PG8_BAR; PG8_WAIT_L(0); PG8_MMA(0, 0, At, B0); PG8_BAR; PG8_SCHED;
            PG8_LDB(B1, 0, 1); PG8_STAGE(PG8_SB(0, 0), b2, voffB);
            PG8_BAR; PG8_WAIT_L(0); PG8_MMA(0, 1, At, B1); PG8_BAR;
            PG8_LDA(At, 0, 1); PG8_STAGE(PG8_SA(0, 0), a2, voffA);
            PG8_BAR; PG8_WAIT_L(0); PG8_MMA(1, 0, At, B0); PG8_BAR; PG8_SCHED;
            PG8_STAGE(PG8_SB(0, 1), b2 + hstep, voffB);
            PG8_WAIT_V(6); PG8_BAR; PG8_MMA(1, 1, At, B1); PG8_BAR;
            PG8_LDB(B0, 1, 0); PG8_SCHED; PG8_LDA(At, 1, 0); PG8_STAGE(PG8_SA(0, 1), a2 + hstep, voffA);
            PG8_WAIT_L(8); PG8_BAR; PG8_WAIT_L(0); PG8_MMA(0, 0, At, B0); PG8_BAR; PG8_SCHED;
            PG8_LDB(B1, 1, 1); PG8_STAGE(PG8_SB(1, 0), b3, voffB);
            PG8_BAR; PG8_WAIT_L(0); PG8_MMA(0, 1, At, B1); PG8_BAR;
            PG8_LDA(At, 1, 1); PG8_STAGE(PG8_SA(1, 0), a3, voffA);
            PG8_BAR; PG8_WAIT_L(0); PG8_MMA(1, 0, At, B0); PG8_BAR; PG8_SCHED;
            PG8_STAGE(PG8_SB(1, 1), b3 + hstep, voffB);
            PG8_WAIT_V(6); PG8_BAR; PG8_MMA(1, 1, At, B1); PG8_BAR;
            }
        }
        if constexpr (ALIGN_EPI) { if (wr == 0) PG8_BAR; }
        { int l2 = lane_id(); asm volatile("" : "+v"(l2)); E(acc, cur, wr, wc, l2 & 15, l2 >> 4); }
        if (!has_next) break;
#pragma unroll
        for (int a = 0; a < 2; ++a)
#pragma unroll
            for (int b = 0; b < 2; ++b)
#pragma unroll
                for (int m = 0; m < 4; ++m)
#pragma unroll
                    for (int n = 0; n < 2; ++n) acc[a][b][m][n] = (f32x4){0.f, 0.f, 0.f, 0.f};
        cur = nxt; cA = nA; cB = nB; ++ui;
        if constexpr (ALIGN_EPI) { if (wr == 1) PG8_BAR; }
    }
    PG8_WAIT_V(0);
    if constexpr (!ALIGN_EPI) { if (wr == 0) PG8_BAR; }
    PG8_BAR;
#undef PG8_SA
#undef PG8_SB
#undef PG8_STAGE
#undef PG8_LDA
#undef PG8_LDB
#undef PG8_MMA
#undef PG8_CAT
#undef PG8_UNI
#undef PG8_WAIT_V
#undef PG8_WAIT_L
#undef PG8_BAR
#undef PG8_SCHED
}
}
using pg8::Unit;
constexpr bool K_ALIGN = true, K_SP2 = true;
#ifndef P4_ALIGN
#define P4_ALIGN true
#endif
#ifndef P4_SP2
#define P4_SP2 true
#endif

enum { KQ = 0, KK = 1, KV = 2, KIQ = 3, KU = 4, KQM = 5, KIKW = 6, KG = 7, KKM = 8, KVMT = 9 };
struct EpiP1 {
    static constexpr bool PERM = true;
    bf16_t *Q, *K, *V, *U, *QM, *G, *KM, *VMT; unsigned short *IQ, *IK; float* IW; const float* bgate; const float* rope; float accscale;
    __device__ __forceinline__ static void rope4(f32x4& v, const f32x4 cs) {
        const float a1 = v[0] * cs[0] - v[1] * cs[1], a2 = v[1] * cs[0] + v[0] * cs[1];
        const float b1 = v[2] * cs[2] - v[3] * cs[3], b2 = v[3] * cs[2] + v[2] * cs[3];
        v = (f32x4){a1, a2, b1, b2};
    }
    template <int KIND> __device__ __forceinline__ void run(const f32x4 (&acc)[2][2][4][2], const Unit& u, int wr, int wc, int fr, int fq) const {
        const int row0 = u.pm * 256 + wr * 64 + fr;
        constexpr bool ROPE = (KIND == KQ || KIND == KK || KIND == KIQ || KIND == KIKW);
        f32x4 gb0[2], gb1[2];
        if constexpr (KIND == KG) {
#pragma unroll
            for (int bj = 0; bj < 2; ++bj) { const float* bp = bgate + u.c0 + bj * 128 + wc * 32 + 8 * fq; gb0[bj] = *(const f32x4*)bp; gb1[bj] = *(const f32x4*)(bp + 4); } }
        const bool ropelane = ROPE && ((wc & 1) == 0) && (fq < 2);
#pragma unroll
        for (int ai = 0; ai < 2; ++ai) {
            f32x4 csa[4], csb[4];
#pragma unroll
            for (int m = 0; m < 4; ++m) { csa[m] = (f32x4){1.f, 0.f, 1.f, 0.f}; csb[m] = csa[m];
                if (ROPE) { if (ropelane) { const float* rp = rope + (size_t)((row0 + ai * 128 + m * 16) & (SEQ - 1)) * 16 + 8 * fq; csa[m] = *(const f32x4*)rp; csb[m] = *(const f32x4*)(rp + 4); } } }
#pragma unroll
            for (int m = 0; m < 4; ++m) {
                const int row = row0 + ai * 128 + m * 16;
                const f32x4 cs0 = csa[m], cs1 = csb[m];
#pragma unroll
                for (int bj = 0; bj < 2; ++bj) {
                    f32x4 v0 = acc[ai][bj][m][0] * accscale, v1 = acc[ai][bj][m][1] * accscale;
                    const int lc = bj * 128 + wc * 32 + 8 * fq;
                    if constexpr (KIND == KQ || KIND == KK || KIND == KIQ) { if (ropelane) { rope4(v0, cs0); rope4(v1, cs1); } }
                    if constexpr (KIND == KIKW) { if (ropelane && bj == 0 && wc == 0) { rope4(v0, cs0); rope4(v1, cs1); } }
                    if constexpr (KIND == KQ || KIND == KQM) { v0 = v0 * C2; v1 = v1 * C2; }
                    if constexpr (KIND == KIQ) { v0 = v0 * 0.125f; v1 = v1 * 0.125f; }
                    if constexpr (KIND == KG) {
#pragma unroll
                        for (int i = 0; i < 4; ++i) { v0[i] = sigmoidf_fast(v0[i] + gb0[bj][i]); v1[i] = sigmoidf_fast(v1[i] + gb1[bj][i]); }
                    }
                    if constexpr (KIND == KIQ) {
                        u32x4 w; w.x = cvt_pk_f16(v0[0], v0[1]); w.y = cvt_pk_f16(v0[2], v0[3]); w.z = cvt_pk_f16(v1[0], v1[1]); w.w = cvt_pk_f16(v1[2], v1[3]);
                        *(u32x4*)(IQ + (size_t)row * 512 + u.c0 + lc) = w;
                    } else if constexpr (KIND == KIKW) {
                        if (lc < 64) { u32x4 w; w.x = cvt_pk_f16(v0[0], v0[1]); w.y = cvt_pk_f16(v0[2], v0[3]); w.z = cvt_pk_f16(v1[0], v1[1]); w.w = cvt_pk_f16(v1[2], v1[3]);
                            *(u32x4*)(IK + (size_t)row * 64 + lc) = w; }
                        else if (lc == 64) { const float s = 0.35355339059327373f; float* p = IW + (size_t)row * 8; *(f32x4*)p = v0 * s; *(f32x4*)(p + 4) = v1 * s; }
                    } else if constexpr (KIND == KVMT) {
                        const int b = row >> 8, key = row & 255;
                        const float vv[8] = {v0[0], v0[1], v0[2], v0[3], v1[0], v1[1], v1[2], v1[3]};
#pragma unroll
                        for (int i = 0; i < 8; ++i) { const int c = lc + i, hm = c >> 6, d = c & 63; VMT[((size_t)(b * 4 + hm) * 64 + d) * 256 + key] = (bf16_t)(cvt_pk_bf16(vv[i], 0.f) & 0xffffu); }
                    } else {
                        u32x4 w; w.x = cvt_pk_bf16(v0[0], v0[1]); w.y = cvt_pk_bf16(v0[2], v0[3]); w.z = cvt_pk_bf16(v1[0], v1[1]); w.w = cvt_pk_bf16(v1[2], v1[3]);
                        bf16_t* dst;
                        if constexpr (KIND == KQ) dst = Q + (size_t)row * 512;
                        else if constexpr (KIND == KK) dst = K + (size_t)row * 512;
                        else if constexpr (KIND == KV) dst = V + (size_t)row * 512;
                        else if constexpr (KIND == KU) dst = U + (size_t)row * 256;
                        else if constexpr (KIND == KQM) dst = QM + (size_t)row * 256;
                        else if constexpr (KIND == KG) dst = G + (size_t)row * 3072;
                        else dst = KM + (size_t)row * 256;
                        *(u32x4*)(dst + u.c0 + lc) = w;
                    }
                }
            }
        }
    }
    __device__ __forceinline__ void operator()(const f32x4 (&acc)[2][2][4][2], const Unit& u, int wr, int wc, int fr, int fq) const {
        switch (u.kind) {
            case KQ: run<KQ>(acc, u, wr, wc, fr, fq); break;
            case KK: run<KK>(acc, u, wr, wc, fr, fq); break;
            case KV: run<KV>(acc, u, wr, wc, fr, fq); break;
            case KIQ: run<KIQ>(acc, u, wr, wc, fr, fq); break;
            case KU: run<KU>(acc, u, wr, wc, fr, fq); break;
            case KQM: run<KQM>(acc, u, wr, wc, fr, fq); break;
            case KIKW: run<KIKW>(acc, u, wr, wc, fr, fq); break;
            case KG: run<KG>(acc, u, wr, wc, fr, fq); break;
            case KKM: run<KKM>(acc, u, wr, wc, fr, fq); break;
            default: run<KVMT>(acc, u, wr, wc, fr, fq); break;
        }
    }
};
struct SchedU {
    const char *XNB, *WU; int G, c;
    __device__ __forceinline__ bool next(int i, Unit& u) const {
        const int j = G - 1 - c; if (i != 0 || j < 0 || j >= 64) return false;
        u.pm = j; u.pn = 8; u.kind = KU; u.c0 = 0; u.a = XNB + (size_t)j * 256 * 2048; u.b = WU; return true;
    }
};
struct Sched1 {
    const char *XN, *W1T, *MEMN, *WKV; int G, c;
    __device__ __forceinline__ bool next(int i, Unit& u) const {
        int L = i * G + c;
        if (G == 256) {
            if (i < 4) L = i * 256 + c; else if (i < 6) { if (c >= 192) return false; L = 1024 + (i - 4) * 192 + c; } else return false;
        }
        if (L < 64 * 22) {
            pg8::tile_order(L, 64, 22, u.pm, u.pn); if (u.pn >= 8) ++u.pn;
            u.a = XN + (size_t)u.pm * 256 * 1024; u.b = W1T + (size_t)u.pn * 256 * 1024;
            const int pn = u.pn;
            if (pn < 2) { u.kind = KQ; u.c0 = pn * 256; } else if (pn < 4) { u.kind = KK; u.c0 = (pn - 2) * 256; } else if (pn < 6) { u.kind = KV; u.c0 = (pn - 4) * 256; }
            else if (pn < 8) { u.kind = KIQ; u.c0 = (pn - 6) * 256; } else if (pn == 8) { u.kind = KU; u.c0 = 0; } else if (pn == 9) { u.kind = KQM; u.c0 = 0; }
            else if (pn == 10) { u.kind = KIKW; u.c0 = 0; } else { u.kind = KG; u.c0 = (pn - 11) * 256; }
            return true;
        }
        return false;
    }
};
template <int MODE> struct EpiGate {
    static constexpr bool PERM = true;
    const bf16_t* G; const bf16_t* PREV; bf16_t* OUT; int br;
    __device__ __forceinline__ void operator()(const f32x4 (&acc)[2][2][4][2], const Unit& u, int wr, int wc, int fr, int fq) const {
        const int row0 = u.pm * 256 + wr * 64 + fr, col0 = u.pn * 256 + wc * 32 + 8 * fq;
#pragma unroll
        for (int b0 = 0; b0 < 16; b0 += 8) {
            u32x4 gv[8], pv[MODE != 0 ? 8 : 1];
#pragma unroll
            for (int q = 0; q < 8; ++q) { const int st = b0 + q, ai = st >> 3, m = (st >> 1) & 3, bj = st & 1; const int row = row0 + ai * 128 + m * 16, col = col0 + bj * 128;
                gv[q] = *(const u32x4*)(G + (size_t)row * 3072 + br * 1024 + col);
                if constexpr (MODE != 0) pv[q] = *(const u32x4*)(PREV + (size_t)row * 1024 + col); }
#pragma unroll
            for (int q = 0; q < 8; ++q) { const int st = b0 + q, ai = st >> 3, m = (st >> 1) & 3, bj = st & 1; const int row = row0 + ai * 128 + m * 16, col = col0 + bj * 128;
                const u32x4 g = gv[q];
                const f32x4 v0 = acc[ai][bj][m][0], v1 = acc[ai][bj][m][1];
                float o[8] = {v0[0] * bflo(g.x), v0[1] * bfhi(g.x), v0[2] * bflo(g.y), v0[3] * bfhi(g.y), v1[0] * bflo(g.z), v1[1] * bfhi(g.z), v1[2] * bflo(g.w), v1[3] * bfhi(g.w)};
#ifdef ABL_ZERO_BR
                if (br == ABL_ZERO_BR) {
#pragma unroll
                    for (int i = 0; i < 8; ++i) o[i] = 0.f; }
#endif
                if constexpr (MODE != 0) { const u32x4 p = pv[q];
                    o[0] += bflo(p.x); o[1] += bfhi(p.x); o[2] += bflo(p.y); o[3] += bfhi(p.y); o[4] += bflo(p.z); o[5] += bfhi(p.z); o[6] += bflo(p.w); o[7] += bfhi(p.w); }
                u32x4 w; w.x = cvt_pk_bf16(o[0], o[1]); w.y = cvt_pk_bf16(o[2], o[3]); w.z = cvt_pk_bf16(o[4], o[5]); w.w = cvt_pk_bf16(o[6], o[7]);
                *(u32x4*)(OUT + (size_t)row * 1024 + col) = w;
            }
        }
    }
};
struct GateRatioHook {
    const bf16_t* G;
    __device__ __forceinline__ void operator()(f32x4 (&acc)[2][2][4][2], const Unit& u, int t, int wr, int wc, int fr, int fq) const {
        if (t != 8 && t != 12) return;
        const int bra = (t == 8) ? 0 : 1;
        int row0 = u.pm * 256 + wr * 64 + fr, col0 = u.pn * 256 + wc * 32 + 8 * fq;
        asm volatile("" : "+v"(row0), "+v"(col0));
#ifndef HOOK_BATCH
#define HOOK_BATCH 8
#endif
#pragma unroll
        for (int b0 = 0; b0 < 16; b0 += HOOK_BATCH) {
            u32x4 ga[HOOK_BATCH], gb[HOOK_BATCH];
#pragma unroll
            for (int q = 0; q < HOOK_BATCH; ++q) { const int st = b0 + q, ai = st >> 3, m = (st >> 1) & 3, bj = st & 1;
                const bf16_t* gp = G + (size_t)(row0 + ai * 128 + m * 16) * 3072 + bra * 1024 + col0 + bj * 128; ga[q] = *(const u32x4*)gp; gb[q] = *(const u32x4*)(gp + 1024); }
#pragma unroll
            for (int q = 0; q < HOOK_BATCH; ++q) { const int st = b0 + q, ai = st >> 3, m = (st >> 1) & 3, bj = st & 1;
                const float na[8] = {bflo(ga[q].x), bfhi(ga[q].x), bflo(ga[q].y), bfhi(ga[q].y), bflo(ga[q].z), bfhi(ga[q].z), bflo(ga[q].w), bfhi(ga[q].w)};
                const float nb[8] = {bflo(gb[q].x), bfhi(gb[q].x), bflo(gb[q].y), bfhi(gb[q].y), bflo(gb[q].z), bfhi(gb[q].z), bflo(gb[q].w), bfhi(gb[q].w)};
#pragma unroll
                for (int i = 0; i < 8; ++i) { const float rt = na[i] * __builtin_amdgcn_rcpf(fmaxf(nb[i], 1e-30f)); acc[ai][bj][m][i >> 2][i & 3] *= rt; } }
            __builtin_amdgcn_sched_barrier(0);
        }
    }
};
struct SchedSimple {
    const char *A, *B; int nM, nN, G, c; size_t tstep;
    __device__ __forceinline__ bool next(int i, Unit& u) const {
        const int L = i * G + c; if (L >= nM * nN) return false;
        pg8::tile_order(L, nM, nN, u.pm, u.pn); u.a = A + (size_t)u.pm * tstep; u.b = B + (size_t)u.pn * tstep; u.kind = 0; u.c0 = 0; return true;
    }
};
struct EpiRes {
    static constexpr bool PERM = false;
    const float* X; float* H;
    __device__ __forceinline__ void operator()(const f32x4 (&acc)[2][2][4][2], const Unit& u, int wr, int wc, int fr, int fq) const {
        const int row0 = u.pm * 256 + wr * 64 + fr, col0 = u.pn * 256 + wc * 32 + 4 * fq;
#pragma unroll
        for (int ai = 0; ai < 2; ++ai)
#pragma unroll
            for (int m = 0; m < 4; ++m) { const size_t off = (size_t)(row0 + ai * 128 + m * 16) * 1024 + col0;
#pragma unroll
                for (int bj = 0; bj < 2; ++bj)
#pragma unroll
                    for (int n = 0; n < 2; ++n) { const size_t o = off + bj * 128 + n * 16; *(f32x4*)(H + o) = *(const f32x4*)(X + o) + acc[ai][bj][m][n];
#ifdef DBG_DRAIN_ST
                        asm volatile("s_waitcnt vmcnt(0)" ::: "memory");
#endif
                    } }
    }
};
struct SchedMoe {
    const char *A, *W; const volatile LAS int* tpre0; int npn, G, c, rowb; int hx = -1, hs = 0; unsigned* wait_ctr = nullptr; int srot = 0;
    __device__ __forceinline__ bool next(int i, Unit& u) const {
        unsigned toff = (unsigned)(uintptr_t)tpre0; asm volatile("" : "+s"(toff)); const volatile LAS int* tpre = (const volatile LAS int*)(uintptr_t)toff;
        const int TT = __builtin_amdgcn_readfirstlane(tpre[32]); int T, pn;
        if ((G & 7) == 0 && (G >> 3) % npn == 0) { const int per = G >> 3, xcd = hx >= 0 ? hx : (c & 7), s0_ = hx >= 0 ? hs : (c >> 3), s = srot ? per - 1 - s0_ : s0_, mt = per / npn, chunk = (TT + 7) >> 3, tl = i * mt + s / npn;
            pn = s % npn; if (tl >= chunk) return false; T = xcd * chunk + tl; }
        else { const int L = i * G + c; T = L / npn; pn = L - T * npn; }
        if (T >= TT) return false;
        int e = 0;
#pragma unroll
        for (int j = 1; j < 32; ++j) e += (tpre[j] <= T) ? 1 : 0;
        e = __builtin_amdgcn_readfirstlane(e);
        if (wait_ctr) { unsigned sp_ = 0u; while (__hip_atomic_load(wait_ctr + T, __ATOMIC_RELAXED, __HIP_MEMORY_SCOPE_AGENT) < 64u) { __builtin_amdgcn_s_sleep(2); if (++sp_ > (1u << 22)) break; } }
        u.pm = T; u.pn = pn; u.kind = e; u.c0 = 0; u.a = A + (size_t)T * 256 * rowb; u.b = W + ((size_t)e * npn + pn) * 256 * rowb; return true;
    }
};
struct EpiSwiglu {
    static constexpr bool PERM = true;
    const float* bup; unsigned char* ACT; unsigned* done_ctr = nullptr;
    __device__ __forceinline__ void operator()(const f32x4 (&acc)[2][2][4][2], const Unit& u, int wr, int wc, int fr, int fq) const {
        const int row0 = u.pm * 256 + wr * 64 + fr, e = u.kind, jc = u.pn * 128 + wc * 32 + 8 * fq;
        const float* bg = bup + (size_t)e * 2048 + jc; const float* bl = bg + 1024;
        const f32x4 bg0 = *(const f32x4*)bg, bg1 = *(const f32x4*)(bg + 4), bl0 = *(const f32x4*)bl, bl1 = *(const f32x4*)(bl + 4);
#pragma unroll
        for (int ai = 0; ai < 2; ++ai)
#pragma unroll
            for (int m = 0; m < 4; ++m) {
                const int row = row0 + ai * 128 + m * 16;
                float o[8];
#pragma unroll
                for (int n = 0; n < 2; ++n) { const f32x4 gv = acc[ai][0][m][n] * (1.f / 64.f) + (n ? bg1 : bg0), lv = acc[ai][1][m][n] * (1.f / 64.f) + (n ? bl1 : bl0);
#pragma unroll
                    for (int i = 0; i < 4; ++i) { const float g = fminf(gv[i], 7.f), l = fminf(fmaxf(lv[i], -7.f), 7.f); o[n * 4 + i] = g * sigmoidf_fast(1.702f * g) * (l + 1.f); } }
                u32x2 w; w.x = cvt_pk_fp8x4(o[0], o[1], o[2], o[3]); w.y = cvt_pk_fp8x4(o[4], o[5], o[6], o[7]);
                *(u32x2*)(ACT + (size_t)row * 1024 + jc) = w;
            }
        if (done_ctr) { asm volatile("s_waitcnt vmcnt(0)" ::: "memory"); if (lane_id() == 0) __hip_atomic_fetch_add(done_ctr + u.pm, 1u, __ATOMIC_RELAXED, __HIP_MEMORY_SCOPE_AGENT); }
    }
};
struct EpiDown {
    static constexpr bool PERM = true;
    const float* bdn; unsigned char* Y;
    __device__ __forceinline__ void operator()(const f32x4 (&acc)[2][2][4][2], const Unit& u, int wr, int wc, int fr, int fq) const {
        const int row0 = u.pm * 256 + wr * 64 + fr, e = u.kind, col0 = u.pn * 256 + wc * 32 + 8 * fq;
        f32x4 bb0[2], bb1[2];
#pragma unroll
        for (int bj = 0; bj < 2; ++bj) { const float* bp = bdn + (size_t)e * 1024 + col0 + bj * 128; bb0[bj] = *(const f32x4*)bp; bb1[bj] = *(const f32x4*)(bp + 4); }
#pragma unroll
        for (int bj = 0; bj < 2; ++bj) { const f32x4 b0 = bb0[bj], b1 = bb1[bj];
#pragma unroll
            for (int ai = 0; ai < 2; ++ai)
#pragma unroll
                for (int m = 0; m < 4; ++m) { const int row = row0 + ai * 128 + m * 16; const f32x4 v0 = acc[ai][bj][m][0] * (1.f / 64.f) + b0, v1 = acc[ai][bj][m][1] * (1.f / 64.f) + b1;
                    float o[8];
#pragma unroll
                    for (int i = 0; i < 4; ++i) { o[i] = fminf(fmaxf(v0[i], -48.f), 48.f) * 8.f; o[4 + i] = fminf(fmaxf(v1[i], -48.f), 48.f) * 8.f; }
                    u32x2 w; w.x = cvt_pk_fp8x4(o[0], o[1], o[2], o[3]); w.y = cvt_pk_fp8x4(o[4], o[5], o[6], o[7]);
                    *(u32x2*)(Y + (size_t)row * 1024 + col0 + bj * 128) = w; } }
    }
};

namespace attn_body {
using bf16 = __hip_bfloat16;
using s16x4 = __attribute__((ext_vector_type(4))) short;
constexpr int BATCH = 4, NHEAD = 8, ASEQ = 4096, D = 64, ADM = NHEAD * D;
constexpr int NW = 8, QBLK = 32, QB = QBLK * NW, KVBLK = 64, NQB = ASEQ / QB;
constexpr int OPITCH = 1024;
__device__ __forceinline__ int crow(int r, int hi) { return (r & 3) + 8 * (r >> 2) + 4 * hi; }
#define SBAR() __builtin_amdgcn_sched_barrier(0)
constexpr int NSLOT = 3, SLOTB = 8192;
constexpr int LDS_K = 0, LDS_V = NSLOT * SLOTB, LDS_WS = 2 * NSLOT * SLOTB, LDS_OST = LDS_WS + NW * 64 * 4, LDS_BYTES_A = LDS_OST + NW * 4096;
__device__ __forceinline__ void glds16(const void* gsrc, unsigned lds_dst) { unsigned keep;
  asm volatile("s_mov_b32 %0, m0\n\ts_mov_b32 m0, %2\n\ts_nop 0\n\tglobal_load_lds_dwordx4 %1, off\n\ts_mov_b32 m0, %0" : "=&s"(keep) : "v"(gsrc), "s"(lds_dst) : "memory"); }
__device__ __forceinline__ float max3f(float a, float b, float c) { float r; asm("v_max3_f32 %0, %1, %2, %3" : "=v"(r) : "v"(a), "v"(b), "v"(c)); return r; }
__device__ __forceinline__ float max2f(float a, float b) { float r; asm("v_max_f32_e32 %0, %1, %2" : "=v"(r) : "v"(a), "v"(b)); return r; }
__device__ __forceinline__ float fadd_s(float a, float b) { float r; asm("v_add_f32_e32 %0, %1, %2" : "=v"(r) : "v"(a), "v"(b)); return r; }
__device__ __forceinline__ float fsub_s(float a, float b) { float r; asm("v_sub_f32_e32 %0, %1, %2" : "=v"(r) : "v"(a), "v"(b)); return r; }
typedef float f32x2_t __attribute__((ext_vector_type(2))); typedef __bf16 bf16x2_t __attribute__((ext_vector_type(2)));
__device__ __forceinline__ unsigned cvtpk_s(float lo, float hi) { f32x2_t v = {lo, hi}; bf16x2_t b = __builtin_convertvector(v, bf16x2_t); return __builtin_bit_cast(unsigned, b); }
#define WAIT_BAR(N) asm volatile("s_waitcnt vmcnt(" #N ") lgkmcnt(0)\n\ts_barrier" ::: "memory")
__device__ __forceinline__ void qkt(f32x16& p0, f32x16& p1, const char* Kslot, const bf16x8* qr, const f32x16& negm, int r32, int hi) {
  const char* kb = Kslot + hi * 1024 + r32 * 16;
  #pragma unroll
  for (int d0 = 0; d0 < 4; ++d0) {
    const bf16x8 b0 = *reinterpret_cast<const bf16x8*>(kb + d0 * 2048);
    const bf16x8 b1 = *reinterpret_cast<const bf16x8*>(kb + d0 * 2048 + 512);
    if (d0 == 0) { p0 = __builtin_amdgcn_mfma_f32_32x32x16_bf16(b0, qr[0], negm, 0, 0, 0); p1 = __builtin_amdgcn_mfma_f32_32x32x16_bf16(b1, qr[0], negm, 0, 0, 0); }
    else { p0 = __builtin_amdgcn_mfma_f32_32x32x16_bf16(b0, qr[d0], p0, 0, 0, 0); p1 = __builtin_amdgcn_mfma_f32_32x32x16_bf16(b1, qr[d0], p1, 0, 0, 0); } }
}
typedef __attribute__((address_space(3))) const char* lds_cptr;
typedef short v4i16_t __attribute__((ext_vector_type(4)));
__device__ __forceinline__ void kload8(bf16x8* kf, lds_cptr kp) {
  kf[0] = *(const LAS bf16x8*)(kp);        kf[1] = *(const LAS bf16x8*)(kp + 512);
  kf[2] = *(const LAS bf16x8*)(kp + 2048); kf[3] = *(const LAS bf16x8*)(kp + 2560);
  kf[4] = *(const LAS bf16x8*)(kp + 4096); kf[5] = *(const LAS bf16x8*)(kp + 4608);
  kf[6] = *(const LAS bf16x8*)(kp + 6144); kf[7] = *(const LAS bf16x8*)(kp + 6656);
}
__device__ __forceinline__ void kload2(bf16x8* kf, lds_cptr kp, int j) { kf[2 * j] = *(const LAS bf16x8*)(kp + j * 2048); kf[2 * j + 1] = *(const LAS bf16x8*)(kp + j * 2048 + 512); }
__device__ __forceinline__ s16x4 vtr(lds_cptr p) { return __builtin_bit_cast(s16x4, __builtin_amdgcn_ds_read_tr16_b64_v4i16((LAS v4i16_t*)p)); }
__device__ __forceinline__ float rowmax(const f32x16& p0, const f32x16& p1) {
  float a = max3f(p0[0], p0[1], p1[0]), b = max3f(p0[2], p0[3], p1[1]); a = max3f(a, p1[2], p1[3]);
  #pragma unroll
  for (int r = 4; r < 16; r += 4) { a = max3f(a, p0[r], p0[r + 1]); b = max3f(b, p0[r + 2], p0[r + 3]); a = max3f(a, p1[r], p1[r + 1]); b = max3f(b, p1[r + 2], p1[r + 3]); }
  const float m = max2f(a, b);
  auto rr = __builtin_amdgcn_permlane32_swap(__float_as_uint(m), __float_as_uint(m), false, false);
  return max2f(__uint_as_float(rr[0]), __uint_as_float(rr[1]));
}
__device__ __forceinline__ void pv(f32x16* o, int vb, bf16x8 pa0, bf16x8 pa1, bf16x8 pa2, bf16x8 pa3) {
  #pragma unroll
  for (int d0 = 0; d0 < 2; ++d0) { s16x4 lo[4], hi[4];
    #pragma unroll
    for (int ks = 0; ks < 4; ++ks) {
      asm volatile("ds_read_b64_tr_b16 %0,%1 offset:%c2" : "=&v"(lo[ks]) : "v"(vb), "i"(d0 * 4096 + ks * 1024) : "memory");
      asm volatile("ds_read_b64_tr_b16 %0,%1 offset:%c2" : "=&v"(hi[ks]) : "v"(vb), "i"(d0 * 4096 + ks * 1024 + 512) : "memory"); }
    asm volatile("s_waitcnt lgkmcnt(0)" ::: "memory"); SBAR();
    #define PK(k) (bf16x8){lo[k][0], lo[k][1], lo[k][2], lo[k][3], hi[k][0], hi[k][1], hi[k][2], hi[k][3]}
    o[d0] = __builtin_amdgcn_mfma_f32_32x32x16_bf16(pa0, PK(0), o[d0], 0, 0, 0);
    o[d0] = __builtin_amdgcn_mfma_f32_32x32x16_bf16(pa1, PK(1), o[d0], 0, 0, 0);
    o[d0] = __builtin_amdgcn_mfma_f32_32x32x16_bf16(pa2, PK(2), o[d0], 0, 0, 0);
    o[d0] = __builtin_amdgcn_mfma_f32_32x32x16_bf16(pa3, PK(3), o[d0], 0, 0, 0);
    #undef PK
  }
}
typedef const __attribute__((address_space(4))) unsigned long long* mask_cptr;
#define ATTN_STORE16(p, v) (*(u32x4*)(p) = (v))
template <int THRL> __device__ __forceinline__ void attn_unit(int wid_in, int b, int h, int qb, const bf16* Q, const bf16* __restrict__ K, const bf16* __restrict__ V, bf16* O, const unsigned long long* MT, char* shm) {
  int lane = lane_id(); asm volatile("" : "+v"(lane));
  const int r32 = lane & 31, hi = lane >> 5; const int wid = wid_in; const int tid = wid * 64 + lane; (void)tid;
  const long rowbase = (long)b * ASEQ; const int q0 = qb * QB;
  const bf16* Qw = Q + (rowbase + q0 + wid * QBLK) * ADM + h * D;
  const bf16 *Kh = K + rowbase * ADM + h * D, *Vh = V + rowbase * ADM + h * D;
  const unsigned long long mb_ = (unsigned long long)(MT + (size_t)__builtin_amdgcn_readfirstlane((b * 128 + qb * 8 + wid) * 64) * 32);
  const mask_cptr mbase = (mask_cptr)(((unsigned long long)(unsigned)__builtin_amdgcn_readfirstlane((int)(unsigned)(mb_ >> 32)) << 32) | (unsigned)__builtin_amdgcn_readfirstlane((int)(unsigned)mb_));
  const unsigned lds0 = (unsigned)(uintptr_t)shm;
  float* wsf = (float*)(shm + LDS_WS) + wid * 64;
  const bf16* ksrc = Kh + (long)lane * ADM + wid * 8;
  const bf16* vsrc = Vh + (long)(16 * (wid & 3) + (lane >> 2)) * ADM + (wid >> 2) * 32 + (lane & 3) * 8;
  const unsigned kdst = lds0 + LDS_K + wid * 1024, vdst = lds0 + LDS_V + wid * 1024;
  #define DMA_K(t, slot) glds16(ksrc + (long)(t) * KVBLK * ADM, (unsigned)__builtin_amdgcn_readfirstlane(kdst + (slot)))
  #define DMA_V(t, slot) glds16(vsrc + (long)(t) * KVBLK * ADM, (unsigned)__builtin_amdgcn_readfirstlane(vdst + (slot)))
  const int vb0 = (int)(lds0 + LDS_V) + ((lane >> 4) & 1) * 32 + (lane & 3) * 8 + (4 * hi + ((lane & 15) >> 2)) * 64;
  const char* Kbase = shm + LDS_K; bf16x8 kf[8];
  const lds_cptr shm3 = (lds_cptr)shm; const lds_cptr kp0 = shm3 + LDS_K + hi * 1024 + r32 * 16; const lds_cptr vp0 = shm3 + LDS_V + ((lane >> 4) & 1) * 32 + (lane & 3) * 8 + (4 * hi + ((lane & 15) >> 2)) * 64;
  const int NT = (q0 + QB) / KVBLK;
  DMA_K(0, 0); DMA_V(0, 0); DMA_K(1, SLOTB);
  bf16x8 qr[4];
  #pragma unroll
  for (int d0 = 0; d0 < 4; ++d0) qr[d0] = *reinterpret_cast<const bf16x8*>(&Qw[(long)r32 * ADM + d0 * 16 + hi * 8]);
  float mhat = 0.f, l_reg = 0.f; f32x16 o[2]; o[0] = f32x16{}; o[1] = f32x16{}; f32x16 negm = f32x16{}; asm volatile("" : "+v"(negm));
  float NEGV = -INFINITY; asm volatile("" : "+v"(NEGV));
  typedef unsigned long long u64x8_t __attribute__((ext_vector_type(8)));
  typedef const __attribute__((address_space(4))) u64x8_t* mask8_cptr;
  #define MLOAD(t) const mask8_cptr mp8_ = (mask8_cptr)(mbase + (size_t)(t) * 32); const u64x8_t mk0_ = mp8_[0], mk1_ = mp8_[1], mk2_ = mp8_[2], mk3_ = mp8_[3]
  #define CMASK(P0, P1) do { \
    asm volatile("s_nop 15\n\ts_nop 7" : "+v"(P0), "+v"(P1)); \
    _Pragma("unroll") for (int r_ = 0; r_ < 8; ++r_) { const unsigned long long a_ = mk0_[r_], b_ = mk1_[r_], c_ = mk2_[r_], d_ = mk3_[r_]; \
      asm("v_cndmask_b32_e64 %0, %1, %0, %2" : "+v"(P0[r_]) : "v"(NEGV), "s"(a_)); \
      asm("v_cndmask_b32_e64 %0, %1, %0, %2" : "+v"(P0[8 + r_]) : "v"(NEGV), "s"(b_)); \
      asm("v_cndmask_b32_e64 %0, %1, %0, %2" : "+v"(P1[r_]) : "v"(NEGV), "s"(c_)); \
      asm("v_cndmask_b32_e64 %0, %1, %0, %2" : "+v"(P1[8 + r_]) : "v"(NEGV), "s"(d_)); } } while (0)
  bool resc = false;
  #define START(P0, P1) do { const float rm = rowmax(P0, P1); resc = false; \
    { const float dl = (rm == -INFINITY) ? 0.f : rm; mhat = fadd_s(mhat, dl); \
      _Pragma("unroll") for (int r = 0; r < 16; ++r) { P0[r] = fsub_s(P0[r], dl); P1[r] = fsub_s(P1[r], dl); } \
      _Pragma("unroll") for (int r = 0; r < 16; ++r) negm[r] = -mhat; asm volatile("" : "+v"(negm)); } \
    _Pragma("unroll") for (int r = 0; r < 16; ++r) P0[r] = __builtin_amdgcn_exp2f(P0[r]); } while (0)
  #define RESC() do { if (resc) { asm volatile("s_waitcnt lgkmcnt(0)" ::: "memory"); \
      _Pragma("unroll") for (int d_ = 0; d_ < 2; ++d_) _Pragma("unroll") for (int r = 0; r < 16; ++r) o[d_][r] *= wsf[crow(r, hi)]; } } while (0)
  f32x16 pA0, pA1, pB0, pB1;
  int sl_prev = 0, sl_cur = 0, sl_next = SLOTB;
  #define ROT() do { sl_prev = sl_cur; sl_cur = sl_next; sl_next = (sl_next == (NSLOT - 1) * SLOTB) ? 0 : sl_next + SLOTB; } while (0)
  DMA_K(2, 2 * SLOTB);
  WAIT_BAR(3);
  { MLOAD(0); qkt(pA0, pA1, Kbase, qr, negm, r32, hi); CMASK(pA0, pA1); }
  START(pA0, pA1);
  _Pragma("unroll") for (int r = 0; r < 16; ++r) pA1[r] = __builtin_amdgcn_exp2f(pA1[r]);
  WAIT_BAR(0);
  DMA_K(3, 0); DMA_V(1, SLOTB);
  ROT();
  kload8(kf, kp0 + sl_cur);
  WAIT_BAR(2);
  s16x4 vlo[8], vhi[8]; u32x4 pw0, pw1, pw2, pw3;
  #define PKW(P, B) cvtpk_s(P[B], P[B + 1])
  #define PAF(k) __builtin_bit_cast(bf16x8, pw##k)
  #define VFR(i) (bf16x8){vlo[i][0], vlo[i][1], vlo[i][2], vlo[i][3], vhi[i][0], vhi[i][1], vhi[i][2], vhi[i][3]}
  #define PIN(x) asm volatile("" : "+v"(x))
  #define MX3(a, b, c) __builtin_fmaxf(__builtin_fmaxf((a), (b)), (c))
  #define GAPA(MF, A0, A1, A2, A3, W0, W1, PW) do { MF; sacc += A0; sacc += A1; sacc += A2; sacc += A3; PIN(sacc); W0; W1; PIN(PW); SBAR(); } while (0)
  #define EX(v) __builtin_amdgcn_exp2f(v)
  #define GAPB(MF, X, B) do { MF; X[B] = EX(X[B]); X[B + 1] = EX(X[B + 1]); X[B + 2] = EX(X[B + 2]); X[B + 3] = EX(X[B + 3]); PIN(X); SBAR(); } while (0)
  #define VRD(i) do { vlo[i] = vtr(vp_ + (((i) >> 2) * 4096 + ((i) & 3) * 1024)); vhi[i] = vtr(vp_ + (((i) >> 2) * 4096 + ((i) & 3) * 1024 + 512)); } while (0)
  #define KRD(G, j) do { if (G) { kload2(kf, kp0 + sl_next, j); SBAR(); } } while (0)
  #define STEP(C0, C1, P0, P1, t, GK, GV, GL) do { MLOAD(t); SBAR(); \
    const lds_cptr vp_ = vp0 + sl_prev; \
    VRD(0); SBAR(); float sacc = (P0[0] + P0[1]); \
    GAPA(C0 = __builtin_amdgcn_mfma_f32_32x32x16_bf16(kf[0], qr[0], negm, 0, 0, 0), P0[2], P0[3], P0[4], P0[5],     pw0[0] = PKW(P0, 0), pw0[1] = PKW(P0, 2), pw0); \
    VRD(4); SBAR(); GAPA(C1 = __builtin_amdgcn_mfma_f32_32x32x16_bf16(kf[1], qr[0], negm, 0, 0, 0), P0[6], P0[7], P0[8], P0[9],     pw0[2] = PKW(P0, 4), pw0[3] = PKW(P0, 6), pw0); \
    VRD(1); SBAR(); GAPA(C0 = __builtin_amdgcn_mfma_f32_32x32x16_bf16(kf[2], qr[1], C0, 0, 0, 0),   P0[10], P0[11], P0[12], P0[13], pw1[0] = PKW(P0, 8), pw1[1] = PKW(P0, 10), pw1); \
    VRD(5); SBAR(); GAPA(C1 = __builtin_amdgcn_mfma_f32_32x32x16_bf16(kf[3], qr[1], C1, 0, 0, 0),   P0[14], P0[15], P1[0], P1[1],   pw1[2] = PKW(P0, 12), pw1[3] = PKW(P0, 14), pw1); \
    VRD(2); SBAR(); GAPA(C0 = __builtin_amdgcn_mfma_f32_32x32x16_bf16(kf[4], qr[2], C0, 0, 0, 0),   P1[2], P1[3], P1[4], P1[5],     pw2[0] = PKW(P1, 0), pw2[1] = PKW(P1, 2), pw2); \
    VRD(6); SBAR(); GAPA(C1 = __builtin_amdgcn_mfma_f32_32x32x16_bf16(kf[5], qr[2], C1, 0, 0, 0),   P1[6], P1[7], P1[8], P1[9],     pw2[2] = PKW(P1, 4), pw2[3] = PKW(P1, 6), pw2); \
    VRD(3); SBAR(); GAPA(C0 = __builtin_amdgcn_mfma_f32_32x32x16_bf16(kf[6], qr[3], C0, 0, 0, 0),   P1[10], P1[11], P1[12], P1[13], pw3[0] = PKW(P1, 8), pw3[1] = PKW(P1, 10), pw3); \
    VRD(7); SBAR(); GAPA(C1 = __builtin_amdgcn_mfma_f32_32x32x16_bf16(kf[7], qr[3], C1, 0, 0, 0),   P1[14], P1[15], 0.f, 0.f,       pw3[2] = PKW(P1, 12), pw3[3] = PKW(P1, 14), pw3); \
    l_reg += sacc; \
    if (GK) { DMA_K((t) + 3, sl_cur); } if (GV) { DMA_V((t) + 1, sl_next); } \
    CMASK(C0, C1); \
    { float a = MX3(C0[0], C0[1], C1[0]), b = MX3(C0[2], C0[3], C1[1]); a = MX3(a, C1[2], C1[3]); \
      _Pragma("unroll") for (int r = 4; r < 16; r += 4) { a = MX3(a, C0[r], C0[r + 1]); b = MX3(b, C0[r + 2], C0[r + 3]); a = MX3(a, C1[r], C1[r + 1]); b = MX3(b, C1[r + 2], C1[r + 3]); } \
      float rm = __builtin_fmaxf(a, b); { auto rr = __builtin_amdgcn_permlane32_swap(__float_as_uint(rm), __float_as_uint(rm), false, false); rm = __builtin_fmaxf(__uint_as_float(rr[0]), __uint_as_float(rr[1])); } \
      resc = false; \
      if (__builtin_expect(__any(rm > (float)THRL), 0)) { const float dl = __builtin_fmaxf(rm, 0.f); mhat += dl; \
        _Pragma("unroll") for (int r = 0; r < 16; ++r) { C0[r] -= dl; C1[r] -= dl; } \
        _Pragma("unroll") for (int r = 0; r < 16; ++r) negm[r] = -mhat; asm volatile("" : "+v"(negm)); \
        const float f = __builtin_amdgcn_exp2f(-dl); l_reg *= f; if (hi == 0) wsf[r32] = f; resc = true; } } \
    SBAR(); \
    GAPB(o[0] = __builtin_amdgcn_mfma_f32_32x32x16_bf16(PAF(0), VFR(0), o[0], 0, 0, 0), C0, 0); \
    GAPB(o[1] = __builtin_amdgcn_mfma_f32_32x32x16_bf16(PAF(0), VFR(4), o[1], 0, 0, 0), C0, 4); \
    KRD(GL, 0); GAPB(o[0] = __builtin_amdgcn_mfma_f32_32x32x16_bf16(PAF(1), VFR(1), o[0], 0, 0, 0), C0, 8); \
    KRD(GL, 1); GAPB(o[1] = __builtin_amdgcn_mfma_f32_32x32x16_bf16(PAF(1), VFR(5), o[1], 0, 0, 0), C0, 12); \
    KRD(GL, 2); GAPB(o[0] = __builtin_amdgcn_mfma_f32_32x32x16_bf16(PAF(2), VFR(2), o[0], 0, 0, 0), C1, 0); \
    KRD(GL, 3); GAPB(o[1] = __builtin_amdgcn_mfma_f32_32x32x16_bf16(PAF(2), VFR(6), o[1], 0, 0, 0), C1, 4); \
    GAPB(o[0] = __builtin_amdgcn_mfma_f32_32x32x16_bf16(PAF(3), VFR(3), o[0], 0, 0, 0), C1, 8); \
    GAPB(o[1] = __builtin_amdgcn_mfma_f32_32x32x16_bf16(PAF(3), VFR(7), o[1], 0, 0, 0), C1, 12); \
    } while (0)
  int t = 1;
  for (; t + 5 < NT; t += 2) {
    STEP(pB0, pB1, pA0, pA1, t, true, true, true);     WAIT_BAR(2); RESC(); ROT();
    STEP(pA0, pA1, pB0, pB1, t + 1, true, true, true); WAIT_BAR(2); RESC(); ROT();
  }
  #define ENDW(tt) do { if ((tt) + 3 < NT) { WAIT_BAR(2); } else if ((tt) + 2 < NT) { WAIT_BAR(1); } else { WAIT_BAR(0); } } while (0)
  for (; t + 1 < NT; t += 2) {
    STEP(pB0, pB1, pA0, pA1, t, (t + 3 < NT), (t + 1 < NT), (t + 1 < NT));         ENDW(t);     RESC(); ROT();
    STEP(pA0, pA1, pB0, pB1, t + 1, (t + 4 < NT), (t + 2 < NT), (t + 2 < NT));     ENDW(t + 1); RESC(); ROT();
  }
  STEP(pB0, pB1, pA0, pA1, NT - 1, false, false, false); RESC();
  { float sacc = pB0[0] + pB0[1]; _Pragma("unroll") for (int r = 2; r < 16; ++r) sacc += pB0[r]; _Pragma("unroll") for (int r = 0; r < 16; ++r) sacc += pB1[r]; l_reg += sacc;
    pw0 = (u32x4){PKW(pB0, 0), PKW(pB0, 2), PKW(pB0, 4), PKW(pB0, 6)}; pw1 = (u32x4){PKW(pB0, 8), PKW(pB0, 10), PKW(pB0, 12), PKW(pB0, 14)}; pw2 = (u32x4){PKW(pB1, 0), PKW(pB1, 2), PKW(pB1, 4), PKW(pB1, 6)}; pw3 = (u32x4){PKW(pB1, 8), PKW(pB1, 10), PKW(pB1, 12), PKW(pB1, 14)};
    SBAR(); pv(o, vb0 + sl_cur, PAF(0), PAF(1), PAF(2), PAF(3)); }
  #undef PKW
  #undef PAF
  #undef VFR
  #undef PIN
  #undef MX3
  #undef GAPA
  #undef GAPB
  #undef EX
  #undef VRD
  #undef KRD
  #undef STEP
  #undef ENDW
  { auto rr = __builtin_amdgcn_permlane32_swap(__float_as_uint(l_reg), __float_as_uint(l_reg), false, false); l_reg = __uint_as_float(rr[0]) + __uint_as_float(rr[1]); }
  if (hi == 0) wsf[32 + r32] = l_reg; asm volatile("s_waitcnt lgkmcnt(0)" ::: "memory");
  float rli[16];
  #pragma unroll
  for (int r = 0; r < 16; ++r) rli[r] = __builtin_amdgcn_rcpf(wsf[32 + crow(r, hi)]);
  bf16* Ow = O + (rowbase + q0 + wid * QBLK) * OPITCH + h * D;
  { bf16* stg = (bf16*)(shm + LDS_OST) + wid * 2048;
    #pragma unroll
    for (int r = 0; r < 16; ++r) { const int orow = crow(r, hi);
      #pragma unroll
      for (int d0 = 0; d0 < 2; ++d0) stg[orow * 64 + d0 * 32 + r32] = __float2bfloat16(o[d0][r] * rli[r]); }
    asm volatile("s_waitcnt lgkmcnt(0)" ::: "memory");
    #pragma unroll
    for (int i = 0; i < 4; ++i) { const int row = i * 8 + (lane >> 3), ch = lane & 7; const u32x4 v = *(const u32x4*)(stg + row * 64 + ch * 8); ATTN_STORE16(Ow + (long)row * OPITCH + ch * 8, v); } }
  asm volatile("s_waitcnt lgkmcnt(0)\n\ts_barrier" ::: "memory");
  #undef DMA_K
  #undef DMA_V
  #undef CMASK
  #undef START
  #undef RESC
  #undef ROT
}
#undef SBAR
#undef WAIT_BAR
}

#define XB_TMO      128
#define XB_XCNT(j)  (256  + 64 * (j))
#define XB_XSUB(j)  (1280 + 64 * (j))
#define XB_XGEN(j)  (2304 + 64 * (j))
#define XB_TOP      3328
#define XB_TOPGEN   3392
#define XCD_BAR_WORDS 3456
#define XB_SPIN_CAP (1u << 18)
__device__ __forceinline__ unsigned xb_ld(unsigned* p)              { return __hip_atomic_load(p, __ATOMIC_RELAXED, __HIP_MEMORY_SCOPE_AGENT); }
__device__ __forceinline__ unsigned xb_add(unsigned* p, unsigned v) { return __hip_atomic_fetch_add(p, v, __ATOMIC_RELAXED, __HIP_MEMORY_SCOPE_AGENT); }
__device__ __forceinline__ unsigned xb_xcc_id() { return (unsigned)__builtin_amdgcn_s_getreg((3 << 11) | 20) & 0xFu; }
#define XB_SPIN(cond, bar) do { unsigned _sp = 0; while (cond) { __builtin_amdgcn_s_sleep(1); \
    if ((++_sp & 255u) == 0u) { if (xb_ld(&(bar)[XB_TMO])) break; if (_sp > XB_SPIN_CAP) { atomicAdd(&(bar)[XB_TMO], 1u); break; } } } } while (0)
struct XcdBarrier { unsigned* bar; unsigned x; volatile LAS unsigned* st; };
__device__ __forceinline__ XcdBarrier xcd_barrier_post(unsigned* bar, volatile LAS unsigned* st, bool leader) {
    XcdBarrier b; b.bar = bar; b.x = xb_xcc_id(); b.st = st;
    if (leader) st[2] = xb_add(&bar[XB_XCNT(b.x)], 1u);
    return b;
}
__device__ __forceinline__ void xcd_barrier_complete(unsigned* bar, unsigned x, unsigned& nloc, unsigned& nx) {
    const unsigned G = gridDim.x * gridDim.y * gridDim.z;
    unsigned sum, cnt, mine, sp = 0u;
    for (;;) {
        sum = 0u; cnt = 0u; mine = 0u;
#pragma unroll
        for (unsigned j = 0; j < 16; ++j) { const unsigned c = xb_ld(&bar[XB_XCNT(j)]); sum += c; cnt += (c > 0u) ? 1u : 0u; mine = (j == x) ? c : mine; }
        if (sum == G) break;
        __builtin_amdgcn_s_sleep(1);
        if ((++sp & 255u) == 0u) { if (xb_ld(&bar[XB_TMO])) break; if (sp > XB_SPIN_CAP) { atomicAdd(&bar[XB_TMO], 1u); break; } }
    }
    nloc = mine > 0u ? mine : 1u; nx = cnt > 0u ? cnt : 1u;
}
__device__ __forceinline__ void xcd_barrier(const XcdBarrier& b, bool leader) {
    asm volatile("s_waitcnt vmcnt(0)" ::: "memory");
    __syncthreads();
    if (leader) {
        unsigned* bar = b.bar;
        __builtin_amdgcn_s_waitcnt(0);
        unsigned nloc = b.st[0], nx = b.st[1];
        if (nloc == 0u) { xcd_barrier_complete(bar, b.x, nloc, nx); b.st[0] = nloc; b.st[1] = nx; }
#ifdef DBG_WG_RELEASE
        __builtin_amdgcn_fence(__ATOMIC_RELEASE, "agent"); asm volatile("s_waitcnt vmcnt(0)" ::: "memory");
#endif
        const unsigned old = xb_add(&bar[XB_XSUB(b.x)], 1u);
        const unsigned gen = old / nloc;
        if (old + 1u == (gen + 1u) * nloc) {
            __builtin_amdgcn_fence(__ATOMIC_RELEASE, "agent");
            asm volatile("s_waitcnt vmcnt(0)" ::: "memory");
            const unsigned og = xb_add(&bar[XB_TOP], 1u);
            const unsigned tg = og / nx;
            if (og + 1u == (tg + 1u) * nx) xb_add(&bar[XB_TOPGEN], 1u);
            else XB_SPIN(xb_ld(&bar[XB_TOPGEN]) == tg, bar);
            __builtin_amdgcn_fence(__ATOMIC_ACQUIRE, "agent");
            xb_add(&bar[XB_XGEN(b.x)], 1u);
            asm volatile("s_waitcnt vmcnt(0)" ::: "memory");
        } else {
            XB_SPIN(xb_ld(&bar[XB_XGEN(b.x)]) == gen, bar);
            __builtin_amdgcn_fence(__ATOMIC_ACQUIRE, "agent");
            asm volatile("s_waitcnt vmcnt(0)" ::: "memory");
        }
    }
    __syncthreads();
}

struct Frame {
    LAS unsigned char* lds; volatile LAS unsigned* MISC; unsigned* ctl; unsigned char* ws;
    int tid, lane, wave, vcu, G;
    const float* const __attribute__((address_space(4)))* in; float* out;
};
constexpr int NWAVES = 8;

__device__ __forceinline__ void transpose_item(const float* W, int ldw, bf16_t* WT, int K, LAS float* scr, int k0, int n0, int src, int lane, int dk0 = 0) {
    float v[32];
    const float* wp = W + (size_t)(k0 + (lane >> 5)) * ldw + (src >= 0 ? src : 0);
#pragma unroll
    for (int i = 0; i < 32; ++i) v[i] = wp[(size_t)(2 * i) * ldw];
#pragma unroll
    for (int i = 0; i < 32; ++i) { const int kk = 2 * i + (lane >> 5); scr[kk * 33 + (lane & 31)] = (src >= 0) ? v[i] : 0.f; }
    LDS_WAIT(); asm volatile("" ::: "memory");
    const int c = lane & 7;
#pragma unroll
    for (int j = 0; j < 4; ++j) { const int n = (lane >> 3) + 8 * j; const LAS float* s = scr + (8 * c) * 33 + n;
        u32x4 o; o.x = cvt_pk_bf16(s[0 * 33], s[1 * 33]); o.y = cvt_pk_bf16(s[2 * 33], s[3 * 33]); o.z = cvt_pk_bf16(s[4 * 33], s[5 * 33]); o.w = cvt_pk_bf16(s[6 * 33], s[7 * 33]);
        *(u32x4*)(WT + (size_t)(n0 + n) * K + dk0 + k0 + 8 * c) = o; }
    LDS_WAIT(); asm volatile("" ::: "memory");
}
__device__ __forceinline__ void transpose_item8(const float* W, int ldw, unsigned char* WT, int K, LAS float* scr, int k0, int n0, int src, int lane) {
    float v[32];
    const float* wp = W + (size_t)(k0 + (lane >> 5)) * ldw + (src >= 0 ? src : 0);
#pragma unroll
    for (int i = 0; i < 32; ++i) v[i] = wp[(size_t)(2 * i) * ldw];
#pragma unroll
    for (int i = 0; i < 32; ++i) { const int kk = 2 * i + (lane >> 5); scr[kk * 33 + (lane & 31)] = (src >= 0) ? v[i] * 64.f : 0.f; }
    LDS_WAIT(); asm volatile("" ::: "memory");
    const int c = lane & 3;
#pragma unroll
    for (int j = 0; j < 2; ++j) { const int n = (lane >> 2) + 16 * j; const LAS float* s = scr + (16 * c) * 33 + n;
        u32x4 o;
#pragma unroll
        for (int d = 0; d < 4; ++d) o[d] = cvt_pk_fp8x4(s[(4 * d) * 33], s[(4 * d + 1) * 33], s[(4 * d + 2) * 33], s[(4 * d + 3) * 33]);
        *(u32x4*)(WT + (size_t)(n0 + n) * K + k0 + 16 * c) = o; }
    LDS_WAIT(); asm volatile("" ::: "memory");
}
__device__ __forceinline__ int rope_perm(int p) { return (p < 16) ? ((p >> 1) + 8 * (p & 1)) : p; }
__device__ __forceinline__ int w1_src(int n) {
    if (n < 2048) { const int seg = n >> 9, o = n & 511, h = o >> 6; int p = o & 63; if (seg != 2) p = rope_perm(p); return seg * 512 + h * 64 + p; }
    if (n < 2304) return 2120 + (n - 2048);
    if (n < 2560) return 2376 + (n - 2304);
    const int o = n - 2560;
    if (o < 64) return 2048 + rope_perm(o);
    if (o < 72) return 2112 + (o - 64);
    return -1;
}
struct ConvItem { const float* wp; int ldw; unsigned char* op8; unsigned ldoff, stoff; };
constexpr int I_UP = 32 * 8 * 128, I_DN = 32 * 8 * 64, NCONV = I_UP + I_DN;
__device__ __forceinline__ ConvItem conv_expert_decode(Frame& F, int r_in, int lane) {
    const int r0 = __builtin_amdgcn_readfirstlane(r_in); const int h = lane >> 4, n = lane & 15; ConvItem c;
    if (r0 < I_UP) { const int e = r0 >> 10, q = r0 & 1023, kb = q >> 7, nb = q & 127, nn0 = nb * 16, tile = nn0 >> 8, o0 = nn0 & 255;
        const int src0 = (o0 < 128) ? tile * 128 + o0 : 1024 + tile * 128 + (o0 - 128);
        c.ldw = 2048; c.wp = F.in[17] + (size_t)e * 1024 * 2048 + (size_t)(kb * 128) * 2048 + src0;
        c.op8 = (unsigned char*)(F.ws + WS_WUP) + (size_t)e * 2048 * 1024 + (size_t)(nb * 16) * 1024 + kb * 128; }
    else { const int r = r0 - I_UP, e = r >> 9, q = r & 511, kb = q >> 6, nb = q & 63;
        c.ldw = 1024; c.wp = F.in[19] + (size_t)e * 1024 * 1024 + (size_t)(kb * 128) * 1024 + nb * 16;
        c.op8 = (unsigned char*)(F.ws + WS_WDN) + (size_t)e * 1024 * 1024 + (size_t)(nb * 16) * 1024 + kb * 128; }
    c.ldoff = (unsigned)(32 * h * c.ldw + n); c.stoff = (unsigned)(n * 1024 + 32 * h);
    return c;
}
__device__ __forceinline__ void conv_load(const ConvItem& c, float (&v)[32], int lane) {
#pragma unroll
    for (int i = 0; i < 32; ++i) { const float* rowp = c.wp + (size_t)(i * c.ldw); v[i] = rowp[c.ldoff]; }
}
__device__ __forceinline__ void conv_store(const ConvItem& c, const float (&v)[32], int lane) {
    u32x4 o0, o1;
#pragma unroll
    for (int d = 0; d < 4; ++d) { o0[d] = cvt_pk_fp8x4(v[4 * d] * 64.f, v[4 * d + 1] * 64.f, v[4 * d + 2] * 64.f, v[4 * d + 3] * 64.f);
                                  o1[d] = cvt_pk_fp8x4(v[16 + 4 * d] * 64.f, v[17 + 4 * d] * 64.f, v[18 + 4 * d] * 64.f, v[19 + 4 * d] * 64.f); }
    unsigned char* op = c.op8 + c.stoff;
    *(u32x4*)op = o0; *(u32x4*)(op + 16) = o1;
}
__device__ __forceinline__ void conv_expert_items3(Frame& F, int cid0, int stride, int lane) {
    float v0[32], v1[32], v2[32]; ConvItem c0, c1, c2;
    const bool h0 = cid0 < NCONV, h1 = cid0 + stride < NCONV, h2 = cid0 + 2 * stride < NCONV;
    if (h0) { c0 = conv_expert_decode(F, cid0, lane); conv_load(c0, v0, lane); }
    if (h1) { c1 = conv_expert_decode(F, cid0 + stride, lane); conv_load(c1, v1, lane); }
    if (h2) { c2 = conv_expert_decode(F, cid0 + 2 * stride, lane); conv_load(c2, v2, lane); }
    if (h0) conv_store(c0, v0, lane);
    if (h1) conv_store(c1, v1, lane);
    if (h2) conv_store(c2, v2, lane);
}
__device__ __forceinline__ void rms_row_to_fp8(const float* xrow, const float* g, unsigned char* orow, int lane, bf16_t* orow16 = nullptr) {
    const f32x4* xr = (const f32x4*)xrow + lane; const f32x4* gr = (const f32x4*)g + lane;
    f32x4 v[4]; float s = 0.f;
#pragma unroll
    for (int j = 0; j < 4; ++j) { v[j] = xr[64 * j]; s += (v[j].x * v[j].x + v[j].y * v[j].y) + (v[j].z * v[j].z + v[j].w * v[j].w); }
    const float rstd = 1.f / sqrtf(wave_sum(s) * (1.f / 1024.f) + EPS);
    unsigned* o4 = (unsigned*)orow + lane;
#pragma unroll
    for (int j = 0; j < 4; ++j) { const f32x4 gg = gr[64 * j]; const float a = v[j].x * rstd * gg.x, b = v[j].y * rstd * gg.y, c = v[j].z * rstd * gg.z, d = v[j].w * rstd * gg.w;
        o4[64 * j] = cvt_pk_fp8x4(a, b, c, d);
        if (orow16) { u32x2 w; w.x = cvt_pk_bf16(a, b); w.y = cvt_pk_bf16(c, d); ((u32x2*)orow16 + lane)[64 * j] = w; } }
}
__device__ __forceinline__ void rms_row_to_bf16(const float* xrow, const float* g, bf16_t* orow, int lane) {
    const f32x4* xr = (const f32x4*)xrow + lane; const f32x4* gr = (const f32x4*)g + lane;
    f32x4 v[4]; float s = 0.f;
#pragma unroll
    for (int j = 0; j < 4; ++j) { v[j] = xr[64 * j]; s += (v[j].x * v[j].x + v[j].y * v[j].y) + (v[j].z * v[j].z + v[j].w * v[j].w); }
    const float rstd = 1.f / sqrtf(wave_sum(s) * (1.f / 1024.f) + EPS);
    u32x2* o8 = (u32x2*)orow + lane;
#pragma unroll
    for (int j = 0; j < 4; ++j) { const f32x4 gg = gr[64 * j]; u32x2 w; w.x = cvt_pk_bf16(v[j].x * rstd * gg.x, v[j].y * rstd * gg.y); w.y = cvt_pk_bf16(v[j].z * rstd * gg.z, v[j].w * rstd * gg.w); o8[64 * j] = w; }
}
__device__ __forceinline__ void p0_prologue(Frame& F) {
    LAS float* scr = (LAS float*)(F.lds + F.wave * 16384);
    const int gw = F.vcu * NWAVES + F.wave, NGW = F.G * NWAVES, lane = F.lane;
    unsigned char* ws = F.ws;
    constexpr int I_IN = 16 * 88, I_GT = 16 * 96, I_PA = 8 * 32, I_PP = 4 * 32, I_PM = 4 * 32, I_OUT = 16 * 32, I_KV = 16 * 16, I_WU = 16 * 8;
    constexpr int NITEMS = I_UP + I_DN + I_IN + I_GT + I_PA + I_PP + I_PM + I_OUT + I_KV + I_WU;
    for (int it = gw + I_UP + I_DN; it < NITEMS; it += NGW) {
        int r = it;
        if (r < I_UP) { const int e = r >> 10, q = r & 1023, kb = q >> 6, nb = q & 63, n = nb * 32 + (lane & 31), tile = n >> 8, o = n & 255;
            const int src = (o < 128) ? tile * 128 + o : 1024 + tile * 128 + (o - 128);
            transpose_item(F.in[17] + (size_t)e * 1024 * 2048, 2048, (bf16_t*)(ws + WS_WUP) + (size_t)e * 2048 * 1024, 1024, scr, kb * 64, nb * 32, src, lane); continue; } r -= I_UP;
        if (r < I_DN) { const int e = r >> 9, q = r & 511, kb = q >> 5, nb = q & 31;
            transpose_item(F.in[19] + (size_t)e * 1024 * 1024, 1024, (bf16_t*)(ws + WS_WDN) + (size_t)e * 1024 * 1024, 1024, scr, kb * 64, nb * 32, nb * 32 + (lane & 31), lane); continue; } r -= I_DN;
        if (r < I_IN) { const int kb = r / 88, nb = r % 88;
            transpose_item8(F.in[3], 2632, (unsigned char*)(ws + WS_W1T), 1024, scr, kb * 64, nb * 32, w1_src(nb * 32 + (lane & 31)), lane); continue; } r -= I_IN;
        if (r < I_GT) { const int kb = r / 96, nb = r % 96;
            transpose_item8(F.in[4], 3072, (unsigned char*)(ws + WS_W1T) + (size_t)N1_IN * 1024, 1024, scr, kb * 64, nb * 32, nb * 32 + (lane & 31), lane); continue; } r -= I_GT;
        if (r < I_PA) { const int kb = r >> 5, nb = r & 31;
            transpose_item(F.in[6], 1024, (bf16_t*)(ws + WS_WCAT), 1024, scr, kb * 64, nb * 32, nb * 32 + (lane & 31), lane, 0); continue; } r -= I_PA;
        if (r < I_PP) { const int kb = r >> 5, nb = r & 31;
            transpose_item(F.in[7], 1024, (bf16_t*)(ws + WS_WCAT), 1024, scr, kb * 64, nb * 32, nb * 32 + (lane & 31), lane, 512); continue; } r -= I_PP;
        if (r < I_PM) { const int kb = r >> 5, nb = r & 31;
            transpose_item(F.in[8], 1024, (bf16_t*)(ws + WS_WCAT), 1024, scr, kb * 64, nb * 32, nb * 32 + (lane & 31), lane, 768); continue; } r -= I_PM;
        if (r < I_OUT) { const int kb = r >> 5, nb = r & 31;
            transpose_item(F.in[13], 1024, (bf16_t*)(ws + WS_WOUT), 1024, scr, kb * 64, nb * 32, nb * 32 + (lane & 31), lane); continue; } r -= I_OUT;
        if (r < I_KV) { const int kb = r >> 4, nb = r & 15;
            transpose_item8(F.in[12], 512, (unsigned char*)(ws + WS_WKV), 1024, scr, kb * 64, nb * 32, nb * 32 + (lane & 31), lane); continue; } r -= I_KV;
        { const int kb = r >> 3, nb = r & 7;
            transpose_item(F.in[3], 2632, (bf16_t*)(ws + WS_WU), 1024, scr, kb * 64, nb * 32, 2120 + nb * 32 + (lane & 31), lane); }
    }
    for (int m = gw; m < NTOK; m += NGW) rms_row_to_fp8(F.in[0] + (size_t)m * 1024, F.in[2], (unsigned char*)(ws + WS_XN) + (size_t)m * 1024, lane, (bf16_t*)(ws + WS_XNB) + (size_t)m * 1024);
    for (int m = gw; m < NB * 256; m += NGW) rms_row_to_fp8(F.in[1] + (size_t)m * 1024, F.in[11], (unsigned char*)(ws + WS_MEMN) + (size_t)m * 1024, lane);
    const int gt = gw * 64 + lane, NGT = NGW * 64;
    for (int i = gt; i < SEQ * 8; i += NGT) { const int pos = i >> 3, j = i & 7; const float inv = powf(500000.0f, -(float)j / 8.0f); const float ang = (float)pos * inv; float s, c; sincosf(ang, &s, &c);
        ((f32x2*)(ws + WS_ROPE))[i] = (f32x2){c, s}; }
    for (int i = gt; i < 4 * 64 * 64; i += NGT) { const int g = i >> 12, d = (i >> 6) & 63, c = i & 63;
        ((bf16_t*)(ws + WS_WGT))[i] = (bf16_t)(cvt_pk_bf16(F.in[9][(g * 64 + c) * 64 + d], 0.f) & 0xffffu); }
    for (int i = gt; i < 32 * 1024; i += NGT) { const int e = i >> 10, k = i & 1023; const float w = F.in[14][k] * F.in[15][k * 32 + e];
        const unsigned hb = cvt_pk_bf16(w, 0.f) & 0xffffu; const float lo = w - bf2f((unsigned short)hb);
        ((bf16_t*)(ws + WS_WRH))[i] = (bf16_t)hb; ((bf16_t*)(ws + WS_WRL))[i] = (bf16_t)(cvt_pk_bf16(lo, 0.f) & 0xffffu); }
}

__device__ __forceinline__ void p1_memkv(Frame& F) {
    const unsigned char* MEMN = (const unsigned char*)(F.ws + WS_MEMN); const unsigned char* WKV = (const unsigned char*)(F.ws + WS_WKV);
    bf16_t* KM = (bf16_t*)(F.ws + WS_KM); bf16_t* VMT = (bf16_t*)(F.ws + WS_VMT);
    const int lane = F.lane, fr = lane & 15, fq = lane >> 4;
    for (int tw = F.vcu * NWAVES + F.wave; tw < 64 * 32; tw += F.G * NWAVES) {
        const int mr = tw >> 5, nc = tw & 31;
        const unsigned char* ap = MEMN + (size_t)(16 * mr + fr) * 1024 + 32 * fq; const unsigned char* bp = WKV + (size_t)(16 * nc + fr) * 1024 + 32 * fq;
        pg8::v8i_t av[8], bv[8];
#pragma unroll
        for (int ks = 0; ks < 8; ++ks) { av[ks] = *(const pg8::v8i_t*)(ap + 128 * ks); bv[ks] = *(const pg8::v8i_t*)(bp + 128 * ks); }
        f32x4 acc = (f32x4){0.f, 0.f, 0.f, 0.f};
#pragma unroll
        for (int ks = 0; ks < 8; ++ks) acc = __builtin_amdgcn_mfma_scale_f32_16x16x128_f8f6f4(bv[ks], av[ks], acc, 0, 0, 0, 0, 0, 0);
        const int row = 16 * mr + fr, col = 16 * nc + 4 * fq; const float sc = 1.f / 64.f;
        if (col < 256) { u32x2 w; w.x = cvt_pk_bf16(acc[0] * sc, acc[1] * sc); w.y = cvt_pk_bf16(acc[2] * sc, acc[3] * sc); *(u32x2*)(KM + (size_t)row * 256 + col) = w; }
        else { const int b = row >> 8, key = row & 255;
#pragma unroll
            for (int i = 0; i < 4; ++i) { const int c = col - 256 + i, hm = c >> 6, d = c & 63; VMT[((size_t)(b * 4 + hm) * 64 + d) * 256 + key] = (bf16_t)(cvt_pk_bf16(acc[i] * sc, 0.f) & 0xffffu); } }
    }
}

constexpr int SCS = 4128;
constexpr int SEL_MW_OFF = 16 * SCS * 2;
__device__ __forceinline__ float relu_i(float x) { const int b = __builtin_bit_cast(int, x); return __builtin_bit_cast(float, b > 0 ? b : 0); }
__device__ __forceinline__ unsigned sortable16(unsigned h) { return (h & 0x8000u) ? (~h & 0xffffu) : (h | 0x8000u); }
#define SEQ64(M) M(0) M(1) M(2) M(3) M(4) M(5) M(6) M(7) M(8) M(9) M(10) M(11) M(12) M(13) M(14) M(15) M(16) M(17) M(18) M(19) M(20) M(21) M(22) M(23) M(24) M(25) M(26) M(27) M(28) M(29) M(30) M(31) M(32) M(33) M(34) M(35) M(36) M(37) M(38) M(39) M(40) M(41) M(42) M(43) M(44) M(45) M(46) M(47) M(48) M(49) M(50) M(51) M(52) M(53) M(54) M(55) M(56) M(57) M(58) M(59) M(60) M(61) M(62) M(63)
#define SEQ32(M) M(0) M(1) M(2) M(3) M(4) M(5) M(6) M(7) M(8) M(9) M(10) M(11) M(12) M(13) M(14) M(15) M(16) M(17) M(18) M(19) M(20) M(21) M(22) M(23) M(24) M(25) M(26) M(27) M(28) M(29) M(30) M(31)
#define WLANE(dst, val, L) asm("s_nop 1\n\tv_writelane_b32 %0, %1, " #L : "+v"(dst) : "s"(val))
#define SEL_CNT8(cnt, cand, K, o) asm volatile( \
    "s_nop 1\n\tv_cmp_ge_u32_e64 s[36:37], %1, %9\n\tv_cmp_ge_u32_e64 s[38:39], %2, %9\n\tv_cmp_ge_u32_e64 s[40:41], %3, %9\n\tv_cmp_ge_u32_e64 s[42:43], %4, %9\n\t" \
    "v_cmp_ge_u32_e64 s[44:45], %5, %9\n\tv_cmp_ge_u32_e64 s[46:47], %6, %9\n\tv_cmp_ge_u32_e64 s[48:49], %7, %9\n\tv_cmp_ge_u32_e64 s[50:51], %8, %9\n\t" \
    "s_bcnt1_i32_b64 s36, s[36:37]\n\ts_bcnt1_i32_b64 s38, s[38:39]\n\ts_bcnt1_i32_b64 s40, s[40:41]\n\ts_bcnt1_i32_b64 s42, s[42:43]\n\t" \
    "s_bcnt1_i32_b64 s44, s[44:45]\n\ts_bcnt1_i32_b64 s46, s[46:47]\n\ts_bcnt1_i32_b64 s48, s[48:49]\n\ts_bcnt1_i32_b64 s50, s[50:51]\n\t" \
    "s_add_i32 s36, s36, s38\n\ts_add_i32 s40, s40, s42\n\ts_add_i32 s44, s44, s46\n\ts_add_i32 s48, s48, s50\n\t" \
    "s_add_i32 s36, s36, s40\n\ts_add_i32 s44, s44, s48\n\ts_add_i32 s36, s36, s44\n\ts_add_i32 %0, %0, s36" \
    : "+s"(cnt) : "v"(K[o]), "v"(K[o + 1]), "v"(K[o + 2]), "v"(K[o + 3]), "v"(K[o + 4]), "v"(K[o + 5]), "v"(K[o + 6]), "v"(K[o + 7]), "s"(cand) \
    : "s36", "s37", "s38", "s39", "s40", "s41", "s42", "s43", "s44", "s45", "s46", "s47", "s48", "s49", "s50", "s51", "scc")
template <bool CONV = true> __device__ __forceinline__ void p2_select(Frame& F) {
    LAS unsigned short* SC = (LAS unsigned short*)F.lds;
    LAS unsigned long long* MW = (LAS unsigned long long*)(F.lds + SEL_MW_OFF);
    const unsigned short* IQ = (const unsigned short*)(F.ws + WS_IQ); const unsigned short* IK = (const unsigned short*)(F.ws + WS_IK); const float* IW = (const float*)(F.ws + WS_IW);
    unsigned long long* MT = (unsigned long long*)(F.ws + WS_MASKT);
    const int wave = F.wave;
    const int cgw = F.vcu * NWAVES + F.wave, cNGW = F.G * NWAVES; int convq = 0;
#ifdef DBG_SELT
    unsigned tacc = 0, tlast = (unsigned)__builtin_amdgcn_s_memrealtime();
#define tacc0 0
#define tacc1 1
#define tacc2 2
#define SEL_T(x) do { const unsigned n_ = (unsigned)__builtin_amdgcn_s_memrealtime(); if ((x) == DBG_SELT) tacc += n_ - tlast; tlast = n_; } while (0)
#else
#define SEL_T(x) do {} while (0)
#endif
    for (int item = F.vcu; item < 256; item += F.G) {
    const int b = item >> 6, jj = item & 63;
    half8 af[4][4]; f32x4 wv[4][4];
    int lane = F.lane; asm volatile("" : "+v"(lane));
    int r = lane & 31, hi = lane >> 5;
    int ql = 2 * ((r >> 2) & 1) + (r >> 4), head = (r & 3) + 4 * ((r >> 3) & 1);
#define SEL_LOAD_AW(T0) do { _Pragma("unroll") for (int rt = 0; rt < 4; ++rt) { const size_t qrow = (size_t)b * SEQ + (T0) + 4 * rt + ql; \
        _Pragma("unroll") for (int kk = 0; kk < 4; ++kk) af[rt][kk] = *(const half8*)(IQ + qrow * 512 + head * 64 + 16 * kk + 8 * hi); } } while (0)
#define SEL_LOAD_W(T0) do { _Pragma("unroll") for (int rt = 0; rt < 4; ++rt) { const float* wp = IW + ((size_t)b * SEQ + (T0) + 4 * rt + 2 * hi) * 8; \
        _Pragma("unroll") for (int i = 0; i < 4; ++i) wv[rt][i] = *(const f32x4*)(wp + 4 * i); } } while (0)
    SEL_LOAD_AW(jj * 32);
    for (int step = 0; step < 4; ++step) {
        const int half = step >> 1, grp = step & 1;
        const int sg = half ? 127 - jj : jj;
        const int t0 = sg * 32 + grp * 16;
        const int KT = (t0 + 16 + 31) >> 5;
        const int KT4 = (KT + 3) & ~3, RV = KT4 >> 2;
        {
            asm volatile("" : "+v"(lane)); r = lane & 31; hi = lane >> 5; ql = 2 * ((r >> 2) & 1) + (r >> 4); head = (r & 3) + 4 * ((r >> 3) & 1);
            const unsigned short* kbase = IK + ((size_t)b * SEQ + r) * 64 + 8 * hi;
#define SEL_LOAD_B(dst, tile) do { const int tl_ = (tile) < 128 ? (tile) : 127; const unsigned short* kp_ = kbase + (size_t)tl_ * 32 * 64; \
        _Pragma("unroll") for (int kk = 0; kk < 4; ++kk) dst[kk] = *(const half8*)(kp_ + 16 * kk); } while (0)
#ifndef SEL_SCHED_BAR
#define SEL_SCHED_BAR do { if (rt & 1) __builtin_amdgcn_sched_barrier(0); } while (0)
#endif
#define SEL_TILE(bf_, tile) do { const int tl_ = (tile); const int key_ = 32 * tl_ + r; \
        const int pos_ = (tl_ >> 2) * 128 + (((tl_ & 1) * 32 + r) << 1) + ((tl_ >> 1) & 1);        \
        const bool diag_ = tl_ >= KT - 1;                                                            \
        _Pragma("unroll") for (int rt = 0; rt < 4; ++rt) { f32x16 acc = f32x16{}; \
            _Pragma("unroll") for (int kk = 0; kk < 4; ++kk) acc = __builtin_amdgcn_mfma_f32_32x32x16_f16(af[rt][kk], bf_[kk], acc, 0, 0, 0); \
            float s0 = 0.f, s1 = 0.f; \
            _Pragma("unroll") for (int g = 0; g < 8; ++g) { s0 += wv[rt][g >> 2][g & 3] * relu_i(acc[g]); s1 += wv[rt][2 + (g >> 2)][g & 3] * relu_i(acc[8 + g]); } \
            const unsigned pk_ = __builtin_bit_cast(unsigned, __builtin_amdgcn_cvt_pkrtz(s0, s1)); \
            const s16x2_t sg_ = __builtin_bit_cast(s16x2_t, pk_) >> 15; \
            unsigned k2_ = pk_ ^ (__builtin_bit_cast(unsigned, sg_) | 0x80008000u);                    \
            if (diag_) { const int q0_ = t0 + 4 * rt + 2 * hi; k2_ = (key_ <= q0_ ? k2_ & 0xffffu : 0u) | (key_ <= q0_ + 1 ? k2_ & 0xffff0000u : 0u); }     \
            SC[(4 * rt + 2 * hi) * SCS + pos_] = (unsigned short)k2_; SC[(4 * rt + 2 * hi + 1) * SCS + pos_] = (unsigned short)(k2_ >> 16); \
            SEL_SCHED_BAR; } } while (0)
            half8 bA[4], bB[4], bC[4], bD[4];
            SEL_LOAD_W(t0);
            SEL_LOAD_B(bA, wave); SEL_LOAD_B(bB, wave + 8); SEL_LOAD_B(bC, wave + 16); SEL_LOAD_B(bD, wave + 24);
            for (int tile = wave; tile < KT4; tile += 32) {
                SEL_TILE(bA, tile); SEL_LOAD_B(bA, tile + 32);
                if (tile + 8 < KT4) { SEL_TILE(bB, tile + 8); SEL_LOAD_B(bB, tile + 40); }
                if (tile + 16 < KT4) { SEL_TILE(bC, tile + 16); SEL_LOAD_B(bC, tile + 48); }
                if (tile + 24 < KT4) { SEL_TILE(bD, tile + 24); SEL_LOAD_B(bD, tile + 56); }
            }
        }
        if (step < 3) { const int nh = (step + 1) >> 1, ng = (step + 1) & 1; SEL_LOAD_AW((nh ? 127 - jj : jj) * 32 + ng * 16); }
        __syncthreads();
        SEL_T(tacc0);
#pragma nounroll
        for (int qq = 0; qq < 2; ++qq) {
            if (CONV && wave < 4) { conv_expert_items3(F, convq * 3 * cNGW + cgw, cNGW, lane); ++convq; }
            const int qi = wave + 8 * qq, t = t0 + qi;
            unsigned kk[32];
            {   const LAS unsigned* row = (const LAS unsigned*)(SC + qi * SCS) + lane;
#pragma unroll
                for (int blk = 0; blk < 4; ++blk) {
                    if (blk * 8 < RV) {
#pragma unroll
                        for (int i = 0; i < 8; ++i) { const int rr = blk * 8 + i; const unsigned v_ = row[rr * 64]; kk[rr] = rr < RV ? v_ : 0u; }
                    } else {
#pragma unroll
                        for (int i = 0; i < 8; ++i) kk[blk * 8 + i] = 0u;
                    }
                }
            }
            unsigned wlo = 0u, whi = 0u;
            if (t + 1 <= 256) {
                const int rem = t + 1 - lane * 64; const unsigned long long w = rem >= 64 ? ~0ull : (rem <= 0 ? 0ull : ((1ull << rem) - 1ull));
                wlo = (unsigned)w; whi = (unsigned)(w >> 32);
            } else {
                unsigned prefix = 0u; int cntp = 0;
                const int nblk = (RV + 7) >> 3;
                for (int bit = 15; bit >= 0; --bit) {
                    const unsigned cand = (unsigned)__builtin_amdgcn_readfirstlane((int)(prefix | (1u << bit)));
                    const unsigned c2 = cand * 0x10001u, c1 = c2 - 0x10001u;
                    unsigned a1 = 0u, a0 = 0u;
#define SAD8(o) { _Pragma("unroll") for (int i = 0; i < 8; ++i) { a1 = __builtin_amdgcn_sad_u16(kk[(o) + i], c2, a1); a0 = __builtin_amdgcn_sad_u16(kk[(o) + i], c1, a0); } }
                    SAD8(0)
                    if (nblk > 1) SAD8(8)
                    if (nblk > 2) SAD8(16)
                    if (nblk > 3) SAD8(24)
#undef SAD8
                    const int cnt = (nblk * 1024 - wave_sum_i((int)(a1 - a0))) >> 1;
                    if (cnt >= 256) { prefix = cand; cntp = cnt; if (cnt == 256) break; }
                }
                prefix = (unsigned)__builtin_amdgcn_readfirstlane((int)prefix); asm volatile("" : "+s"(prefix));
                int excess = __builtin_amdgcn_readfirstlane(cntp - 256);
                unsigned pv = prefix; asm volatile("" : "+v"(pv));
#define M(rr) { unsigned long long w_; asm volatile("v_cmp_ge_u16_e64 %0, %1, %2" : "=s"(w_) : "v"(kk[rr]), "s"(prefix)); { const unsigned l_ = (unsigned)w_, h_ = (unsigned)(w_ >> 32); WLANE(wlo, l_, 2 * (rr)); WLANE(whi, h_, 2 * (rr)); } \
                asm volatile("v_cmp_ge_u16_sdwa %0, %1, %2 src0_sel:WORD_1 src1_sel:WORD_0" : "=s"(w_) : "v"(kk[rr]), "v"(pv)); { const unsigned l_ = (unsigned)w_, h_ = (unsigned)(w_ >> 32); WLANE(wlo, l_, 2 * (rr) + 1); WLANE(whi, h_, 2 * (rr) + 1); } }
                SEQ32(M)
#undef M
                if (excess > 0) {
#define FIXW(rr, HALF, CMPGE, CMPEQ) if (excess > 0) { unsigned long long eq_; asm volatile(CMPEQ : "=s"(eq_) : "v"(kk[rr]), "s"(prefix), "v"(pv)); \
                        if (eq_ != 0ull) { unsigned long long rem_ = 0ull; while (excess > 0 && eq_ != 0ull) { const unsigned long long hb_ = 1ull << (63 - __builtin_clzll(eq_)); rem_ |= hb_; eq_ ^= hb_; --excess; } \
                            unsigned long long w_; asm volatile(CMPGE : "=s"(w_) : "v"(kk[rr]), "s"(prefix), "v"(pv)); w_ &= ~rem_; const unsigned l_ = (unsigned)w_, h_ = (unsigned)(w_ >> 32); WLANE(wlo, l_, 2 * (rr) + (HALF)); WLANE(whi, h_, 2 * (rr) + (HALF)); } }
#define M(i) { FIXW(31 - (i), 1, "v_cmp_ge_u16_sdwa %0, %1, %3 src0_sel:WORD_1 src1_sel:WORD_0", "v_cmp_eq_u16_sdwa %0, %1, %3 src0_sel:WORD_1 src1_sel:WORD_0") \
               FIXW(31 - (i), 0, "v_cmp_ge_u16_e64 %0, %1, %2", "v_cmp_eq_u16_e64 %0, %1, %2") }
                    SEQ32(M)
#undef M
#undef FIXW
                }
            }
            MW[(grp * 16 + qi) * 64 + lane] = (unsigned long long)wlo | ((unsigned long long)whi << 32);
            if (CONV && wave >= 4) { conv_expert_items3(F, convq * 3 * cNGW + cgw, cNGW, lane); ++convq; }
        }
        __syncthreads();
        SEL_T(tacc1);
        if (grp == 1) {
#ifdef DBG_LAST
            const int NT64 = 64;
#else
            const int NT64 = 4 * (sg >> 3) + 4;
#endif
            for (int T = wave; T < NT64; T += 8) {
                const unsigned long long w = MW[r * 64 + T] >> (4 * hi);
                const unsigned lo = (unsigned)w, hi32 = (unsigned)(w >> 32);
                unsigned olo = 0u, ohi = 0u;
#define M(i) { constexpr int r16_ = (i) & 15, bitc_ = (r16_ & 3) + 8 * (r16_ >> 2); const unsigned src_ = ((i) >> 4) ? hi32 : lo; \
                    const unsigned long long bal_ = __ballot(((src_ >> bitc_) & 1u) != 0u); const unsigned l_ = (unsigned)bal_, h_ = (unsigned)(bal_ >> 32); WLANE(olo, l_, i); WLANE(ohi, h_, i); }
                SEQ32(M)
#undef M
                if (lane < 32) MT[((size_t)(b * 128 + sg) * 64 + T) * 32 + lane] = (unsigned long long)olo | ((unsigned long long)ohi << 32);
            }
            __syncthreads();
            SEL_T(tacc2);
        }
    }
    }
    if (CONV) for (int cid = convq * 3 * cNGW + cgw; cid < NCONV; cid += 3 * cNGW) conv_expert_items3(F, cid, cNGW, F.lane);
#ifdef DBG_SELT
    if (blockIdx.x == 0 && F.tid == 0) { unsigned long long* t = (unsigned long long*)(F.ctl + 16384); t[20] = 0; t[21] = tacc; }
#endif
}

template <int G> __device__ __forceinline__ void p2_pool_unit(Frame& F, int tb) {
    const bf16_t* U = (const bf16_t*)(F.ws + WS_U); const bf16_t* WGT = (const bf16_t*)(F.ws + WS_WGT); bf16_t* YP = (bf16_t*)(F.ws + WS_YCAT) + 512;
    constexpr int w = 2 << G;
    const int lane = F.lane, r = lane & 31, hi = lane >> 5;
    const int tok = tb * 32 + r, t = tok & (SEQ - 1), cnt = (t + 1 < w) ? t + 1 : w;
    const float inv = 1.f / (float)cnt;
    f32x16 acc[2]; acc[0] = f32x16{}; acc[1] = f32x16{};
#pragma unroll
    for (int kk = 0; kk < 4; ++kk) {
        const int c0 = G * 64 + 16 * kk + 8 * hi;
        constexpr int CH = (w < 8) ? w : 8;
        float s[8], own[8];
#pragma unroll
        for (int j = 0; j < 8; ++j) s[j] = 0.f;
#pragma nounroll
        for (int i0 = 0; i0 < w; i0 += CH) {
            u32x4 v[CH];
#pragma unroll
            for (int i = 0; i < CH; ++i) { const int back = (i0 + i < cnt) ? i0 + i : 0; v[i] = *(const u32x4*)(U + (size_t)(tok - back) * 256 + c0); }
#pragma unroll
            for (int i = 0; i < CH; ++i) { const float m = (i0 + i < cnt) ? 1.f : 0.f;
                s[0] += m * bflo(v[i].x); s[1] += m * bfhi(v[i].x); s[2] += m * bflo(v[i].y); s[3] += m * bfhi(v[i].y); s[4] += m * bflo(v[i].z); s[5] += m * bfhi(v[i].z); s[6] += m * bflo(v[i].w); s[7] += m * bfhi(v[i].w); }
            if (i0 == 0) { own[0] = bflo(v[0].x); own[1] = bfhi(v[0].x); own[2] = bflo(v[0].y); own[3] = bfhi(v[0].y); own[4] = bflo(v[0].z); own[5] = bfhi(v[0].z); own[6] = bflo(v[0].w); own[7] = bfhi(v[0].w); }
        }
        u32x4 pb; pb.x = cvt_pk_bf16(s[0] * inv - own[0], s[1] * inv - own[1]); pb.y = cvt_pk_bf16(s[2] * inv - own[2], s[3] * inv - own[3]);
        pb.z = cvt_pk_bf16(s[4] * inv - own[4], s[5] * inv - own[5]); pb.w = cvt_pk_bf16(s[6] * inv - own[6], s[7] * inv - own[7]);
#pragma unroll
        for (int dh = 0; dh < 2; ++dh) { const bf16x8 a = *(const bf16x8*)(WGT + ((size_t)(G * 64 + 32 * dh + r)) * 64 + 16 * kk + 8 * hi);
            acc[dh] = __builtin_amdgcn_mfma_f32_32x32x16_bf16(a, __builtin_bit_cast(bf16x8, pb), acc[dh], 0, 0, 0); }
        __builtin_amdgcn_sched_barrier(0);
    }
    const float* sc = F.in[10];
#pragma unroll
    for (int dh = 0; dh < 2; ++dh)
#pragma unroll
        for (int q4 = 0; q4 < 4; ++q4) { const int d = G * 64 + 32 * dh + 8 * q4 + 4 * hi; const f32x4 s4 = *(const f32x4*)(sc + d);
            u32x2 o; o.x = cvt_pk_bf16(acc[dh][4 * q4] * s4[0], acc[dh][4 * q4 + 1] * s4[1]); o.y = cvt_pk_bf16(acc[dh][4 * q4 + 2] * s4[2], acc[dh][4 * q4 + 3] * s4[3]);
            *(u32x2*)(YP + (size_t)tok * 1024 + d) = o; }
}
constexpr int MEM_KROW = 144, MEM_VROW = 528;
constexpr int MEM_K_OFF = 0, MEM_V_OFF = 256 * MEM_KROW;
__device__ __forceinline__ void p2_mem_item(Frame& F, int item) {
    const bf16_t* QM = (const bf16_t*)(F.ws + WS_QM); const bf16_t* KM = (const bf16_t*)(F.ws + WS_KM); const bf16_t* VMT = (const bf16_t*)(F.ws + WS_VMT); bf16_t* YM = (bf16_t*)(F.ws + WS_YCAT) + 768;
    const int lane = F.lane, wave = F.wave, r = lane & 31, hi = lane >> 5, tid = F.tid;
    const int bhm = item >> 4, b = bhm >> 2, hm = bhm & 3;
    LAS unsigned char* lk = F.lds + MEM_K_OFF; LAS unsigned char* lv = F.lds + MEM_V_OFF;
#pragma unroll
    for (int i = 0; i < 4; ++i) { const int idx = tid + 512 * i, key = idx >> 3, ch = idx & 7;
        *(LAS u32x4*)(lk + key * MEM_KROW + ch * 16) = *(const u32x4*)(KM + (size_t)(b * 256 + key) * 256 + hm * 64 + ch * 8); }
#pragma unroll
    for (int i = 0; i < 4; ++i) { const int idx = tid + 512 * i, d = idx >> 5, ch = idx & 31;
        *(LAS u32x4*)(lv + d * MEM_VROW + ch * 16) = *(const u32x4*)(VMT + ((size_t)(b * 4 + hm) * 64 + d) * 256 + ch * 8); }
    __syncthreads();
    const int tok = b * SEQ + (item & 15) * 256 + wave * 32 + r;
    bf16x8 qf[4];
#pragma unroll
    for (int kk = 0; kk < 4; ++kk) qf[kk] = *(const bf16x8*)(QM + (size_t)tok * 256 + hm * 64 + 16 * kk + 8 * hi);
    f32x16 sc[8];
#pragma unroll
    for (int kb = 0; kb < 8; ++kb) { sc[kb] = f32x16{};
#pragma unroll
        for (int kk = 0; kk < 4; ++kk) { const bf16x8 a = *(const LAS bf16x8*)(lk + (kb * 32 + r) * MEM_KROW + (16 * kk + 8 * hi) * 2);
            sc[kb] = __builtin_amdgcn_mfma_f32_32x32x16_bf16(a, qf[kk], sc[kb], 0, 0, 0); } }
    float mx = -INFINITY;
#pragma unroll
    for (int kb = 0; kb < 8; ++kb)
#pragma unroll
        for (int i = 0; i < 16; ++i) mx = fmaxf(mx, sc[kb][i]);
    mx = fmaxf(mx, __shfl_xor(mx, 32));
    float l = 0.f;
#pragma unroll
    for (int kb = 0; kb < 8; ++kb)
#pragma unroll
        for (int i = 0; i < 16; ++i) { const float p = __builtin_amdgcn_exp2f(sc[kb][i] - mx); sc[kb][i] = p; l += p; }
    l += __shfl_xor(l, 32);
    f32x16 o[2]; o[0] = f32x16{}; o[1] = f32x16{};
#pragma unroll
    for (int kb = 0; kb < 8; ++kb)
#pragma unroll
        for (int s = 0; s < 2; ++s) {
            u32x4 pw; pw.x = cvt_pk_bf16(sc[kb][8 * s], sc[kb][8 * s + 1]); pw.y = cvt_pk_bf16(sc[kb][8 * s + 2], sc[kb][8 * s + 3]); pw.z = cvt_pk_bf16(sc[kb][8 * s + 4], sc[kb][8 * s + 5]); pw.w = cvt_pk_bf16(sc[kb][8 * s + 6], sc[kb][8 * s + 7]);
#pragma unroll
            for (int dh = 0; dh < 2; ++dh) {
                const LAS unsigned char* vp = lv + (32 * dh + r) * MEM_VROW + (32 * kb + 16 * s + 4 * hi) * 2;
                const u32x2 a0 = *(const LAS u32x2*)vp, a1 = *(const LAS u32x2*)(vp + 16);
                const u32x4 av = (u32x4){a0.x, a0.y, a1.x, a1.y};
                o[dh] = __builtin_amdgcn_mfma_f32_32x32x16_bf16(__builtin_bit_cast(bf16x8, av), __builtin_bit_cast(bf16x8, pw), o[dh], 0, 0, 0); }
            __builtin_amdgcn_sched_barrier(0);
        }
    const float il = 1.f / l;
#pragma unroll
    for (int dh = 0; dh < 2; ++dh)
#pragma unroll
        for (int q4 = 0; q4 < 4; ++q4) { const int d = hm * 64 + 32 * dh + 8 * q4 + 4 * hi;
            u32x2 ov; ov.x = cvt_pk_bf16(o[dh][4 * q4] * il, o[dh][4 * q4 + 1] * il); ov.y = cvt_pk_bf16(o[dh][4 * q4 + 2] * il, o[dh][4 * q4 + 3] * il);
            *(u32x2*)(YM + (size_t)tok * 1024 + d) = ov; }
    __syncthreads();
}
__device__ __forceinline__ void p6_router(Frame& F) {
    const float* H1 = F.out; const bf16_t* WRH = (const bf16_t*)(F.ws + WS_WRH); const bf16_t* WRL = (const bf16_t*)(F.ws + WS_WRL);
    int* RE = (int*)(F.ws + WS_RE); int* RR = (int*)(F.ws + WS_RR); float* RG = (float*)(F.ws + WS_RG); float* RSTD = (float*)(F.ws + WS_RSTD);
    LAS float* RED = (LAS float*)F.lds;
    LAS float* SSQ = (LAS float*)(F.lds + 2 * 4 * 32 * 33 * 4);
    volatile LAS unsigned* LCNT = (volatile LAS unsigned*)(F.lds + 2 * 4 * 32 * 33 * 4 + 2 * 4 * 64 * 4);
    const int lane = F.lane, wave = F.wave, r = lane & 31, hi = lane >> 5, tblk = wave >> 2, kq = wave & 3;
    for (int item = F.vcu; item < NTOK / 64; item += F.G) {
        const int tok = item * 64 + tblk * 32 + r;
        f32x16 acc = f32x16{}; float ssq = 0.f;
        const float* hp = H1 + (size_t)tok * 1024 + 256 * kq + 8 * hi;
        const bf16_t* ah = WRH + (size_t)r * 1024 + 256 * kq + 8 * hi; const bf16_t* al = WRL + (size_t)r * 1024 + 256 * kq + 8 * hi;
#pragma unroll 8
        for (int ks = 0; ks < 16; ++ks) {
            const f32x4 x0 = *(const f32x4*)(hp + 16 * ks), x1 = *(const f32x4*)(hp + 16 * ks + 4);
            ssq += (x0[0] * x0[0] + x0[1] * x0[1]) + (x0[2] * x0[2] + x0[3] * x0[3]) + (x1[0] * x1[0] + x1[1] * x1[1]) + (x1[2] * x1[2] + x1[3] * x1[3]);
            u32x4 bh; bh.x = cvt_pk_bf16_s(x0[0], x0[1]); bh.y = cvt_pk_bf16_s(x0[2], x0[3]); bh.z = cvt_pk_bf16_s(x1[0], x1[1]); bh.w = cvt_pk_bf16_s(x1[2], x1[3]);
            u32x4 bl; bl.x = cvt_pk_bf16_s(x0[0] - bflo(bh.x), x0[1] - bfhi(bh.x)); bl.y = cvt_pk_bf16_s(x0[2] - bflo(bh.y), x0[3] - bfhi(bh.y));
            bl.z = cvt_pk_bf16_s(x1[0] - bflo(bh.z), x1[1] - bfhi(bh.z)); bl.w = cvt_pk_bf16_s(x1[2] - bflo(bh.w), x1[3] - bfhi(bh.w));
            const bf16x8 Ah = *(const bf16x8*)(ah + 16 * ks), Al = *(const bf16x8*)(al + 16 * ks);
            acc = __builtin_amdgcn_mfma_f32_32x32x16_bf16(Ah, __builtin_bit_cast(bf16x8, bh), acc, 0, 0, 0);
            acc = __builtin_amdgcn_mfma_f32_32x32x16_bf16(Ah, __builtin_bit_cast(bf16x8, bl), acc, 0, 0, 0);
            acc = __builtin_amdgcn_mfma_f32_32x32x16_bf16(Al, __builtin_bit_cast(bf16x8, bh), acc, 0, 0, 0);
        }
#pragma unroll
        for (int g = 0; g < 16; ++g) RED[((tblk * 4 + kq) * 32 + attn_body::crow(g, hi)) * 33 + r] = acc[g];
        SSQ[(tblk * 4 + kq) * 64 + lane] = ssq;
        __syncthreads();
        if (F.tid < 64) {
            const int tb2 = F.tid >> 5, rr = F.tid & 31, tk = item * 64 + F.tid;
            float sq = 0.f;
#pragma unroll
            for (int q = 0; q < 4; ++q) sq += SSQ[(tb2 * 4 + q) * 64 + rr] + SSQ[(tb2 * 4 + q) * 64 + 32 + rr];
            const float rstd = 1.f / sqrtf(sq * (1.f / 1024.f) + EPS);
            float lg[32];
#pragma unroll
            for (int e = 0; e < 32; ++e) { float s = 0.f;
#pragma unroll
                for (int q = 0; q < 4; ++q) s += RED[((tb2 * 4 + q) * 32 + e) * 33 + rr];
                lg[e] = s * rstd + F.in[16][e]; }
            float tv[4]; int ti[4];
#pragma unroll
            for (int p = 0; p < 4; ++p) { float best = -INFINITY; int bi = 0;
#pragma unroll
                for (int e = 0; e < 32; ++e) if (lg[e] > best) { best = lg[e]; bi = e; }
                tv[p] = best; ti[p] = bi;
#pragma unroll
                for (int e = 0; e < 32; ++e) lg[e] = (e == bi) ? -INFINITY : lg[e]; }
            float ex[4], den = 0.f;
#pragma unroll
            for (int p = 0; p < 4; ++p) { ex[p] = __expf(tv[p] - tv[0]); den += ex[p]; }
            const float id = 1.f / den;
#pragma unroll
            for (int p = 0; p < 4; ++p) { RE[tk * 4 + p] = ti[p]; RG[tk * 4 + p] = ex[p] * id; }
            if (F.tid < 32) LCNT[F.tid] = 0u;
            int rk[4];
#pragma unroll
            for (int p = 0; p < 4; ++p) rk[p] = (int)__hip_atomic_fetch_add((LAS unsigned*)&LCNT[ti[p]], 1u, __ATOMIC_RELAXED, __HIP_MEMORY_SCOPE_WORKGROUP);
            if (F.tid < 32) { const unsigned c = LCNT[F.tid]; LCNT[32 + F.tid] = c ? __hip_atomic_fetch_add(F.ctl + CW_CNT + 64 * F.tid, c, __ATOMIC_RELAXED, __HIP_MEMORY_SCOPE_AGENT) : 0u; }
#pragma unroll
            for (int p = 0; p < 4; ++p) RR[tk * 4 + p] = rk[p] + (int)LCNT[32 + ti[p]];
            RSTD[tk] = rstd;
        }
        __syncthreads();
    }
}
__device__ __forceinline__ int moe_row_offset(Frame& F) {
    const int lane = F.lane; const unsigned c = (lane < 32) ? __hip_atomic_load(F.ctl + CW_CNT + 64 * lane, __ATOMIC_RELAXED, __HIP_MEMORY_SCOPE_AGENT) : 0u;
    const int pad = (int)((c + 255u) & ~255u); int inc = pad;
#pragma unroll
    for (int o = 1; o < 32; o <<= 1) { const int v = __shfl_up(inc, o); if ((lane & 31) >= o) inc += v; }
    return inc - pad;
}
__device__ __forceinline__ void p7_scatter(Frame& F) {
    const float* H1 = F.out; const int* RE = (const int*)(F.ws + WS_RE); const int* RR = (const int*)(F.ws + WS_RR); const float* RSTD = (const float*)(F.ws + WS_RSTD);
    int* SLOT = (int*)(F.ws + WS_SLOT); unsigned char* XG = (unsigned char*)(F.ws + WS_XG);
    const int lane = F.lane, gw = F.vcu * NWAVES + F.wave, NGW = F.G * NWAVES;
    const int off = moe_row_offset(F);
    const f32x4* gr = (const f32x4*)F.in[14] + lane;
    f32x4 gg[4];
#pragma unroll
    for (int j = 0; j < 4; ++j) gg[j] = gr[64 * j];
    for (int tok = gw; tok < NTOK; tok += NGW) {
        const float rstd = RSTD[tok];
        const f32x4* xr = (const f32x4*)(H1 + (size_t)tok * 1024) + lane;
        unsigned w[4];
#pragma unroll
        for (int j = 0; j < 4; ++j) { const f32x4 v = xr[64 * j]; w[j] = cvt_pk_fp8x4(v.x * rstd * gg[j].x, v.y * rstd * gg[j].y, v.z * rstd * gg[j].z, v.w * rstd * gg[j].w); }
#pragma unroll
        for (int p = 0; p < 4; ++p) { const int e = RE[tok * 4 + p], rk = RR[tok * 4 + p]; const int slot = __shfl(off, e) + rk;
            unsigned* o4 = (unsigned*)(XG + (size_t)slot * 1024) + lane;
#pragma unroll
            for (int j = 0; j < 4; ++j) o4[64 * j] = w[j];
            if (lane == 0) SLOT[tok * 4 + p] = slot; }
    }
}
__device__ __forceinline__ void moe_tile_table(Frame& F) {
    if (F.wave == 0) { const int off = moe_row_offset(F); const unsigned c = (F.lane < 32) ? __hip_atomic_load(F.ctl + CW_CNT + 64 * F.lane, __ATOMIC_RELAXED, __HIP_MEMORY_SCOPE_AGENT) : 0u;
        if (F.lane < 32) F.MISC[32 + F.lane] = (unsigned)(off >> 8);
        if (F.lane == 31) F.MISC[64] = (unsigned)((off >> 8) + (int)((c + 255u) >> 8)); }
    __syncthreads();
}
__device__ __forceinline__ void p10_final(Frame& F) {
    float* H1 = F.out; const int* SLOT = (const int*)(F.ws + WS_SLOT); const float* RG = (const float*)(F.ws + WS_RG); const unsigned char* Y = (const unsigned char*)(F.ws + WS_XG);
    const int lane = F.lane, gw = F.vcu * NWAVES + F.wave, NGW = F.G * NWAVES;
    const f32x4* gr = (const f32x4*)F.in[21] + lane;
    f32x4 gg[4];
#pragma unroll
    for (int j = 0; j < 4; ++j) gg[j] = gr[64 * j];
    for (int tok = gw; tok < NTOK; tok += NGW) {
        f32x4* xr = (f32x4*)(H1 + (size_t)tok * 1024) + lane;
        f32x4 v[4];
#pragma unroll
        for (int j = 0; j < 4; ++j) v[j] = xr[64 * j];
#pragma unroll
        for (int p = 0; p < 4; ++p) { const int slot = SLOT[tok * 4 + p]; const float gate = RG[tok * 4 + p] * 0.125f;
            const unsigned* yr = (const unsigned*)(Y + (size_t)slot * 1024) + lane;
#pragma unroll
            for (int j = 0; j < 4; ++j) { const unsigned y = yr[64 * j]; const f32x2 lo = __builtin_amdgcn_cvt_pk_f32_fp8((int)y, false), hi = __builtin_amdgcn_cvt_pk_f32_fp8((int)y, true);
                v[j].x += gate * lo[0]; v[j].y += gate * lo[1]; v[j].z += gate * hi[0]; v[j].w += gate * hi[1]; } }
        float s = 0.f;
#pragma unroll
        for (int j = 0; j < 4; ++j) s += (v[j].x * v[j].x + v[j].y * v[j].y) + (v[j].z * v[j].z + v[j].w * v[j].w);
        const float rstd = 1.f / sqrtf(wave_sum(s) * (1.f / 1024.f) + EPS);
#pragma unroll
        for (int j = 0; j < 4; ++j) xr[64 * j] = (f32x4){v[j].x * rstd * gg[j].x, v[j].y * rstd * gg[j].y, v[j].z * rstd * gg[j].z, v[j].w * rstd * gg[j].w};
    }
#ifdef DBG_STAMP
    if (gw == 0 && lane == 0) { const unsigned long long* t = (const unsigned long long*)(F.ctl + 16384); H1[0] = floorf((float)(t[DBG_STAMP_HI] - t[DBG_STAMP_LO]) * 0.01f / DBG_STAMP_Q) * DBG_STAMP_Q; }
#endif
}

#ifndef MK_N_LAUNCHES
#define MK_N_LAUNCHES 1
#endif
constexpr int N_PHASES = 11;
constexpr int N_LAUNCHES = MK_N_LAUNCHES;
struct Args { const float* in[22]; float* out; unsigned char* ws; int ph_lo, ph_hi, li, pad; };
__global__ void __launch_bounds__(NWAVES * 64, 2) fwd_kernel(Args args) {
    extern __shared__ __attribute__((aligned(16))) unsigned char lds[];
    Frame F;
    F.lds = (LAS unsigned char*)lds; F.MISC = (volatile LAS unsigned*)(F.lds + MISC_OFF);
    F.tid = threadIdx.x; F.lane = F.tid & 63; F.wave = __builtin_amdgcn_readfirstlane(F.tid >> 6);
    F.G = gridDim.x; { const int bx = blockIdx.x; F.vcu = (F.G % 8 == 0) ? (bx % 8) * (F.G / 8) + bx / 8 : bx; }
    F.ws = args.ws; F.ctl = (unsigned*)(args.ws + WS_CTL); F.out = args.out;
    F.in = (const float* const __attribute__((address_space(4)))*)__builtin_amdgcn_kernarg_segment_ptr();
    static_assert(__builtin_offsetof(Args, in) == 0, "Frame::in reads the input pointers at the start of the kernarg segment");
    unsigned char* ws = args.ws;
#define WS_FRESH() do { ws = args.ws; asm volatile("" : "+s"(ws)); F.ws = ws; } while (0)
    for (int u = F.tid; u < 256; u += NWAVES * 64) F.MISC[u] = 0u;
    __syncthreads();
    XcdBarrier bar; bar.bar = F.ctl + CW_BAR; bar.x = 0; bar.st = nullptr;
    if (N_LAUNCHES == 1) bar = xcd_barrier_post(F.ctl + CW_BAR, F.MISC + 8, F.tid == 0);
#define GRID_BAR() do { if (N_LAUNCHES == 1) xcd_barrier(bar, F.wave == 0 && lane_id() == 0); } while (0)
    const int lo = args.ph_lo, hi = args.ph_hi;
#ifndef PH_MASK
#define PH_MASK 0x7ff
#endif
#ifdef DBG_LAST
#define IN(k) ((k) <= DBG_LAST && (((PH_MASK) >> (k)) & 1) && lo <= (k) && (k) < hi)
#else
#define IN(k) ((((PH_MASK) >> (k)) & 1) && lo <= (k) && (k) < hi)
#endif
#define BOTH(k) (IN(k) && IN((k) + 1))

#define IN_FRESH() do { F.in = (const float* const __attribute__((address_space(4)))*)__builtin_amdgcn_kernarg_segment_ptr(); asm volatile("" : "+s"(F.in)); } while (0)
#define REFRESH_F() do { int l_ = lane_id(); asm volatile("" : "+v"(l_)); F.lane = l_; F.tid = F.wave * 64 + l_; } while (0)
#ifdef DBG_PHSTAMP
#define STAMP(k) do { if (blockIdx.x == 0 && F.tid == 0) ((unsigned long long*)(F.ctl + 16384))[k] = __builtin_amdgcn_s_memrealtime(); } while (0)
#else
#define STAMP(k) do {} while (0)
#endif
    STAMP(0);
    if (IN(0)) { IN_FRESH(); REFRESH_F(); p0_prologue(F); if (BOTH(0)) GRID_BAR(); }
    STAMP(1);

    if (IN(1)) { IN_FRESH();
        Sched1 S{(const char*)(ws + WS_XN), (const char*)(ws + WS_W1T), (const char*)(ws + WS_MEMN), (const char*)(ws + WS_WKV), F.G, (int)blockIdx.x};
        EpiP1 E{(bf16_t*)(ws + WS_Q), (bf16_t*)(ws + WS_K), (bf16_t*)(ws + WS_V), (bf16_t*)(ws + WS_U), (bf16_t*)(ws + WS_QM), (bf16_t*)(ws + WS_G), (bf16_t*)(ws + WS_KM), (bf16_t*)(ws + WS_VMT),
                (unsigned short*)(ws + WS_IQ), (unsigned short*)(ws + WS_IK), (float*)(ws + WS_IW), F.in[5], (const float*)(ws + WS_ROPE), 1.f / 64.f};
        { SchedU SU{(const char*)(ws + WS_XNB), (const char*)(ws + WS_WU), F.G, (int)blockIdx.x}; EpiP1 EU = E; EU.accscale = 1.f;
          pg8::gemm_phase<EpiP1, SchedU, K_ALIGN, K_SP2>(F.wave, F.lds, 1024, SU, EU); }
        pg8::gemm_phase<EpiP1, Sched1, K_ALIGN, K_SP2, pg8::NoHook, 1>(F.wave, F.lds, 1024, S, E);
        REFRESH_F(); p1_memkv(F);
        if (BOTH(1)) GRID_BAR();
    }

    STAMP(2);
    if (IN(2)) { IN_FRESH();
        F.lane = lane_id(); F.tid = F.wave * 64 + F.lane;
        p2_select(F);
        REFRESH_F();
        STAMP(12);
        if (BOTH(2)) GRID_BAR();
    }

    STAMP(3);
    if (IN(3)) { IN_FRESH();
        for (int v = F.vcu; v < 256; v += F.G) {
            const int bh = v >> 3, s = v & 7;
#pragma unroll 1
            for (int i = 0; i < 2; ++i) attn_body::attn_unit<8>(F.wave, bh >> 3, bh & 7, i == 0 ? s : 15 - s, (const attn_body::bf16*)(ws + WS_Q), (const attn_body::bf16*)(ws + WS_K), (const attn_body::bf16*)(ws + WS_V),
                                                                 (attn_body::bf16*)(ws + WS_YCAT), (const unsigned long long*)(ws + WS_MASKT), (char*)lds);
        }
        __syncthreads(); REFRESH_F();
        const int gw = F.vcu * NWAVES + F.wave, NGW = F.G * NWAVES;
#ifndef NO_POOL
        for (int u = gw; u < 2048; u += NGW) { const int tb = u >> 2; switch (u & 3) { case 0: p2_pool_unit<0>(F, tb); break; case 1: p2_pool_unit<1>(F, tb); break; case 2: p2_pool_unit<2>(F, tb); break; default: p2_pool_unit<3>(F, tb); break; } }
#endif
#ifndef NO_MEM
        for (int it = F.vcu; it < 256; it += F.G) p2_mem_item(F, it);
#endif
        if (BOTH(3)) GRID_BAR();
    }

    STAMP(4);
    if (IN(4)) { IN_FRESH();
        SchedSimple S{(const char*)(ws + WS_YCAT), (const char*)(ws + WS_WCAT), 64, 4, F.G, (int)blockIdx.x, (size_t)256 * 1024 * 2};
        EpiGate<0> E{(const bf16_t*)(ws + WS_G), nullptr, (bf16_t*)(ws + WS_MERGED), 2}; GateRatioHook H{(const bf16_t*)(ws + WS_G)};
        pg8::gemm_phase<EpiGate<0>, SchedSimple, K_ALIGN, K_SP2, GateRatioHook>(F.wave, F.lds, 1024, S, E, 0, H);
        if (BOTH(4)) GRID_BAR();
    }
    STAMP(5);
    if (IN(5)) { IN_FRESH();
        SchedSimple S{(const char*)(ws + WS_MERGED), (const char*)(ws + WS_WOUT), 64, 4, F.G, (int)blockIdx.x, (size_t)256 * 1024 * 2};
        EpiRes E{F.in[0], F.out}; pg8::gemm_phase<EpiRes, SchedSimple, K_ALIGN, K_SP2>(F.wave, F.lds, 1024, S, E);
        if (BOTH(5)) GRID_BAR();
    }

    STAMP(6);
    if (IN(6)) { IN_FRESH(); REFRESH_F(); p6_router(F); if (BOTH(6)) GRID_BAR(); }
    STAMP(7);
    if (IN(7)) { IN_FRESH(); REFRESH_F(); p7_scatter(F); if (BOTH(7)) GRID_BAR(); }

    STAMP(8);
    if (IN(8)) { IN_FRESH();
        REFRESH_F();
        if (F.wave == 0) { const int l = lane_id(); const unsigned c = (l < 16) ? xb_ld(&bar.bar[XB_XCNT(l)]) : 0u;
            const unsigned long long nz = __ballot(c > 0u), okm = __ballot(l >= 16 || c == 0u || c == (unsigned)(F.G >> 3));
            const bool nice = (N_LAUNCHES == 1) && BOTH(8) && ((F.G & 63) == 0) && (__builtin_popcountll(nz) == 8) && (okm == ~0ull);
            if (l == 0) { F.MISC[12] = nice ? 1u : 0u; F.MISC[13] = (unsigned)__builtin_popcountll(nz & ((1ull << bar.x) - 1ull)); } }
        moe_tile_table(F);
        const bool merged = __builtin_amdgcn_readfirstlane((int)F.MISC[12]) != 0; const int hx = merged ? __builtin_amdgcn_readfirstlane((int)F.MISC[13]) : -1, hs = __builtin_amdgcn_readfirstlane((int)F.MISC[10]);
        SchedMoe S{(const char*)(ws + WS_XG), (const char*)(ws + WS_WUP), (const volatile LAS int*)(F.MISC + 32), 8, F.G, (int)blockIdx.x, 1024, hx, hs};
        EpiSwiglu E{F.in[18], (unsigned char*)(ws + WS_ACT), merged ? F.ctl + CW_UPDONE : nullptr}; pg8::gemm_phase<EpiSwiglu, SchedMoe, K_ALIGN, K_SP2, pg8::NoHook, 1>(F.wave, F.lds, 1024, S, E);
        if (BOTH(8) && !merged) GRID_BAR();
    }
    STAMP(9);
    if (IN(9)) { IN_FRESH();
        REFRESH_F(); moe_tile_table(F);
        const bool merged = BOTH(8) && __builtin_amdgcn_readfirstlane((int)F.MISC[12]) != 0; const int hx = merged ? __builtin_amdgcn_readfirstlane((int)F.MISC[13]) : -1, hs = __builtin_amdgcn_readfirstlane((int)F.MISC[10]);
        SchedMoe S{(const char*)(ws + WS_ACT), (const char*)(ws + WS_WDN), (const volatile LAS int*)(F.MISC + 32), 4, F.G, (int)blockIdx.x, 1024, hx, hs, merged ? F.ctl + CW_UPDONE : nullptr, merged ? (F.G >> 4) : 0};
        EpiDown E{F.in[20], (unsigned char*)(ws + WS_XG)}; pg8::gemm_phase<EpiDown, SchedMoe, K_ALIGN, K_SP2, pg8::NoHook, 1>(F.wave, F.lds, 1024, S, E);
        if (BOTH(9)) GRID_BAR();
    }
    STAMP(10);
    if (IN(10)) { IN_FRESH(); REFRESH_F(); p10_final(F); }
    STAMP(11);
#if defined(DBG_LAST) && defined(DBG_SCAN)
    {
        if (N_LAUNCHES == 1) xcd_barrier(bar, F.wave == 0 && lane_id() == 0);
        const unsigned short* base = (const unsigned short*)(ws + DBG_SCAN_OFF);
        const size_t gt = (size_t)blockIdx.x * 512 + threadIdx.x, NGT = (size_t)gridDim.x * 512;
        for (size_t j = gt; j < (size_t)NTOK * DM; j += NGT) { float r = 0.f;
            for (size_t q = j; q < (size_t)DBG_SCAN_ELEMS; q += (size_t)NTOK * DM) { const unsigned v = base[q]; const unsigned e = (v >> 7) & 0xffu, m = v & 0x7fu;
                if (DBG_SCAN == 1 ? (e == 0xffu) : (e == 0u && m != 0u)) r = __builtin_nanf(""); }
            F.out[j] = r; }
    }
#endif
#if defined(DBG_LAST) && defined(DBG_REGIONS)
    {
        if (N_LAUNCHES == 1) xcd_barrier(bar, F.wave == 0 && lane_id() == 0);
        const size_t offs[] = {DBG_REGIONS}; const size_t nreg = sizeof(offs) / sizeof(offs[0]) / 2;
        const size_t gt = (size_t)blockIdx.x * 512 + threadIdx.x, NGT = (size_t)gridDim.x * 512;
        for (size_t j = gt; j < (size_t)NTOK * DM; j += NGT) { float acc = 0.f;
            for (size_t q = 0; q < nreg; ++q) { const unsigned short* base = (const unsigned short*)(ws + offs[2 * q]);
#ifdef DBG_LOWBYTE
                acc += (float)(base[j % (offs[2 * q + 1] / 2)] & 0xffu); }
#else
                acc += (float)base[j % (offs[2 * q + 1] / 2)]; }
#endif
#ifdef DBG_NOISE
            acc += (float)(DBG_NOISE) * (float)((__builtin_amdgcn_s_memrealtime() >> 4) & 1ull) * (float)((j * 2654435761ull >> 13) & 1ull);
#endif
            F.out[j] = acc; }
    }
#endif
#undef IN
#undef BOTH
}

extern "C" void kernel_launch(void* const* d_in, const int* in_sizes, int n_in, void* d_out, int out_size, void* d_ws, size_t ws_size, hipStream_t stream) {
    static int grid = 0;
    if (grid == 0) {
        if (n_in != 22 || in_sizes[0] != NTOK * DM || out_size != NTOK * DM || ws_size < WS_END) { fprintf(stderr, "kernel_launch: unexpected problem shape / workspace (n_in %d, ws %zu < %zu); nothing launched\n", n_in, ws_size, (size_t)WS_END); grid = -1; return; }
        int dev = 0, cus = 0, per_cu = 0;
        if (hipGetDevice(&dev) != hipSuccess || hipDeviceGetAttribute(&cus, hipDeviceAttributeMultiprocessorCount, dev) != hipSuccess) { grid = -1; return; }
        if (hipFuncSetAttribute((const void*)fwd_kernel, hipFuncAttributeMaxDynamicSharedMemorySize, LDS_BYTES) != hipSuccess) { fprintf(stderr, "kernel_launch: hipFuncSetAttribute failed\n"); grid = -1; return; }
        if (hipOccupancyMaxActiveBlocksPerMultiprocessor(&per_cu, (const void*)fwd_kernel, NWAVES * 64, LDS_BYTES) != hipSuccess || per_cu < 1) fprintf(stderr, "kernel_launch: occupancy query reports %d\n", per_cu);
        (void)hipGetLastError();
        grid = cus;
    }
    if (grid < 0) return;
    if (hipMemsetAsync((char*)d_ws + WS_CTL, 0, CTL_ZERO_BYTES, stream) != hipSuccess) return;
    Args a{};
    for (int i = 0; i < 22; ++i) a.in[i] = (const float*)d_in[i];
    a.out = (float*)d_out; a.ws = (unsigned char*)d_ws;
    for (int li = 0; li < N_LAUNCHES; ++li) {
        a.ph_lo = (N_LAUNCHES == 1) ? 0 : li; a.ph_hi = (N_LAUNCHES == 1) ? N_PHASES : li + 1; a.li = li;
        hipLaunchKernelGGL(fwd_kernel, dim3(grid), dim3(NWAVES * 64), LDS_BYTES, stream, a);
        if (hipPeekAtLastError() != hipSuccess) { fprintf(stderr, "kernel_launch: launch %d failed\n", li); break; }
    }
}
```

```cpp
#include <hip/hip_runtime.h>
#include <hip/hip_bf16.h>
#include <cstdio>
#include <cstdint>

#define GAS __attribute__((address_space(1)))
#define LAS __attribute__((address_space(3)))
typedef unsigned short bf16_t;
typedef short bf16x8 __attribute__((ext_vector_type(8)));
typedef _Float16 half8 __attribute__((ext_vector_type(8)));
typedef float f32x4 __attribute__((ext_vector_type(4)));
typedef float f32x2 __attribute__((ext_vector_type(2)));
typedef float f32x16 __attribute__((ext_vector_type(16)));
typedef unsigned u32x4 __attribute__((ext_vector_type(4)));
typedef unsigned u32x2 __attribute__((ext_vector_type(2)));
typedef GAS unsigned gu32;

constexpr int NB = 4, SEQ = 4096, NTOK = NB * SEQ, DM = 1024;
constexpr int NE = 32, TOPK = 4;
constexpr int N1 = 5888;
constexpr int N1_IN = 2816;
constexpr int MOE_ROWS = 73728;
constexpr float EPS = 1e-6f;
constexpr float C2 = 0.125f * 1.4426950408889634f;

constexpr size_t MiB = 1u << 20;
constexpr size_t WS_CTL = 0, CTL_ZERO_BYTES = 1 * MiB;
constexpr size_t WS_ROPE = 1 * MiB;
constexpr size_t WS_WGT = WS_ROPE + 256 * 1024;
constexpr size_t WS_WRH = WS_WGT + 32 * 1024;
constexpr size_t WS_WRL = WS_WRH + 64 * 1024;
constexpr size_t WS_W1T = 2 * MiB;
constexpr size_t WS_WPA = 14 * MiB, WS_WPP = 15 * MiB, WS_WPM = 15 * MiB + 512 * 1024, WS_WOUT = 16 * MiB, WS_WKV = 18 * MiB;
constexpr size_t WS_MEMN = 19 * MiB, WS_KM = 21 * MiB, WS_VMT = 21 * MiB + 512 * 1024;
constexpr size_t WS_IW = 22 * MiB, WS_IK = 23 * MiB;
constexpr size_t WS_RE = 25 * MiB, WS_RR = WS_RE + 256 * 1024, WS_RG = WS_RR + 256 * 1024, WS_SLOT = WS_RG + 256 * 1024, WS_RSTD = WS_SLOT + 256 * 1024;
constexpr size_t WS_WUP = 32 * MiB, WS_WDN = 160 * MiB, WS_XN = 224 * MiB;
constexpr size_t WS_Q = 256 * MiB, WS_K = 272 * MiB, WS_V = 288 * MiB, WS_IQ = 304 * MiB, WS_U = 320 * MiB, WS_QM = 328 * MiB;
constexpr size_t WS_YPOOL = 336 * MiB, WS_YMEM = 344 * MiB, WS_MASKT = 352 * MiB, WS_MERGED = 360 * MiB, WS_G = 392 * MiB;
constexpr size_t WS_XG = 488 * MiB, WS_ACT = 632 * MiB, WS_END = 776 * MiB;
constexpr size_t WS_XNB = WS_MERGED;
constexpr size_t WS_WU = 18 * MiB + 512 * 1024;
constexpr size_t WS_YCAT = WS_XN;
constexpr size_t WS_WCAT = WS_WPA;

constexpr int CW_TMO = 0;
constexpr int CW_CNT = 1024;
constexpr int CW_BAR = 4096;
constexpr int CW_UPDONE = 8192;

constexpr int RING_BYTES = 131072;
constexpr int LDS_BYTES = 155648;
constexpr int MISC_OFF = LDS_BYTES - 1024;

#define LDS_WAIT() asm volatile("s_waitcnt lgkmcnt(0)" ::: "memory")
#define VM_WAIT() asm volatile("s_waitcnt vmcnt(0)" ::: "memory")

typedef __bf16 bf16x2_cv __attribute__((ext_vector_type(2)));
__device__ __forceinline__ unsigned cvt_pk_bf16(float lo, float hi) { f32x2 v = {lo, hi}; bf16x2_cv b = __builtin_convertvector(v, bf16x2_cv); return __builtin_bit_cast(unsigned, b); }
__device__ __forceinline__ unsigned cvt_pk_fp8x4(float a, float b, float c, float d) { int w = 0; w = __builtin_amdgcn_cvt_pk_fp8_f32(a, b, w, false); w = __builtin_amdgcn_cvt_pk_fp8_f32(c, d, w, true); return (unsigned)w; }
__device__ __forceinline__ unsigned cvt_pk_bf16_s(float lo, float hi) { return cvt_pk_bf16(lo, hi); }
typedef _Float16 h2_t __attribute__((ext_vector_type(2)));
__device__ __forceinline__ unsigned cvt_pk_f16(float lo, float hi) { h2_t v = {(_Float16)lo, (_Float16)hi}; return __builtin_bit_cast(unsigned, v); }
__device__ __forceinline__ float bf2f(unsigned short b) { return __builtin_bit_cast(float, (unsigned)b << 16); }
__device__ __forceinline__ float bflo(unsigned w) { return __builtin_bit_cast(float, w << 16); }
__device__ __forceinline__ float bfhi(unsigned w) { return __builtin_bit_cast(float, w & 0xffff0000u); }
__device__ __forceinline__ int lane_id() { int l; asm volatile("v_mbcnt_lo_u32_b32 %0, -1, 0\n\tv_mbcnt_hi_u32_b32 %0, -1, %0" : "=v"(l)); return l; }
__device__ __forceinline__ float wave_sum(float v) {
#pragma unroll
    for (int o = 1; o < 64; o <<= 1) v += __shfl_xor(v, o);
    return v;
}
typedef short s16x2_t __attribute__((ext_vector_type(2)));
__device__ __forceinline__ int wave_sum_i(int v) {
    v += __builtin_amdgcn_update_dpp(0, v, 0xB1, 0xf, 0xf, false);
    v += __builtin_amdgcn_update_dpp(0, v, 0x4E, 0xf, 0xf, false);
    v += __builtin_amdgcn_update_dpp(0, v, 0x141, 0xf, 0xf, false);
    v += __builtin_amdgcn_update_dpp(0, v, 0x140, 0xf, 0xf, false);
    return __builtin_amdgcn_readlane(v, 0) + __builtin_amdgcn_readlane(v, 16) + __builtin_amdgcn_readlane(v, 32) + __builtin_amdgcn_readlane(v, 48);
}
__device__ __forceinline__ float sigmoidf_fast(float x) { return __builtin_amdgcn_rcpf(1.f + __builtin_amdgcn_exp2f(-1.4426950408889634f * x)); }

#ifndef PG8_DMA_AUX
#define PG8_DMA_AUX 0
#endif
namespace pg8 {
constexpr int BM = 256, BK = 64, HALF = 128, HTB = HALF * BK * 2, STAGE_BYTES = 8 * HTB, NXCD = 8, WGM = 8;
__host__ __device__ __forceinline__ int lds_byte(int r, int c) { const int st = (r >> 4) * 2 + (c >> 5), rr = r & 15, cc = c & 31, ob = rr * 64 + cc * 2; return st * 1024 + (ob ^ (((ob >> 9) & 1) << 5)); }
__host__ __device__ __forceinline__ void stage_rc(int b, int& R, int& C) { const int st = b / 1024, sb = b % 1024, swz = sb ^ (((sb >> 9) & 1) << 5); R = (st >> 1) * 16 + swz / 64; C = (st & 1) * 32 + (swz % 64) / 2; }
__host__ __device__ __forceinline__ int perm32(int rho) { const int n = rho >> 4, i = rho & 15; return 8 * (i >> 2) + 4 * n + (i & 3); }

struct Unit { int pm, pn, kind, c0; const char* a; const char* b; };

__device__ __forceinline__ void tile_order(int L, int nM, int nN, int& pm, int& pn) {
    const int nwg = nM * nN; int wgid = L;
    { const int q = nwg / NXCD, r = nwg % NXCD, xcd = wgid % NXCD, off = wgid / NXCD; wgid = (xcd < r ? xcd * (q + 1) : r * (q + 1) + (xcd - r) * q) + off; }
    const int nig = WGM * nN, gid = wgid / nig, fm = gid * WGM, gsz = (nM - fm) < WGM ? (nM - fm) : WGM;
    pm = fm + ((wgid % nig) % gsz); pn = (wgid % nig) / gsz;
}

struct NoHook { template <class A> __device__ __forceinline__ void operator()(A&, const Unit&, int, int, int, int, int) const {} };
typedef int v8i_t __attribute__((ext_vector_type(8)));
template <class Epi, class Sched, bool ALIGN_EPI = false, bool SP2 = false, class Hook = NoHook, int ESZ = 2>
__device__ __forceinline__ void gemm_phase(const int wid, LAS unsigned char* lds, const int K, const Sched& S, const Epi& E, const int ktiles = 0, const Hook& H = Hook()) {
    int lane = lane_id(); asm volatile("" : "+v"(lane));
    const int tid = wid * 64 + lane, wr = wid >> 2, wc = wid & 3, fr = lane & 15, fq = lane >> 4;
    const int nt = ktiles ? ktiles : K * ESZ / 128;
    unsigned voffA[2], voffB[2];
#pragma unroll
    for (int i = 0; i < 2; ++i) { int R, C; stage_rc(tid * 16 + i * 8192, R, C); const int Rb = Epi::PERM ? ((R & ~31) + perm32(R & 31)) : R;
        voffA[i] = (unsigned)(R * K * ESZ + C * 2); voffB[i] = (unsigned)(Rb * K * ESZ + C * 2); }
    const size_t kstep = (size_t)(BK * 2);
    const size_t hstep = (size_t)HALF * K * ESZ;
    const unsigned ldsw = (unsigned)wid * 1024u;
#ifndef FP8_FRAG_CONTIG
    const int aoff0 = lds_byte(wr * 64 + fr, fq * 8), aoff1 = lds_byte(wr * 64 + fr, fq * 8 + 32);
    const int boff0 = lds_byte(wc * 32 + fr, fq * 8), boff1 = lds_byte(wc * 32 + fr, fq * 8 + 32);
#else
    const int aoff0 = lds_byte(wr * 64 + fr, ESZ == 2 ? fq * 8 : fq * 16), aoff1 = lds_byte(wr * 64 + fr, ESZ == 2 ? fq * 8 + 32 : fq * 16 + 8);
    const int boff0 = lds_byte(wc * 32 + fr, ESZ == 2 ? fq * 8 : fq * 16), boff1 = lds_byte(wc * 32 + fr, ESZ == 2 ? fq * 8 + 32 : fq * 16 + 8);
#endif
#define PG8_SA(b, h) (((b) * 2 + (h)) * HTB)
#define PG8_SB(b, h) ((4 + (b) * 2 + (h)) * HTB)
    const unsigned lds0 = (unsigned)(uintptr_t)lds;
#define PG8_STAGE(bufoff, gbase, voff) do { _Pragma("unroll") for (int _i = 0; _i < 2; ++_i) { unsigned keep_; \
        asm volatile("s_mov_b32 %0, m0\n\ts_mov_b32 m0, %3\n\ts_nop 2\n\tglobal_load_lds_dwordx4 %1, %2\n\ts_mov_b32 m0, %0" : "=&s"(keep_) : "v"((voff)[_i]), "s"((const char*)(gbase)), "s"(lds0 + (unsigned)(bufoff) + ldsw + (unsigned)_i * 8192u) : "memory"); } } while (0)
#define PG8_LDA(dst, b, h) do { _Pragma("unroll") for (int m = 0; m < 4; ++m) { dst[m][0] = *(const LAS bf16x8*)(lds + PG8_SA(b, h) + aoff0 + m * 2048); dst[m][1] = *(const LAS bf16x8*)(lds + PG8_SA(b, h) + aoff1 + m * 2048); } } while (0)
#define PG8_LDB(dst, b, h) do { _Pragma("unroll") for (int n = 0; n < 2; ++n) { dst[n][0] = *(const LAS bf16x8*)(lds + PG8_SB(b, h) + boff0 + n * 2048); dst[n][1] = *(const LAS bf16x8*)(lds + PG8_SB(b, h) + boff1 + n * 2048); } } while (0)
#define PG8_CAT(x) __builtin_shufflevector(__builtin_bit_cast(u32x4, (x)[0]), __builtin_bit_cast(u32x4, (x)[1]), 0, 1, 2, 3, 4, 5, 6, 7)
#define PG8_MMA(ai, bj, At, Bt) do { __builtin_amdgcn_s_setprio(1); _Pragma("unroll") for (int m = 0; m < 4; ++m) _Pragma("unroll") for (int n = 0; n < 2; ++n) { \
        if constexpr (ESZ == 2) { _Pragma("unroll") for (int k = 0; k < 2; ++k) acc[ai][bj][m][n] = __builtin_amdgcn_mfma_f32_16x16x32_bf16(Bt[n][k], At[m][k], acc[ai][bj][m][n], 0, 0, 0); } \
        else acc[ai][bj][m][n] = __builtin_amdgcn_mfma_scale_f32_16x16x128_f8f6f4(__builtin_bit_cast(v8i_t, PG8_CAT(Bt[n])), __builtin_bit_cast(v8i_t, PG8_CAT(At[m])), acc[ai][bj][m][n], 0, 0, 0, 0, 0, 0); }        \
        __builtin_amdgcn_s_setprio(0); } while (0)
#define PG8_WAIT_V(n) asm volatile("s_waitcnt vmcnt(" #n ")" ::: "memory")
#define PG8_WAIT_L(n) asm volatile("s_waitcnt lgkmcnt(" #n ")" ::: "memory")
#define PG8_BAR __builtin_amdgcn_s_barrier()
#define PG8_SCHED __builtin_amdgcn_sched_barrier(0)
    Unit cur, nxt; int ui = 0;
    if (!S.next(0, cur)) return;
    f32x4 acc[2][2][4][2];
#pragma unroll
    for (int a = 0; a < 2; ++a)
#pragma unroll
        for (int b = 0; b < 2; ++b)
#pragma unroll
            for (int m = 0; m < 4; ++m)
#pragma unroll
                for (int n = 0; n < 2; ++n) acc[a][b][m][n] = (f32x4){0.f, 0.f, 0.f, 0.f};
    bf16x8 At[4][2], B0[2][2], B1[2][2];
#define PG8_UNI(p) ((const char*)(((unsigned long long)(unsigned)__builtin_amdgcn_readfirstlane((int)(unsigned)((unsigned long long)(p) >> 32)) << 32) | (unsigned)__builtin_amdgcn_readfirstlane((int)(unsigned)(unsigned long long)(p))))
    const char* cA = PG8_UNI(cur.a); const char* cB = PG8_UNI(cur.b);
    if constexpr (SP2) {
        PG8_STAGE(PG8_SB(0, 0), cB, voffB); PG8_STAGE(PG8_SB(0, 1), cB + hstep, voffB); PG8_STAGE(PG8_SA(0, 0), cA, voffA); PG8_STAGE(PG8_SA(0, 1), cA + hstep, voffA);
        if (wr == 1) PG8_BAR;
        PG8_WAIT_V(2); PG8_BAR;
        PG8_STAGE(PG8_SB(1, 0), cB + kstep, voffB); PG8_STAGE(PG8_SA(1, 0), cA + kstep, voffA); PG8_STAGE(PG8_SB(1, 1), cB + hstep + kstep, voffB);
        PG8_WAIT_V(6); PG8_BAR;
    } else {
        PG8_STAGE(PG8_SB(0, 0), cB, voffB); PG8_STAGE(PG8_SA(0, 0), cA, voffA); PG8_STAGE(PG8_SB(0, 1), cB + hstep, voffB); PG8_STAGE(PG8_SA(0, 1), cA + hstep, voffA);
        if (wr == 1) PG8_BAR;
        PG8_WAIT_V(4); PG8_BAR;
        PG8_STAGE(PG8_SB(1, 0), cB + kstep, voffB); PG8_STAGE(PG8_SA(1, 0), cA + kstep, voffA); PG8_STAGE(PG8_SB(1, 1), cB + hstep + kstep, voffB);
        PG8_WAIT_V(6); PG8_BAR;
    }
    for (;;) {
        const bool has_next = S.next(ui + 1, nxt);
        const char* nA = PG8_UNI(has_next ? nxt.a : cA); const char* nB = PG8_UNI(has_next ? nxt.b : cB);
#pragma nounroll
        for (int t = 0; t < nt; t += 2) {
            const bool last = (t == nt - 2);
            H(acc, cur, t, wr, wc, fr, fq);
            const char* a1 = cA + (size_t)(t + 1) * kstep;
            const char* a2 = last ? nA : cA + (size_t)(t + 2) * kstep; const char* b2 = last ? nB : cB + (size_t)(t + 2) * kstep;
            const char* a3 = a2 + kstep; const char* b3 = b2 + kstep;
            if constexpr (SP2) {
            PG8_LDB(B0, 0, 0); PG8_LDB(B1, 0, 1); PG8_SCHED; PG8_LDA(At, 0, 0); PG8_STAGE(PG8_SA(1, 1), a1 + hstep, voffA);
            PG8_WAIT_V(8); PG8_WAIT_L(0); PG8_BAR; PG8_MMA(0, 0, At, B0); PG8_MMA(0, 1, At, B1); PG8_BAR; PG8_SCHED;
            PG8_LDA(At, 0, 1); PG8_STAGE(PG8_SB(0, 0), b2, voffB); PG8_STAGE(PG8_SB(0, 1), b2 + hstep, voffB); PG8_STAGE(PG8_SA(0, 0), a2, voffA);
            PG8_WAIT_V(8); PG8_WAIT_L(0); PG8_BAR; PG8_MMA(1, 0, At, B0); PG8_MMA(1, 1, At, B1); PG8_BAR; PG8_SCHED;
            PG8_LDB(B0, 1, 0); PG8_LDB(B1, 1, 1); PG8_SCHED; PG8_LDA(At, 1, 0); PG8_STAGE(PG8_SA(0, 1), a2 + hstep, voffA);
            PG8_WAIT_V(8); PG8_WAIT_L(0); PG8_BAR; PG8_MMA(0, 0, At, B0); PG8_MMA(0, 1, At, B1); PG8_BAR; PG8_SCHED;
            PG8_LDA(At, 1, 1); PG8_STAGE(PG8_SB(1, 0), b3, voffB); PG8_STAGE(PG8_SB(1, 1), b3 + hstep, voffB); PG8_STAGE(PG8_SA(1, 0), a3, voffA);
            PG8_WAIT_V(8); PG8_WAIT_L(0); PG8_BAR; PG8_MMA(1, 0, At, B0); PG8_MMA(1, 1, At, B1); PG8_BAR; PG8_SCHED;
            } else {
            PG8_LDB(B0, 0, 0); PG8_SCHED; PG8_LDA(At, 0, 0); PG8_STAGE(PG8_SA(1, 1), a1 + hstep, voffA);
            PG8_WAIT_L(8); PG8_BAR; PG8_WAIT_L(0); PG8_MMA(0, 0, At, B0); PG8_BAR; PG8_SCHED;
            PG8_LDB(B1, 0, 1); PG8_STAGE(PG8_SB(0, 0), b2, voffB);
            PG8_BAR; PG8_WAIT_L(0); PG8_MMA(0, 1, At, B1); PG8_BAR;
            PG8_LDA(At, 0, 1); PG8_STAGE(PG8_SA(0, 0), a2, voffA);
            PG8_BAR; PG8_WAIT_L(0); PG8_MMA(1, 0, At, B0); PG8_BAR; PG8_SCHED;
            PG8_STAGE(PG8_SB(0, 1), b2 + hstep, voffB);
            PG8_WAIT_V(6); PG8_BAR; PG8_MMA(1, 1, At, B1); PG8_BAR;
            PG8_LDB(B0, 1, 0); PG8_SCHED; PG8_LDA(At, 1, 0); PG8_STAGE(PG8_SA(0, 1), a2 + hstep, voffA);
            PG8_WAIT_L(8); PG8_BAR; PG8_WAIT_L(0); PG8_MMA(0, 0, At, B0); PG8_BAR; PG8_SCHED;
            PG8_LDB(B1, 1, 1); PG8_STAGE(PG8_SB(1, 0), b3, voffB);
            PG8_BAR; PG8_WAIT_L(0); PG8_MMA(0, 1, At, B1); PG8_BAR;
            PG8_LDA(At, 1, 1); PG8_STAGE(PG8_SA(1, 0), a3, voffA);
            PG8_BAR; PG8_WAIT_L(0); PG8_MMA(1, 0, At, B0); PG8_BAR; PG8_SCHED;
            PG8_STAGE(PG8_SB(1, 1), b3 + hstep, voffB);
            PG8_WAIT_V(6); PG8_BAR; PG8_MMA(1, 1, At, B1); PG8_BAR;
            }
        }
        if constexpr (ALIGN_EPI) { if (wr == 0) PG8_BAR; }
        { int l2 = lane_id(); asm volatile("" : "+v"(l2)); E(acc, cur, wr, wc, l2 & 15, l2 >> 4); }
        if (!has_next) break;
#pragma unroll
        for (int a = 0; a < 2; ++a)
#pragma unroll
            for (int b = 0; b < 2; ++b)
#pragma unroll
                for (int m = 0; m < 4; ++m)
#pragma unroll
                    for (int n = 0; n < 2; ++n) acc[a][b][m][n] = (f32x4){0.f, 0.f, 0.f, 0.f};
        cur = nxt; cA = nA; cB = nB; ++ui;
        if constexpr (ALIGN_EPI) { if (wr == 1) PG8_BAR; }
    }
    PG8_WAIT_V(0);
    if constexpr (!ALIGN_EPI) { if (wr == 0) PG8_BAR; }
    PG8_BAR;
#undef PG8_SA
#undef PG8_SB
#undef PG8_STAGE
#undef PG8_LDA
#undef PG8_LDB
#undef PG8_MMA
#undef PG8_CAT
#undef PG8_UNI
#undef PG8_WAIT_V
#undef PG8_WAIT_L
#undef PG8_BAR
#undef PG8_SCHED
}
}
using pg8::Unit;
constexpr bool K_ALIGN = true, K_SP2 = true;
#ifndef P4_ALIGN
#define P4_ALIGN true
#endif
#ifndef P4_SP2
#define P4_SP2 true
#endif

enum { KQ = 0, KK = 1, KV = 2, KIQ = 3, KU = 4, KQM = 5, KIKW = 6, KG = 7, KKM = 8, KVMT = 9 };
struct EpiP1 {
    static constexpr bool PERM = true;
    bf16_t *Q, *K, *V, *U, *QM, *G, *KM, *VMT; unsigned short *IQ, *IK; float* IW; const float* bgate; const float* rope; float accscale;
    __device__ __forceinline__ static void rope4(f32x4& v, const f32x4 cs) {
        const float a1 = v[0] * cs[0] - v[1] * cs[1], a2 = v[1] * cs[0] + v[0] * cs[1];
        const float b1 = v[2] * cs[2] - v[3] * cs[3], b2 = v[3] * cs[2] + v[2] * cs[3];
        v = (f32x4){a1, a2, b1, b2};
    }
    template <int KIND> __device__ __forceinline__ void run(const f32x4 (&acc)[2][2][4][2], const Unit& u, int wr, int wc, int fr, int fq) const {
        const int row0 = u.pm * 256 + wr * 64 + fr;
        constexpr bool ROPE = (KIND == KQ || KIND == KK || KIND == KIQ || KIND == KIKW);
        f32x4 gb0[2], gb1[2];
        if constexpr (KIND == KG) {
#pragma unroll
            for (int bj = 0; bj < 2; ++bj) { const float* bp = bgate + u.c0 + bj * 128 + wc * 32 + 8 * fq; gb0[bj] = *(const f32x4*)bp; gb1[bj] = *(const f32x4*)(bp + 4); } }
        const bool ropelane = ROPE && ((wc & 1) == 0) && (fq < 2);
#pragma unroll
        for (int ai = 0; ai < 2; ++ai) {
            f32x4 csa[4], csb[4];
#pragma unroll
            for (int m = 0; m < 4; ++m) { csa[m] = (f32x4){1.f, 0.f, 1.f, 0.f}; csb[m] = csa[m];
                if (ROPE) { if (ropelane) { const float* rp = rope + (size_t)((row0 + ai * 128 + m * 16) & (SEQ - 1)) * 16 + 8 * fq; csa[m] = *(const f32x4*)rp; csb[m] = *(const f32x4*)(rp + 4); } } }
#pragma unroll
            for (int m = 0; m < 4; ++m) {
                const int row = row0 + ai * 128 + m * 16;
                const f32x4 cs0 = csa[m], cs1 = csb[m];
#pragma unroll
                for (int bj = 0; bj < 2; ++bj) {
                    f32x4 v0 = acc[ai][bj][m][0] * accscale, v1 = acc[ai][bj][m][1] * accscale;
                    const int lc = bj * 128 + wc * 32 + 8 * fq;
                    if constexpr (KIND == KQ || KIND == KK || KIND == KIQ) { if (ropelane) { rope4(v0, cs0); rope4(v1, cs1); } }
                    if constexpr (KIND == KIKW) { if (ropelane && bj == 0 && wc == 0) { rope4(v0, cs0); rope4(v1, cs1); } }
                    if constexpr (KIND == KQ || KIND == KQM) { v0 = v0 * C2; v1 = v1 * C2; }
                    if constexpr (KIND == KIQ) { v0 = v0 * 0.125f; v1 = v1 * 0.125f; }
                    if constexpr (KIND == KG) {
#pragma unroll
                        for (int i = 0; i < 4; ++i) { v0[i] = sigmoidf_fast(v0[i] + gb0[bj][i]); v1[i] = sigmoidf_fast(v1[i] + gb1[bj][i]); }
                    }
                    if constexpr (KIND == KIQ) {
                        u32x4 w; w.x = cvt_pk_f16(v0[0], v0[1]); w.y = cvt_pk_f16(v0[2], v0[3]); w.z = cvt_pk_f16(v1[0], v1[1]); w.w = cvt_pk_f16(v1[2], v1[3]);
                        *(u32x4*)(IQ + (size_t)row * 512 + u.c0 + lc) = w;
                    } else if constexpr (KIND == KIKW) {
                        if (lc < 64) { u32x4 w; w.x = cvt_pk_f16(v0[0], v0[1]); w.y = cvt_pk_f16(v0[2], v0[3]); w.z = cvt_pk_f16(v1[0], v1[1]); w.w = cvt_pk_f16(v1[2], v1[3]);
                            *(u32x4*)(IK + (size_t)row * 64 + lc) = w; }
                        else if (lc == 64) { const float s = 0.35355339059327373f; float* p = IW + (size_t)row * 8; *(f32x4*)p = v0 * s; *(f32x4*)(p + 4) = v1 * s; }
                    } else if constexpr (KIND == KVMT) {
                        const int b = row >> 8, key = row & 255;
                        const float vv[8] = {v0[0], v0[1], v0[2], v0[3], v1[0], v1[1], v1[2], v1[3]};
#pragma unroll
                        for (int i = 0; i < 8; ++i) { const int c = lc + i, hm = c >> 6, d = c & 63; VMT[((size_t)(b * 4 + hm) * 64 + d) * 256 + key] = (bf16_t)(cvt_pk_bf16(vv[i], 0.f) & 0xffffu); }
                    } else {
                        u32x4 w; w.x = cvt_pk_bf16(v0[0], v0[1]); w.y = cvt_pk_bf16(v0[2], v0[3]); w.z = cvt_pk_bf16(v1[0], v1[1]); w.w = cvt_pk_bf16(v1[2], v1[3]);
                        bf16_t* dst;
                        if constexpr (KIND == KQ) dst = Q + (size_t)row * 512;
                        else if constexpr (KIND == KK) dst = K + (size_t)row * 512;
                        else if constexpr (KIND == KV) dst = V + (size_t)row * 512;
                        else if constexpr (KIND == KU) dst = U + (size_t)row * 256;
                        else if constexpr (KIND == KQM) dst = QM + (size_t)row * 256;
                        else if constexpr (KIND == KG) dst = G + (size_t)row * 3072;
                        else dst = KM + (size_t)row * 256;
                        *(u32x4*)(dst + u.c0 + lc) = w;
                    }
                }
            }
        }
    }
    __device__ __forceinline__ void operator()(const f32x4 (&acc)[2][2][4][2], const Unit& u, int wr, int wc, int fr, int fq) const {
        switch (u.kind) {
            case KQ: run<KQ>(acc, u, wr, wc, fr, fq); break;
            case KK: run<KK>(acc, u, wr, wc, fr, fq); break;
            case KV: run<KV>(acc, u, wr, wc, fr, fq); break;
            case KIQ: run<KIQ>(acc, u, wr, wc, fr, fq); break;
            case KU: run<KU>(acc, u, wr, wc, fr, fq); break;
            case KQM: run<KQM>(acc, u, wr, wc, fr, fq); break;
            case KIKW: run<KIKW>(acc, u, wr, wc, fr, fq); break;
            case KG: run<KG>(acc, u, wr, wc, fr, fq); break;
            case KKM: run<KKM>(acc, u, wr, wc, fr, fq); break;
            default: run<KVMT>(acc, u, wr, wc, fr, fq); break;
        }
    }
};
struct SchedU {
    const char *XNB, *WU; int G, c;
    __device__ __forceinline__ bool next(int i, Unit& u) const {
        const int j = G - 1 - c; if (i != 0 || j < 0 || j >= 64) return false;
        u.pm = j; u.pn = 8; u.kind = KU; u.c0 = 0; u.a = XNB + (size_t)j * 256 * 2048; u.b = WU; return true;
    }
};
struct Sched1 {
    const char *XN, *W1T, *MEMN, *WKV; int G, c;
    __device__ __forceinline__ bool next(int i, Unit& u) const {
        int L = i * G + c;
        if (G == 256) {
            if (i < 4) L = i * 256 + c; else if (i < 6) { if (c >= 192) return false; L = 1024 + (i - 4) * 192 + c; } else return false;
        }
        if (L < 64 * 22) {
            pg8::tile_order(L, 64, 22, u.pm, u.pn); if (u.pn >= 8) ++u.pn;
            u.a = XN + (size_t)u.pm * 256 * 1024; u.b = W1T + (size_t)u.pn * 256 * 1024;
            const int pn = u.pn;
            if (pn < 2) { u.kind = KQ; u.c0 = pn * 256; } else if (pn < 4) { u.kind = KK; u.c0 = (pn - 2) * 256; } else if (pn < 6) { u.kind = KV; u.c0 = (pn - 4) * 256; }
            else if (pn < 8) { u.kind = KIQ; u.c0 = (pn - 6) * 256; } else if (pn == 8) { u.kind = KU; u.c0 = 0; } else if (pn == 9) { u.kind = KQM; u.c0 = 0; }
            else if (pn == 10) { u.kind = KIKW; u.c0 = 0; } else { u.kind = KG; u.c0 = (pn - 11) * 256; }
            return true;
        }
        return false;
    }
};
template <int MODE> struct EpiGate {
    static constexpr bool PERM = true;
    const bf16_t* G; const bf16_t* PREV; bf16_t* OUT; int br;
    __device__ __forceinline__ void operator()(const f32x4 (&acc)[2][2][4][2], const Unit& u, int wr, int wc, int fr, int fq) const {
        const int row0 = u.pm * 256 + wr * 64 + fr, col0 = u.pn * 256 + wc * 32 + 8 * fq;
#pragma unroll
        for (int b0 = 0; b0 < 16; b0 += 8) {
            u32x4 gv[8], pv[MODE != 0 ? 8 : 1];
#pragma unroll
            for (int q = 0; q < 8; ++q) { const int st = b0 + q, ai = st >> 3, m = (st >> 1) & 3, bj = st & 1; const int row = row0 + ai * 128 + m * 16, col = col0 + bj * 128;
                gv[q] = *(const u32x4*)(G + (size_t)row * 3072 + br * 1024 + col);
                if constexpr (MODE != 0) pv[q] = *(const u32x4*)(PREV + (size_t)row * 1024 + col); }
#pragma unroll
            for (int q = 0; q < 8; ++q) { const int st = b0 + q, ai = st >> 3, m = (st >> 1) & 3, bj = st & 1; const int row = row0 + ai * 128 + m * 16, col = col0 + bj * 128;
                const u32x4 g = gv[q];
                const f32x4 v0 = acc[ai][bj][m][0], v1 = acc[ai][bj][m][1];
                float o[8] = {v0[0] * bflo(g.x), v0[1] * bfhi(g.x), v0[2] * bflo(g.y), v0[3] * bfhi(g.y), v1[0] * bflo(g.z), v1[1] * bfhi(g.z), v1[2] * bflo(g.w), v1[3] * bfhi(g.w)};
#ifdef ABL_ZERO_BR
                if (br == ABL_ZERO_BR) {
#pragma unroll
                    for (int i = 0; i < 8; ++i) o[i] = 0.f; }
#endif
                if constexpr (MODE != 0) { const u32x4 p = pv[q];
                    o[0] += bflo(p.x); o[1] += bfhi(p.x); o[2] += bflo(p.y); o[3] += bfhi(p.y); o[4] += bflo(p.z); o[5] += bfhi(p.z); o[6] += bflo(p.w); o[7] += bfhi(p.w); }
                u32x4 w; w.x = cvt_pk_bf16(o[0], o[1]); w.y = cvt_pk_bf16(o[2], o[3]); w.z = cvt_pk_bf16(o[4], o[5]); w.w = cvt_pk_bf16(o[6], o[7]);
                *(u32x4*)(OUT + (size_t)row * 1024 + col) = w;
            }
        }
    }
};
struct GateRatioHook {
    const bf16_t* G;
    __device__ __forceinline__ void operator()(f32x4 (&acc)[2][2][4][2], const Unit& u, int t, int wr, int wc, int fr, int fq) const {
        if (t != 8 && t != 12) return;
        const int bra = (t == 8) ? 0 : 1;
        int row0 = u.pm * 256 + wr * 64 + fr, col0 = u.pn * 256 + wc * 32 + 8 * fq;
        asm volatile("" : "+v"(row0), "+v"(col0));
#ifndef HOOK_BATCH
#define HOOK_BATCH 8
#endif
#pragma unroll
        for (int b0 = 0; b0 < 16; b0 += HOOK_BATCH) {
            u32x4 ga[HOOK_BATCH], gb[HOOK_BATCH];
#pragma unroll
            for (int q = 0; q < HOOK_BATCH; ++q) { const int st = b0 + q, ai = st >> 3, m = (st >> 1) & 3, bj = st & 1;
                const bf16_t* gp = G + (size_t)(row0 + ai * 128 + m * 16) * 3072 + bra * 1024 + col0 + bj * 128; ga[q] = *(const u32x4*)gp; gb[q] = *(const u32x4*)(gp + 1024); }
#pragma unroll
            for (int q = 0; q < HOOK_BATCH; ++q) { const int st = b0 + q, ai = st >> 3, m = (st >> 1) & 3, bj = st & 1;
                const float na[8] = {bflo(ga[q].x), bfhi(ga[q].x), bflo(ga[q].y), bfhi(ga[q].y), bflo(ga[q].z), bfhi(ga[q].z), bflo(ga[q].w), bfhi(ga[q].w)};
                const float nb[8] = {bflo(gb[q].x), bfhi(gb[q].x), bflo(gb[q].y), bfhi(gb[q].y), bflo(gb[q].z), bfhi(gb[q].z), bflo(gb[q].w), bfhi(gb[q].w)};
#pragma unroll
                for (int i = 0; i < 8; ++i) { const float rt = na[i] * __builtin_amdgcn_rcpf(fmaxf(nb[i], 1e-30f)); acc[ai][bj][m][i >> 2][i & 3] *= rt; } }
            __builtin_amdgcn_sched_barrier(0);
        }
    }
};
struct SchedSimple {
    const char *A, *B; int nM, nN, G, c; size_t tstep;
    __device__ __forceinline__ bool next(int i, Unit& u) const {
        const int L = i * G + c; if (L >= nM * nN) return false;
        pg8::tile_order(L, nM, nN, u.pm, u.pn); u.a = A + (size_t)u.pm * tstep; u.b = B + (size_t)u.pn * tstep; u.kind = 0; u.c0 = 0; return true;
    }
};
struct EpiRes {
    static constexpr bool PERM = false;
    const float* X; float* H;
    __device__ __forceinline__ void operator()(const f32x4 (&acc)[2][2][4][2], const Unit& u, int wr, int wc, int fr, int fq) const {
        const int row0 = u.pm * 256 + wr * 64 + fr, col0 = u.pn * 256 + wc * 32 + 4 * fq;
#pragma unroll
        for (int ai = 0; ai < 2; ++ai)
#pragma unroll
            for (int m = 0; m < 4; ++m) { const size_t off = (size_t)(row0 + ai * 128 + m * 16) * 1024 + col0;
#pragma unroll
                for (int bj = 0; bj < 2; ++bj)
#pragma unroll
                    for (int n = 0; n < 2; ++n) { const size_t o = off + bj * 128 + n * 16; *(f32x4*)(H + o) = *(const f32x4*)(X + o) + acc[ai][bj][m][n];
#ifdef DBG_DRAIN_ST
                        asm volatile("s_waitcnt vmcnt(0)" ::: "memory");
#endif
                    } }
    }
};
struct SchedMoe {
    const char *A, *W; const volatile LAS int* tpre0; int npn, G, c, rowb; int hx = -1, hs = 0; unsigned* wait_ctr = nullptr; int srot = 0;
    __device__ __forceinline__ bool next(int i, Unit& u) const {
        unsigned toff = (unsigned)(uintptr_t)tpre0; asm volatile("" : "+s"(toff)); const volatile LAS int* tpre = (const volatile LAS int*)(uintptr_t)toff;
        const int TT = __builtin_amdgcn_readfirstlane(tpre[32]); int T, pn;
        if ((G & 7) == 0 && (G >> 3) % npn == 0) { const int per = G >> 3, xcd = hx >= 0 ? hx : (c & 7), s0_ = hx >= 0 ? hs : (c >> 3), s = srot ? per - 1 - s0_ : s0_, mt = per / npn, chunk = (TT + 7) >> 3, tl = i * mt + s / npn;
            pn = s % npn; if (tl >= chunk) return false; T = xcd * chunk + tl; }
        else { const int L = i * G + c; T = L / npn; pn = L - T * npn; }
        if (T >= TT) return false;
        int e = 0;
#pragma unroll
        for (int j = 1; j < 32; ++j) e += (tpre[j] <= T) ? 1 : 0;
        e = __builtin_amdgcn_readfirstlane(e);
        if (wait_ctr) { unsigned sp_ = 0u; while (__hip_atomic_load(wait_ctr + T, __ATOMIC_RELAXED, __HIP_MEMORY_SCOPE_AGENT) < 64u) { __builtin_amdgcn_s_sleep(2); if (++sp_ > (1u << 22)) break; } }
        u.pm = T; u.pn = pn; u.kind = e; u.c0 = 0; u.a = A + (size_t)T * 256 * rowb; u.b = W + ((size_t)e * npn + pn) * 256 * rowb; return true;
    }
};
struct EpiSwiglu {
    static constexpr bool PERM = true;
    const float* bup; unsigned char* ACT; unsigned* done_ctr = nullptr;
    __device__ __forceinline__ void operator()(const f32x4 (&acc)[2][2][4][2], const Unit& u, int wr, int wc, int fr, int fq) const {
        const int row0 = u.pm * 256 + wr * 64 + fr, e = u.kind, jc = u.pn * 128 + wc * 32 + 8 * fq;
        const float* bg = bup + (size_t)e * 2048 + jc; const float* bl = bg + 1024;
        const f32x4 bg0 = *(const f32x4*)bg, bg1 = *(const f32x4*)(bg + 4), bl0 = *(const f32x4*)bl, bl1 = *(const f32x4*)(bl + 4);
#pragma unroll
        for (int ai = 0; ai < 2; ++ai)
#pragma unroll
            for (int m = 0; m < 4; ++m) {
                const int row = row0 + ai * 128 + m * 16;
                float o[8];
#pragma unroll
                for (int n = 0; n < 2; ++n) { const f32x4 gv = acc[ai][0][m][n] * (1.f / 64.f) + (n ? bg1 : bg0), lv = acc[ai][1][m][n] * (1.f / 64.f) + (n ? bl1 : bl0);
#pragma unroll
                    for (int i = 0; i < 4; ++i) { const float g = fminf(gv[i], 7.f), l = fminf(fmaxf(lv[i], -7.f), 7.f); o[n * 4 + i] = g * sigmoidf_fast(1.702f * g) * (l + 1.f); } }
                u32x2 w; w.x = cvt_pk_fp8x4(o[0], o[1], o[2], o[3]); w.y = cvt_pk_fp8x4(o[4], o[5], o[6], o[7]);
                *(u32x2*)(ACT + (size_t)row * 1024 + jc) = w;
            }
        if (done_ctr) { asm volatile("s_waitcnt vmcnt(0)" ::: "memory"); if (lane_id() == 0) __hip_atomic_fetch_add(done_ctr + u.pm, 1u, __ATOMIC_RELAXED, __HIP_MEMORY_SCOPE_AGENT); }
    }
};
struct EpiDown {
    static constexpr bool PERM = true;
    const float* bdn; unsigned char* Y;
    __device__ __forceinline__ void operator()(const f32x4 (&acc)[2][2][4][2], const Unit& u, int wr, int wc, int fr, int fq) const {
        const int row0 = u.pm * 256 + wr * 64 + fr, e = u.kind, col0 = u.pn * 256 + wc * 32 + 8 * fq;
        f32x4 bb0[2], bb1[2];
#pragma unroll
        for (int bj = 0; bj < 2; ++bj) { const float* bp = bdn + (size_t)e * 1024 + col0 + bj * 128; bb0[bj] = *(const f32x4*)bp; bb1[bj] = *(const f32x4*)(bp + 4); }
#pragma unroll
        for (int bj = 0; bj < 2; ++bj) { const f32x4 b0 = bb0[bj], b1 = bb1[bj];
#pragma unroll
            for (int ai = 0; ai < 2; ++ai)
#pragma unroll
                for (int m = 0; m < 4; ++m) { const int row = row0 + ai * 128 + m * 16; const f32x4 v0 = acc[ai][bj][m][0] * (1.f / 64.f) + b0, v1 = acc[ai][bj][m][1] * (1.f / 64.f) + b1;
                    float o[8];
#pragma unroll
                    for (int i = 0; i < 4; ++i) { o[i] = fminf(fmaxf(v0[i], -48.f), 48.f) * 8.f; o[4 + i] = fminf(fmaxf(v1[i], -48.f), 48.f) * 8.f; }
                    u32x2 w; w.x = cvt_pk_fp8x4(o[0], o[1], o[2], o[3]); w.y = cvt_pk_fp8x4(o[4], o[5], o[6], o[7]);
                    *(u32x2*)(Y + (size_t)row * 1024 + col0 + bj * 128) = w; } }
    }
};

namespace attn_body {
using bf16 = __hip_bfloat16;
using s16x4 = __attribute__((ext_vector_type(4))) short;
constexpr int BATCH = 4, NHEAD = 8, ASEQ = 4096, D = 64, ADM = NHEAD * D;
constexpr int NW = 8, QBLK = 32, QB = QBLK * NW, KVBLK = 64, NQB = ASEQ / QB;
constexpr int OPITCH = 1024;
__device__ __forceinline__ int crow(int r, int hi) { return (r & 3) + 8 * (r >> 2) + 4 * hi; }
#define SBAR() __builtin_amdgcn_sched_barrier(0)
constexpr int NSLOT = 3, SLOTB = 8192;
constexpr int LDS_K = 0, LDS_V = NSLOT * SLOTB, LDS_WS = 2 * NSLOT * SLOTB, LDS_OST = LDS_WS + NW * 64 * 4, LDS_BYTES_A = LDS_OST + NW * 4096;
__device__ __forceinline__ void glds16(const void* gsrc, unsigned lds_dst) { unsigned keep;
  asm volatile("s_mov_b32 %0, m0\n\ts_mov_b32 m0, %2\n\ts_nop 0\n\tglobal_load_lds_dwordx4 %1, off\n\ts_mov_b32 m0, %0" : "=&s"(keep) : "v"(gsrc), "s"(lds_dst) : "memory"); }
__device__ __forceinline__ float max3f(float a, float b, float c) { float r; asm("v_max3_f32 %0, %1, %2, %3" : "=v"(r) : "v"(a), "v"(b), "v"(c)); return r; }
__device__ __forceinline__ float max2f(float a, float b) { float r; asm("v_max_f32_e32 %0, %1, %2" : "=v"(r) : "v"(a), "v"(b)); return r; }
__device__ __forceinline__ float fadd_s(float a, float b) { float r; asm("v_add_f32_e32 %0, %1, %2" : "=v"(r) : "v"(a), "v"(b)); return r; }
__device__ __forceinline__ float fsub_s(float a, float b) { float r; asm("v_sub_f32_e32 %0, %1, %2" : "=v"(r) : "v"(a), "v"(b)); return r; }
typedef float f32x2_t __attribute__((ext_vector_type(2))); typedef __bf16 bf16x2_t __attribute__((ext_vector_type(2)));
__device__ __forceinline__ unsigned cvtpk_s(float lo, float hi) { f32x2_t v = {lo, hi}; bf16x2_t b = __builtin_convertvector(v, bf16x2_t); return __builtin_bit_cast(unsigned, b); }
#define WAIT_BAR(N) asm volatile("s_waitcnt vmcnt(" #N ") lgkmcnt(0)\n\ts_barrier" ::: "memory")
__device__ __forceinline__ void qkt(f32x16& p0, f32x16& p1, const char* Kslot, const bf16x8* qr, const f32x16& negm, int r32, int hi) {
  const char* kb = Kslot + hi * 1024 + r32 * 16;
  #pragma unroll
  for (int d0 = 0; d0 < 4; ++d0) {
    const bf16x8 b0 = *reinterpret_cast<const bf16x8*>(kb + d0 * 2048);
    const bf16x8 b1 = *reinterpret_cast<const bf16x8*>(kb + d0 * 2048 + 512);
    if (d0 == 0) { p0 = __builtin_amdgcn_mfma_f32_32x32x16_bf16(b0, qr[0], negm, 0, 0, 0); p1 = __builtin_amdgcn_mfma_f32_32x32x16_bf16(b1, qr[0], negm, 0, 0, 0); }
    else { p0 = __builtin_amdgcn_mfma_f32_32x32x16_bf16(b0, qr[d0], p0, 0, 0, 0); p1 = __builtin_amdgcn_mfma_f32_32x32x16_bf16(b1, qr[d0], p1, 0, 0, 0); } }
}
typedef __attribute__((address_space(3))) const char* lds_cptr;
typedef short v4i16_t __attribute__((ext_vector_type(4)));
__device__ __forceinline__ void kload8(bf16x8* kf, lds_cptr kp) {
  kf[0] = *(const LAS bf16x8*)(kp);        kf[1] = *(const LAS bf16x8*)(kp + 512);
  kf[2] = *(const LAS bf16x8*)(kp + 2048); kf[3] = *(const LAS bf16x8*)(kp + 2560);
  kf[4] = *(const LAS bf16x8*)(kp + 4096); kf[5] = *(const LAS bf16x8*)(kp + 4608);
  kf[6] = *(const LAS bf16x8*)(kp + 6144); kf[7] = *(const LAS bf16x8*)(kp + 6656);
}
__device__ __forceinline__ void kload2(bf16x8* kf, lds_cptr kp, int j) { kf[2 * j] = *(const LAS bf16x8*)(kp + j * 2048); kf[2 * j + 1] = *(const LAS bf16x8*)(kp + j * 2048 + 512); }
__device__ __forceinline__ s16x4 vtr(lds_cptr p) { return __builtin_bit_cast(s16x4, __builtin_amdgcn_ds_read_tr16_b64_v4i16((LAS v4i16_t*)p)); }
__device__ __forceinline__ float rowmax(const f32x16& p0, const f32x16& p1) {
  float a = max3f(p0[0], p0[1], p1[0]), b = max3f(p0[2], p0[3], p1[1]); a = max3f(a, p1[2], p1[3]);
  #pragma unroll
  for (int r = 4; r < 16; r += 4) { a = max3f(a, p0[r], p0[r + 1]); b = max3f(b, p0[r + 2], p0[r + 3]); a = max3f(a, p1[r], p1[r + 1]); b = max3f(b, p1[r + 2], p1[r + 3]); }
  const float m = max2f(a, b);
  auto rr = __builtin_amdgcn_permlane32_swap(__float_as_uint(m), __float_as_uint(m), false, false);
  return max2f(__uint_as_float(rr[0]), __uint_as_float(rr[1]));
}
__device__ __forceinline__ void pv(f32x16* o, int vb, bf16x8 pa0, bf16x8 pa1, bf16x8 pa2, bf16x8 pa3) {
  #pragma unroll
  for (int d0 = 0; d0 < 2; ++d0) { s16x4 lo[4], hi[4];
    #pragma unroll
    for (int ks = 0; ks < 4; ++ks) {
      asm volatile("ds_read_b64_tr_b16 %0,%1 offset:%c2" : "=&v"(lo[ks]) : "v"(vb), "i"(d0 * 4096 + ks * 1024) : "memory");
      asm volatile("ds_read_b64_tr_b16 %0,%1 offset:%c2" : "=&v"(hi[ks]) : "v"(vb), "i"(d0 * 4096 + ks * 1024 + 512) : "memory"); }
    asm volatile("s_waitcnt lgkmcnt(0)" ::: "memory"); SBAR();
    #define PK(k) (bf16x8){lo[k][0], lo[k][1], lo[k][2], lo[k][3], hi[k][0], hi[k][1], hi[k][2], hi[k][3]}
    o[d0] = __builtin_amdgcn_mfma_f32_32x32x16_bf16(pa0, PK(0), o[d0], 0, 0, 0);
    o[d0] = __builtin_amdgcn_mfma_f32_32x32x16_bf16(pa1, PK(1), o[d0], 0, 0, 0);
    o[d0] = __builtin_amdgcn_mfma_f32_32x32x16_bf16(pa2, PK(2), o[d0], 0, 0, 0);
    o[d0] = __builtin_amdgcn_mfma_f32_32x32x16_bf16(pa3, PK(3), o[d0], 0, 0, 0);
    #undef PK
  }
}
typedef const __attribute__((address_space(4))) unsigned long long* mask_cptr;
#define ATTN_STORE16(p, v) (*(u32x4*)(p) = (v))
template <int THRL> __device__ __forceinline__ void attn_unit(int wid_in, int b, int h, int qb, const bf16* Q, const bf16* __restrict__ K, const bf16* __restrict__ V, bf16* O, const unsigned long long* MT, char* shm) {
  int lane = lane_id(); asm volatile("" : "+v"(lane));
  const int r32 = lane & 31, hi = lane >> 5; const int wid = wid_in; const int tid = wid * 64 + lane; (void)tid;
  const long rowbase = (long)b * ASEQ; const int q0 = qb * QB;
  const bf16* Qw = Q + (rowbase + q0 + wid * QBLK) * ADM + h * D;
  const bf16 *Kh = K + rowbase * ADM + h * D, *Vh = V + rowbase * ADM + h * D;
  const unsigned long long mb_ = (unsigned long long)(MT + (size_t)__builtin_amdgcn_readfirstlane((b * 128 + qb * 8 + wid) * 64) * 32);
  const mask_cptr mbase = (mask_cptr)(((unsigned long long)(unsigned)__builtin_amdgcn_readfirstlane((int)(unsigned)(mb_ >> 32)) << 32) | (unsigned)__builtin_amdgcn_readfirstlane((int)(unsigned)mb_));
  const unsigned lds0 = (unsigned)(uintptr_t)shm;
  float* wsf = (float*)(shm + LDS_WS) + wid * 64;
  const bf16* ksrc = Kh + (long)lane * ADM + wid * 8;
  const bf16* vsrc = Vh + (long)(16 * (wid & 3) + (lane >> 2)) * ADM + (wid >> 2) * 32 + (lane & 3) * 8;
  const unsigned kdst = lds0 + LDS_K + wid * 1024, vdst = lds0 + LDS_V + wid * 1024;
  #define DMA_K(t, slot) glds16(ksrc + (long)(t) * KVBLK * ADM, (unsigned)__builtin_amdgcn_readfirstlane(kdst + (slot)))
  #define DMA_V(t, slot) glds16(vsrc + (long)(t) * KVBLK * ADM, (unsigned)__builtin_amdgcn_readfirstlane(vdst + (slot)))
  const int vb0 = (int)(lds0 + LDS_V) + ((lane >> 4) & 1) * 32 + (lane & 3) * 8 + (4 * hi + ((lane & 15) >> 2)) * 64;
  const char* Kbase = shm + LDS_K; bf16x8 kf[8];
  const lds_cptr shm3 = (lds_cptr)shm; const lds_cptr kp0 = shm3 + LDS_K + hi * 1024 + r32 * 16; const lds_cptr vp0 = shm3 + LDS_V + ((lane >> 4) & 1) * 32 + (lane & 3) * 8 + (4 * hi + ((lane & 15) >> 2)) * 64;
  const int NT = (q0 + QB) / KVBLK;
  DMA_K(0, 0); DMA_V(0, 0); DMA_K(1, SLOTB);
  bf16x8 qr[4];
  #pragma unroll
  for (int d0 = 0; d0 < 4; ++d0) qr[d0] = *reinterpret_cast<const bf16x8*>(&Qw[(long)r32 * ADM + d0 * 16 + hi * 8]);
  float mhat = 0.f, l_reg = 0.f; f32x16 o[2]; o[0] = f32x16{}; o[1] = f32x16{}; f32x16 negm = f32x16{}; asm volatile("" : "+v"(negm));
  float NEGV = -INFINITY; asm volatile("" : "+v"(NEGV));
  typedef unsigned long long u64x8_t __attribute__((ext_vector_type(8)));
  typedef const __attribute__((address_space(4))) u64x8_t* mask8_cptr;
  #define MLOAD(t) const mask8_cptr mp8_ = (mask8_cptr)(mbase + (size_t)(t) * 32); const u64x8_t mk0_ = mp8_[0], mk1_ = mp8_[1], mk2_ = mp8_[2], mk3_ = mp8_[3]
  #define CMASK(P0, P1) do { \
    asm volatile("s_nop 15\n\ts_nop 7" : "+v"(P0), "+v"(P1)); \
    _Pragma("unroll") for (int r_ = 0; r_ < 8; ++r_) { const unsigned long long a_ = mk0_[r_], b_ = mk1_[r_], c_ = mk2_[r_], d_ = mk3_[r_]; \
      asm("v_cndmask_b32_e64 %0, %1, %0, %2" : "+v"(P0[r_]) : "v"(NEGV), "s"(a_)); \
      asm("v_cndmask_b32_e64 %0, %1, %0, %2" : "+v"(P0[8 + r_]) : "v"(NEGV), "s"(b_)); \
      asm("v_cndmask_b32_e64 %0, %1, %0, %2" : "+v"(P1[r_]) : "v"(NEGV), "s"(c_)); \
      asm("v_cndmask_b32_e64 %0, %1, %0, %2" : "+v"(P1[8 + r_]) : "v"(NEGV), "s"(d_)); } } while (0)
  bool resc = false;
  #define START(P0, P1) do { const float rm = rowmax(P0, P1); resc = false; \
    { const float dl = (rm == -INFINITY) ? 0.f : rm; mhat = fadd_s(mhat, dl); \
      _Pragma("unroll") for (int r = 0; r < 16; ++r) { P0[r] = fsub_s(P0[r], dl); P1[r] = fsub_s(P1[r], dl); } \
      _Pragma("unroll") for (int r = 0; r < 16; ++r) negm[r] = -mhat; asm volatile("" : "+v"(negm)); } \
    _Pragma("unroll") for (int r = 0; r < 16; ++r) P0[r] = __builtin_amdgcn_exp2f(P0[r]); } while (0)
  #define RESC() do { if (resc) { asm volatile("s_waitcnt lgkmcnt(0)" ::: "memory"); \
      _Pragma("unroll") for (int d_ = 0; d_ < 2; ++d_) _Pragma("unroll") for (int r = 0; r < 16; ++r) o[d_][r] *= wsf[crow(r, hi)]; } } while (0)
  f32x16 pA0, pA1, pB0, pB1;
  int sl_prev = 0, sl_cur = 0, sl_next = SLOTB;
  #define ROT() do { sl_prev = sl_cur; sl_cur = sl_next; sl_next = (sl_next == (NSLOT - 1) * SLOTB) ? 0 : sl_next + SLOTB; } while (0)
  DMA_K(2, 2 * SLOTB);
  WAIT_BAR(3);
  { MLOAD(0); qkt(pA0, pA1, Kbase, qr, negm, r32, hi); CMASK(pA0, pA1); }
  START(pA0, pA1);
  _Pragma("unroll") for (int r = 0; r < 16; ++r) pA1[r] = __builtin_amdgcn_exp2f(pA1[r]);
  WAIT_BAR(0);
  DMA_K(3, 0); DMA_V(1, SLOTB);
  ROT();
  kload8(kf, kp0 + sl_cur);
  WAIT_BAR(2);
  s16x4 vlo[8], vhi[8]; u32x4 pw0, pw1, pw2, pw3;
  #define PKW(P, B) cvtpk_s(P[B], P[B + 1])
  #define PAF(k) __builtin_bit_cast(bf16x8, pw##k)
  #define VFR(i) (bf16x8){vlo[i][0], vlo[i][1], vlo[i][2], vlo[i][3], vhi[i][0], vhi[i][1], vhi[i][2], vhi[i][3]}
  #define PIN(x) asm volatile("" : "+v"(x))
  #define MX3(a, b, c) __builtin_fmaxf(__builtin_fmaxf((a), (b)), (c))
  #define GAPA(MF, A0, A1, A2, A3, W0, W1, PW) do { MF; sacc += A0; sacc += A1; sacc += A2; sacc += A3; PIN(sacc); W0; W1; PIN(PW); SBAR(); } while (0)
  #define EX(v) __builtin_amdgcn_exp2f(v)
  #define GAPB(MF, X, B) do { MF; X[B] = EX(X[B]); X[B + 1] = EX(X[B + 1]); X[B + 2] = EX(X[B + 2]); X[B + 3] = EX(X[B + 3]); PIN(X); SBAR(); } while (0)
  #define VRD(i) do { vlo[i] = vtr(vp_ + (((i) >> 2) * 4096 + ((i) & 3) * 1024)); vhi[i] = vtr(vp_ + (((i) >> 2) * 4096 + ((i) & 3) * 1024 + 512)); } while (0)
  #define KRD(G, j) do { if (G) { kload2(kf, kp0 + sl_next, j); SBAR(); } } while (0)
  #define STEP(C0, C1, P0, P1, t, GK, GV, GL) do { MLOAD(t); SBAR(); \
    const lds_cptr vp_ = vp0 + sl_prev; \
    VRD(0); SBAR(); float sacc = (P0[0] + P0[1]); \
    GAPA(C0 = __builtin_amdgcn_mfma_f32_32x32x16_bf16(kf[0], qr[0], negm, 0, 0, 0), P0[2], P0[3], P0[4], P0[5],     pw0[0] = PKW(P0, 0), pw0[1] = PKW(P0, 2), pw0); \
    VRD(4); SBAR(); GAPA(C1 = __builtin_amdgcn_mfma_f32_32x32x16_bf16(kf[1], qr[0], negm, 0, 0, 0), P0[6], P0[7], P0[8], P0[9],     pw0[2] = PKW(P0, 4), pw0[3] = PKW(P0, 6), pw0); \
    VRD(1); SBAR(); GAPA(C0 = __builtin_amdgcn_mfma_f32_32x32x16_bf16(kf[2], qr[1], C0, 0, 0, 0),   P0[10], P0[11], P0[12], P0[13], pw1[0] = PKW(P0, 8), pw1[1] = PKW(P0, 10), pw1); \
    VRD(5); SBAR(); GAPA(C1 = __builtin_amdgcn_mfma_f32_32x32x16_bf16(kf[3], qr[1], C1, 0, 0, 0),   P0[14], P0[15], P1[0], P1[1],   pw1[2] = PKW(P0, 12), pw1[3] = PKW(P0, 14), pw1); \
    VRD(2); SBAR(); GAPA(C0 = __builtin_amdgcn_mfma_f32_32x32x16_bf16(kf[4], qr[2], C0, 0, 0, 0),   P1[2], P1[3], P1[4], P1[5],     pw2[0] = PKW(P1, 0), pw2[1] = PKW(P1, 2), pw2); \
    VRD(6); SBAR(); GAPA(C1 = __builtin_amdgcn_mfma_f32_32x32x16_bf16(kf[5], qr[2], C1, 0, 0, 0),   P1[6], P1[7], P1[8], P1[9],     pw2[2] = PKW(P1, 4), pw2[3] = PKW(P1, 6), pw2); \
    VRD(3); SBAR(); GAPA(C0 = __builtin_amdgcn_mfma_f32_32x32x16_bf16(kf[6], qr[3], C0, 0, 0, 0),   P1[10], P1[11], P1[12], P1[13], pw3[0] = PKW(P1, 8), pw3[1] = PKW(P1, 10), pw3); \
    VRD(7); SBAR(); GAPA(C1 = __builtin_amdgcn_mfma_f32_32x32x16_bf16(kf[7], qr[3], C1, 0, 0, 0),   P1[14], P1[15], 0.f, 0.f,       pw3[2] = PKW(P1, 12), pw3[3] = PKW(P1, 14), pw3); \
    l_reg += sacc; \
    if (GK) { DMA_K((t) + 3, sl_cur); } if (GV) { DMA_V((t) + 1, sl_next); } \
    CMASK(C0, C1); \
    { float a = MX3(C0[0], C0[1], C1[0]), b = MX3(C0[2], C0[3], C1[1]); a = MX3(a, C1[2], C1[3]); \
      _Pragma("unroll") for (int r = 4; r < 16; r += 4) { a = MX3(a, C0[r], C0[r + 1]); b = MX3(b, C0[r + 2], C0[r + 3]); a = MX3(a, C1[r], C1[r + 1]); b = MX3(b, C1[r + 2], C1[r + 3]); } \
      float rm = __builtin_fmaxf(a, b); { auto rr = __builtin_amdgcn_permlane32_swap(__float_as_uint(rm), __float_as_uint(rm), false, false); rm = __builtin_fmaxf(__uint_as_float(rr[0]), __uint_as_float(rr[1])); } \
      resc = false; \
      if (__builtin_expect(__any(rm > (float)THRL), 0)) { const float dl = __builtin_fmaxf(rm, 0.f); mhat += dl; \
        _Pragma("unroll") for (int r = 0; r < 16; ++r) { C0[r] -= dl; C1[r] -= dl; } \
        _Pragma("unroll") for (int r = 0; r < 16; ++r) negm[r] = -mhat; asm volatile("" : "+v"(negm)); \
        const float f = __builtin_amdgcn_exp2f(-dl); l_reg *= f; if (hi == 0) wsf[r32] = f; resc = true; } } \
    SBAR(); \
    GAPB(o[0] = __builtin_amdgcn_mfma_f32_32x32x16_bf16(PAF(0), VFR(0), o[0], 0, 0, 0), C0, 0); \
    GAPB(o[1] = __builtin_amdgcn_mfma_f32_32x32x16_bf16(PAF(0), VFR(4), o[1], 0, 0, 0), C0, 4); \
    KRD(GL, 0); GAPB(o[0] = __builtin_amdgcn_mfma_f32_32x32x16_bf16(PAF(1), VFR(1), o[0], 0, 0, 0), C0, 8); \
    KRD(GL, 1); GAPB(o[1] = __builtin_amdgcn_mfma_f32_32x32x16_bf16(PAF(1), VFR(5), o[1], 0, 0, 0), C0, 12); \
    KRD(GL, 2); GAPB(o[0] = __builtin_amdgcn_mfma_f32_32x32x16_bf16(PAF(2), VFR(2), o[0], 0, 0, 0), C1, 0); \
    KRD(GL, 3); GAPB(o[1] = __builtin_amdgcn_mfma_f32_32x32x16_bf16(PAF(2), VFR(6), o[1], 0, 0, 0), C1, 4); \
    GAPB(o[0] = __builtin_amdgcn_mfma_f32_32x32x16_bf16(PAF(3), VFR(3), o[0], 0, 0, 0), C1, 8); \
    GAPB(o[1] = __builtin_amdgcn_mfma_f32_32x32x16_bf16(PAF(3), VFR(7), o[1], 0, 0, 0), C1, 12); \
    } while (0)
  int t = 1;
  for (; t + 5 < NT; t += 2) {
    STEP(pB0, pB1, pA0, pA1, t, true, true, true);     WAIT_BAR(2); RESC(); ROT();
    STEP(pA0, pA1, pB0, pB1, t + 1, true, true, true); WAIT_BAR(2); RESC(); ROT();
  }
  #define ENDW(tt) do { if ((tt) + 3 < NT) { WAIT_BAR(2); } else if ((tt) + 2 < NT) { WAIT_BAR(1); } else { WAIT_BAR(0); } } while (0)
  for (; t + 1 < NT; t += 2) {
    STEP(pB0, pB1, pA0, pA1, t, (t + 3 < NT), (t + 1 < NT), (t + 1 < NT));         ENDW(t);     RESC(); ROT();
    STEP(pA0, pA1, pB0, pB1, t + 1, (t + 4 < NT), (t + 2 < NT), (t + 2 < NT));     ENDW(t + 1); RESC(); ROT();
  }
  STEP(pB0, pB1, pA0, pA1, NT - 1, false, false, false); RESC();
  { float sacc = pB0[0] + pB0[1]; _Pragma("unroll") for (int r = 2; r < 16; ++r) sacc += pB0[r]; _Pragma("unroll") for (int r = 0; r < 16; ++r) sacc += pB1[r]; l_reg += sacc;
    pw0 = (u32x4){PKW(pB0, 0), PKW(pB0, 2), PKW(pB0, 4), PKW(pB0, 6)}; pw1 = (u32x4){PKW(pB0, 8), PKW(pB0, 10), PKW(pB0, 12), PKW(pB0, 14)}; pw2 = (u32x4){PKW(pB1, 0), PKW(pB1, 2), PKW(pB1, 4), PKW(pB1, 6)}; pw3 = (u32x4){PKW(pB1, 8), PKW(pB1, 10), PKW(pB1, 12), PKW(pB1, 14)};
    SBAR(); pv(o, vb0 + sl_cur, PAF(0), PAF(1), PAF(2), PAF(3)); }
  #undef PKW
  #undef PAF
  #undef VFR
  #undef PIN
  #undef MX3
  #undef GAPA
  #undef GAPB
  #undef EX
  #undef VRD
  #undef KRD
  #undef STEP
  #undef ENDW
  { auto rr = __builtin_amdgcn_permlane32_swap(__float_as_uint(l_reg), __float_as_uint(l_reg), false, false); l_reg = __uint_as_float(rr[0]) + __uint_as_float(rr[1]); }
  if (hi == 0) wsf[32 + r32] = l_reg; asm volatile("s_waitcnt lgkmcnt(0)" ::: "memory");
  float rli[16];
  #pragma unroll
  for (int r = 0; r < 16; ++r) rli[r] = __builtin_amdgcn_rcpf(wsf[32 + crow(r, hi)]);
  bf16* Ow = O + (rowbase + q0 + wid * QBLK) * OPITCH + h * D;
  { bf16* stg = (bf16*)(shm + LDS_OST) + wid * 2048;
    #pragma unroll
    for (int r = 0; r < 16; ++r) { const int orow = crow(r, hi);
      #pragma unroll
      for (int d0 = 0; d0 < 2; ++d0) stg[orow * 64 + d0 * 32 + r32] = __float2bfloat16(o[d0][r] * rli[r]); }
    asm volatile("s_waitcnt lgkmcnt(0)" ::: "memory");
    #pragma unroll
    for (int i = 0; i < 4; ++i) { const int row = i * 8 + (lane >> 3), ch = lane & 7; const u32x4 v = *(const u32x4*)(stg + row * 64 + ch * 8); ATTN_STORE16(Ow + (long)row * OPITCH + ch * 8, v); } }
  asm volatile("s_waitcnt lgkmcnt(0)\n\ts_barrier" ::: "memory");
  #undef DMA_K
  #undef DMA_V
  #undef CMASK
  #undef START
  #undef RESC
  #undef ROT
}
#undef SBAR
#undef WAIT_BAR
}

#define XB_TMO      128
#define XB_XCNT(j)  (256  + 64 * (j))
#define XB_XSUB(j)  (1280 + 64 * (j))
#define XB_XGEN(j)  (2304 + 64 * (j))
#define XB_TOP      3328
#define XB_TOPGEN   3392
#define XCD_BAR_WORDS 3456
#define XB_SPIN_CAP (1u << 18)
__device__ __forceinline__ unsigned xb_ld(unsigned* p)              { return __hip_atomic_load(p, __ATOMIC_RELAXED, __HIP_MEMORY_SCOPE_AGENT); }
__device__ __forceinline__ unsigned xb_add(unsigned* p, unsigned v) { return __hip_atomic_fetch_add(p, v, __ATOMIC_RELAXED, __HIP_MEMORY_SCOPE_AGENT); }
__device__ __forceinline__ unsigned xb_xcc_id() { return (unsigned)__builtin_amdgcn_s_getreg((3 << 11) | 20) & 0xFu; }
#define XB_SPIN(cond, bar) do { unsigned _sp = 0; while (cond) { __builtin_amdgcn_s_sleep(1); \
    if ((++_sp & 255u) == 0u) { if (xb_ld(&(bar)[XB_TMO])) break; if (_sp > XB_SPIN_CAP) { atomicAdd(&(bar)[XB_TMO], 1u); break; } } } } while (0)
struct XcdBarrier { unsigned* bar; unsigned x; volatile LAS unsigned* st; };
__device__ __forceinline__ XcdBarrier xcd_barrier_post(unsigned* bar, volatile LAS unsigned* st, bool leader) {
    XcdBarrier b; b.bar = bar; b.x = xb_xcc_id(); b.st = st;
    if (leader) st[2] = xb_add(&bar[XB_XCNT(b.x)], 1u);
    return b;
}
__device__ __forceinline__ void xcd_barrier_complete(unsigned* bar, unsigned x, unsigned& nloc, unsigned& nx) {
    const unsigned G = gridDim.x * gridDim.y * gridDim.z;
    unsigned sum, cnt, mine, sp = 0u;
    for (;;) {
        sum = 0u; cnt = 0u; mine = 0u;
#pragma unroll
        for (unsigned j = 0; j < 16; ++j) { const unsigned c = xb_ld(&bar[XB_XCNT(j)]); sum += c; cnt += (c > 0u) ? 1u : 0u; mine = (j == x) ? c : mine; }
        if (sum == G) break;
        __builtin_amdgcn_s_sleep(1);
        if ((++sp & 255u) == 0u) { if (xb_ld(&bar[XB_TMO])) break; if (sp > XB_SPIN_CAP) { atomicAdd(&bar[XB_TMO], 1u); break; } }
    }
    nloc = mine > 0u ? mine : 1u; nx = cnt > 0u ? cnt : 1u;
}
__device__ __forceinline__ void xcd_barrier(const XcdBarrier& b, bool leader) {
    asm volatile("s_waitcnt vmcnt(0)" ::: "memory");
    __syncthreads();
    if (leader) {
        unsigned* bar = b.bar;
        __builtin_amdgcn_s_waitcnt(0);
        unsigned nloc = b.st[0], nx = b.st[1];
        if (nloc == 0u) { xcd_barrier_complete(bar, b.x, nloc, nx); b.st[0] = nloc; b.st[1] = nx; }
#ifdef DBG_WG_RELEASE
        __builtin_amdgcn_fence(__ATOMIC_RELEASE, "agent"); asm volatile("s_waitcnt vmcnt(0)" ::: "memory");
#endif
        const unsigned old = xb_add(&bar[XB_XSUB(b.x)], 1u);
        const unsigned gen = old / nloc;
        if (old + 1u == (gen + 1u) * nloc) {
            __builtin_amdgcn_fence(__ATOMIC_RELEASE, "agent");
            asm volatile("s_waitcnt vmcnt(0)" ::: "memory");
            const unsigned og = xb_add(&bar[XB_TOP], 1u);
            const unsigned tg = og / nx;
            if (og + 1u == (tg + 1u) * nx) xb_add(&bar[XB_TOPGEN], 1u);
            else XB_SPIN(xb_ld(&bar[XB_TOPGEN]) == tg, bar);
            __builtin_amdgcn_fence(__ATOMIC_ACQUIRE, "agent");
            xb_add(&bar[XB_XGEN(b.x)], 1u);
            asm volatile("s_waitcnt vmcnt(0)" ::: "memory");
        } else {
            XB_SPIN(xb_ld(&bar[XB_XGEN(b.x)]) == gen, bar);
            __builtin_amdgcn_fence(__ATOMIC_ACQUIRE, "agent");
            asm volatile("s_waitcnt vmcnt(0)" ::: "memory");
        }
    }
    __syncthreads();
}

struct Frame {
    LAS unsigned char* lds; volatile LAS unsigned* MISC; unsigned* ctl; unsigned char* ws;
    int tid, lane, wave, vcu, G;
    const float* const __attribute__((address_space(4)))* in; float* out;
};
constexpr int NWAVES = 8;

__device__ __forceinline__ void transpose_item(const float* W, int ldw, bf16_t* WT, int K, LAS float* scr, int k0, int n0, int src, int lane, int dk0 = 0) {
    float v[32];
    const float* wp = W + (size_t)(k0 + (lane >> 5)) * ldw + (src >= 0 ? src : 0);
#pragma unroll
    for (int i = 0; i < 32; ++i) v[i] = wp[(size_t)(2 * i) * ldw];
#pragma unroll
    for (int i = 0; i < 32; ++i) { const int kk = 2 * i + (lane >> 5); scr[kk * 33 + (lane & 31)] = (src >= 0) ? v[i] : 0.f; }
    LDS_WAIT(); asm volatile("" ::: "memory");
    const int c = lane & 7;
#pragma unroll
    for (int j = 0; j < 4; ++j) { const int n = (lane >> 3) + 8 * j; const LAS float* s = scr + (8 * c) * 33 + n;
        u32x4 o; o.x = cvt_pk_bf16(s[0 * 33], s[1 * 33]); o.y = cvt_pk_bf16(s[2 * 33], s[3 * 33]); o.z = cvt_pk_bf16(s[4 * 33], s[5 * 33]); o.w = cvt_pk_bf16(s[6 * 33], s[7 * 33]);
        *(u32x4*)(WT + (size_t)(n0 + n) * K + dk0 + k0 + 8 * c) = o; }
    LDS_WAIT(); asm volatile("" ::: "memory");
}
__device__ __forceinline__ void transpose_item8(const float* W, int ldw, unsigned char* WT, int K, LAS float* scr, int k0, int n0, int src, int lane) {
    float v[32];
    const float* wp = W + (size_t)(k0 + (lane >> 5)) * ldw + (src >= 0 ? src : 0);
#pragma unroll
    for (int i = 0; i < 32; ++i) v[i] = wp[(size_t)(2 * i) * ldw];
#pragma unroll
    for (int i = 0; i < 32; ++i) { const int kk = 2 * i + (lane >> 5); scr[kk * 33 + (lane & 31)] = (src >= 0) ? v[i] * 64.f : 0.f; }
    LDS_WAIT(); asm volatile("" ::: "memory");
    const int c = lane & 3;
#pragma unroll
    for (int j = 0; j < 2; ++j) { const int n = (lane >> 2) + 16 * j; const LAS float* s = scr + (16 * c) * 33 + n;
        u32x4 o;
#pragma unroll
        for (int d = 0; d < 4; ++d) o[d] = cvt_pk_fp8x4(s[(4 * d) * 33], s[(4 * d + 1) * 33], s[(4 * d + 2) * 33], s[(4 * d + 3) * 33]);
        *(u32x4*)(WT + (size_t)(n0 + n) * K + k0 + 16 * c) = o; }
    LDS_WAIT(); asm volatile("" ::: "memory");
}
__device__ __forceinline__ int rope_perm(int p) { return (p < 16) ? ((p >> 1) + 8 * (p & 1)) : p; }
__device__ __forceinline__ int w1_src(int n) {
    if (n < 2048) { const int seg = n >> 9, o = n & 511, h = o >> 6; int p = o & 63; if (seg != 2) p = rope_perm(p); return seg * 512 + h * 64 + p; }
    if (n < 2304) return 2120 + (n - 2048);
    if (n < 2560) return 2376 + (n - 2304);
    const int o = n - 2560;
    if (o < 64) return 2048 + rope_perm(o);
    if (o < 72) return 2112 + (o - 64);
    return -1;
}
struct ConvItem { const float* wp; int ldw; unsigned char* op8; unsigned ldoff, stoff; };
constexpr int I_UP = 32 * 8 * 128, I_DN = 32 * 8 * 64, NCONV = I_UP + I_DN;
__device__ __forceinline__ ConvItem conv_expert_decode(Frame& F, int r_in, int lane) {
    const int r0 = __builtin_amdgcn_readfirstlane(r_in); const int h = lane >> 4, n = lane & 15; ConvItem c;
    if (r0 < I_UP) { const int e = r0 >> 10, q = r0 & 1023, kb = q >> 7, nb = q & 127, nn0 = nb * 16, tile = nn0 >> 8, o0 = nn0 & 255;
        const int src0 = (o0 < 128) ? tile * 128 + o0 : 1024 + tile * 128 + (o0 - 128);
        c.ldw = 2048; c.wp = F.in[17] + (size_t)e * 1024 * 2048 + (size_t)(kb * 128) * 2048 + src0;
        c.op8 = (unsigned char*)(F.ws + WS_WUP) + (size_t)e * 2048 * 1024 + (size_t)(nb * 16) * 1024 + kb * 128; }
    else { const int r = r0 - I_UP, e = r >> 9, q = r & 511, kb = q >> 6, nb = q & 63;
        c.ldw = 1024; c.wp = F.in[19] + (size_t)e * 1024 * 1024 + (size_t)(kb * 128) * 1024 + nb * 16;
        c.op8 = (unsigned char*)(F.ws + WS_WDN) + (size_t)e * 1024 * 1024 + (size_t)(nb * 16) * 1024 + kb * 128; }
    c.ldoff = (unsigned)(32 * h * c.ldw + n); c.stoff = (unsigned)(n * 1024 + 32 * h);
    return c;
}
__device__ __forceinline__ void conv_load(const ConvItem& c, float (&v)[32], int lane) {
#pragma unroll
    for (int i = 0; i < 32; ++i) { const float* rowp = c.wp + (size_t)(i * c.ldw); v[i] = rowp[c.ldoff]; }
}
__device__ __forceinline__ void conv_store(const ConvItem& c, const float (&v)[32], int lane) {
    u32x4 o0, o1;
#pragma unroll
    for (int d = 0; d < 4; ++d) { o0[d] = cvt_pk_fp8x4(v[4 * d] * 64.f, v[4 * d + 1] * 64.f, v[4 * d + 2] * 64.f, v[4 * d + 3] * 64.f);
                                  o1[d] = cvt_pk_fp8x4(v[16 + 4 * d] * 64.f, v[17 + 4 * d] * 64.f, v[18 + 4 * d] * 64.f, v[19 + 4 * d] * 64.f); }
    unsigned char* op = c.op8 + c.stoff;
    *(u32x4*)op = o0; *(u32x4*)(op + 16) = o1;
}
__device__ __forceinline__ void conv_expert_items3(Frame& F, int cid0, int stride, int lane) {
    float v0[32], v1[32], v2[32]; ConvItem c0, c1, c2;
    const bool h0 = cid0 < NCONV, h1 = cid0 + stride < NCONV, h2 = cid0 + 2 * stride < NCONV;
    if (h0) { c0 = conv_expert_decode(F, cid0, lane); conv_load(c0, v0, lane); }
    if (h1) { c1 = conv_expert_decode(F, cid0 + stride, lane); conv_load(c1, v1, lane); }
    if (h2) { c2 = conv_expert_decode(F, cid0 + 2 * stride, lane); conv_load(c2, v2, lane); }
    if (h0) conv_store(c0, v0, lane);
    if (h1) conv_store(c1, v1, lane);
    if (h2) conv_store(c2, v2, lane);
}
__device__ __forceinline__ void rms_row_to_fp8(const float* xrow, const float* g, unsigned char* orow, int lane, bf16_t* orow16 = nullptr) {
    const f32x4* xr = (const f32x4*)xrow + lane; const f32x4* gr = (const f32x4*)g + lane;
    f32x4 v[4]; float s = 0.f;
#pragma unroll
    for (int j = 0; j < 4; ++j) { v[j] = xr[64 * j]; s += (v[j].x * v[j].x + v[j].y * v[j].y) + (v[j].z * v[j].z + v[j].w * v[j].w); }
    const float rstd = 1.f / sqrtf(wave_sum(s) * (1.f / 1024.f) + EPS);
    unsigned* o4 = (unsigned*)orow + lane;
#pragma unroll
    for (int j = 0; j < 4; ++j) { const f32x4 gg = gr[64 * j]; const float a = v[j].x * rstd * gg.x, b = v[j].y * rstd * gg.y, c = v[j].z * rstd * gg.z, d = v[j].w * rstd * gg.w;
        o4[64 * j] = cvt_pk_fp8x4(a, b, c, d);
        if (orow16) { u32x2 w; w.x = cvt_pk_bf16(a, b); w.y = cvt_pk_bf16(c, d); ((u32x2*)orow16 + lane)[64 * j] = w; } }
}
__device__ __forceinline__ void rms_row_to_bf16(const float* xrow, const float* g, bf16_t* orow, int lane) {
    const f32x4* xr = (const f32x4*)xrow + lane; const f32x4* gr = (const f32x4*)g + lane;
    f32x4 v[4]; float s = 0.f;
#pragma unroll
    for (int j = 0; j < 4; ++j) { v[j] = xr[64 * j]; s += (v[j].x * v[j].x + v[j].y * v[j].y) + (v[j].z * v[j].z + v[j].w * v[j].w); }
    const float rstd = 1.f / sqrtf(wave_sum(s) * (1.f / 1024.f) + EPS);
    u32x2* o8 = (u32x2*)orow + lane;
#pragma unroll
    for (int j = 0; j < 4; ++j) { const f32x4 gg = gr[64 * j]; u32x2 w; w.x = cvt_pk_bf16(v[j].x * rstd * gg.x, v[j].y * rstd * gg.y); w.y = cvt_pk_bf16(v[j].z * rstd * gg.z, v[j].w * rstd * gg.w); o8[64 * j] = w; }
}
__device__ __forceinline__ void p0_prologue(Frame& F) {
    LAS float* scr = (LAS float*)(F.lds + F.wave * 16384);
    const int gw = F.vcu * NWAVES + F.wave, NGW = F.G * NWAVES, lane = F.lane;
    unsigned char* ws = F.ws;
    constexpr int I_IN = 16 * 88, I_GT = 16 * 96, I_PA = 8 * 32, I_PP = 4 * 32, I_PM = 4 * 32, I_OUT = 16 * 32, I_KV = 16 * 16, I_WU = 16 * 8;
    constexpr int NITEMS = I_UP + I_DN + I_IN + I_GT + I_PA + I_PP + I_PM + I_OUT + I_KV + I_WU;
    for (int it = gw + I_UP + I_DN; it < NITEMS; it += NGW) {
        int r = it;
        if (r < I_UP) { const int e = r >> 10, q = r & 1023, kb = q >> 6, nb = q & 63, n = nb * 32 + (lane & 31), tile = n >> 8, o = n & 255;
            const int src = (o < 128) ? tile * 128 + o : 1024 + tile * 128 + (o - 128);
            transpose_item(F.in[17] + (size_t)e * 1024 * 2048, 2048, (bf16_t*)(ws + WS_WUP) + (size_t)e * 2048 * 1024, 1024, scr, kb * 64, nb * 32, src, lane); continue; } r -= I_UP;
        if (r < I_DN) { const int e = r >> 9, q = r & 511, kb = q >> 5, nb = q & 31;
            transpose_item(F.in[19] + (size_t)e * 1024 * 1024, 1024, (bf16_t*)(ws + WS_WDN) + (size_t)e * 1024 * 1024, 1024, scr, kb * 64, nb * 32, nb * 32 + (lane & 31), lane); continue; } r -= I_DN;
        if (r < I_IN) { const int kb = r / 88, nb = r % 88;
            transpose_item8(F.in[3], 2632, (unsigned char*)(ws + WS_W1T), 1024, scr, kb * 64, nb * 32, w1_src(nb * 32 + (lane & 31)), lane); continue; } r -= I_IN;
        if (r < I_GT) { const int kb = r / 96, nb = r % 96;
            transpose_item8(F.in[4], 3072, (unsigned char*)(ws + WS_W1T) + (size_t)N1_IN * 1024, 1024, scr, kb * 64, nb * 32, nb * 32 + (lane & 31), lane); continue; } r -= I_GT;
        if (r < I_PA) { const int kb = r >> 5, nb = r & 31;
            transpose_item(F.in[6], 1024, (bf16_t*)(ws + WS_WCAT), 1024, scr, kb * 64, nb * 32, nb * 32 + (lane & 31), lane, 0); continue; } r -= I_PA;
        if (r < I_PP) { const int kb = r >> 5, nb = r & 31;
            transpose_item(F.in[7], 1024, (bf16_t*)(ws + WS_WCAT), 1024, scr, kb * 64, nb * 32, nb * 32 + (lane & 31), lane, 512); continue; } r -= I_PP;
        if (r < I_PM) { const int kb = r >> 5, nb = r & 31;
            transpose_item(F.in[8], 1024, (bf16_t*)(ws + WS_WCAT), 1024, scr, kb * 64, nb * 32, nb * 32 + (lane & 31), lane, 768); continue; } r -= I_PM;
        if (r < I_OUT) { const int kb = r >> 5, nb = r & 31;
            transpose_item(F.in[13], 1024, (bf16_t*)(ws + WS_WOUT), 1024, scr, kb * 64, nb * 32, nb * 32 + (lane & 31), lane); continue; } r -= I_OUT;
        if (r < I_KV) { const int kb = r >> 4, nb = r & 15;
            transpose_item8(F.in[12], 512, (unsigned char*)(ws + WS_WKV), 1024, scr, kb * 64, nb * 32, nb * 32 + (lane & 31), lane); continue; } r -= I_KV;
        { const int kb = r >> 3, nb = r & 7;
            transpose_item(F.in[3], 2632, (bf16_t*)(ws + WS_WU), 1024, scr, kb * 64, nb * 32, 2120 + nb * 32 + (lane & 31), lane); }
    }
    for (int m = gw; m < NTOK; m += NGW) rms_row_to_fp8(F.in[0] + (size_t)m * 1024, F.in[2], (unsigned char*)(ws + WS_XN) + (size_t)m * 1024, lane, (bf16_t*)(ws + WS_XNB) + (size_t)m * 1024);
    for (int m = gw; m < NB * 256; m += NGW) rms_row_to_fp8(F.in[1] + (size_t)m * 1024, F.in[11], (unsigned char*)(ws + WS_MEMN) + (size_t)m * 1024, lane);
    const int gt = gw * 64 + lane, NGT = NGW * 64;
    for (int i = gt; i < SEQ * 8; i += NGT) { const int pos = i >> 3, j = i & 7; const float inv = powf(500000.0f, -(float)j / 8.0f); const float ang = (float)pos * inv; float s, c; sincosf(ang, &s, &c);
        ((f32x2*)(ws + WS_ROPE))[i] = (f32x2){c, s}; }
    for (int i = gt; i < 4 * 64 * 64; i += NGT) { const int g = i >> 12, d = (i >> 6) & 63, c = i & 63;
        ((bf16_t*)(ws + WS_WGT))[i] = (bf16_t)(cvt_pk_bf16(F.in[9][(g * 64 + c) * 64 + d], 0.f) & 0xffffu); }
    for (int i = gt; i < 32 * 1024; i += NGT) { const int e = i >> 10, k = i & 1023; const float w = F.in[14][k] * F.in[15][k * 32 + e];
        const unsigned hb = cvt_pk_bf16(w, 0.f) & 0xffffu; const float lo = w - bf2f((unsigned short)hb);
        ((bf16_t*)(ws + WS_WRH))[i] = (bf16_t)hb; ((bf16_t*)(ws + WS_WRL))[i] = (bf16_t)(cvt_pk_bf16(lo, 0.f) & 0xffffu); }
}

__device__ __forceinline__ void p1_memkv(Frame& F) {
    const unsigned char* MEMN = (const unsigned char*)(F.ws + WS_MEMN); const unsigned char* WKV = (const unsigned char*)(F.ws + WS_WKV);
    bf16_t* KM = (bf16_t*)(F.ws + WS_KM); bf16_t* VMT = (bf16_t*)(F.ws + WS_VMT);
    const int lane = F.lane, fr = lane & 15, fq = lane >> 4;
    for (int tw = F.vcu * NWAVES + F.wave; tw < 64 * 32; tw += F.G * NWAVES) {
        const int mr = tw >> 5, nc = tw & 31;
        const unsigned char* ap = MEMN + (size_t)(16 * mr + fr) * 1024 + 32 * fq; const unsigned char* bp = WKV + (size_t)(16 * nc + fr) * 1024 + 32 * fq;
        pg8::v8i_t av[8], bv[8];
#pragma unroll
        for (int ks = 0; ks < 8; ++ks) { av[ks] = *(const pg8::v8i_t*)(ap + 128 * ks); bv[ks] = *(const pg8::v8i_t*)(bp + 128 * ks); }
        f32x4 acc = (f32x4){0.f, 0.f, 0.f, 0.f};
#pragma unroll
        for (int ks = 0; ks < 8; ++ks) acc = __builtin_amdgcn_mfma_scale_f32_16x16x128_f8f6f4(bv[ks], av[ks], acc, 0, 0, 0, 0, 0, 0);
        const int row = 16 * mr + fr, col = 16 * nc + 4 * fq; const float sc = 1.f / 64.f;
        if (col < 256) { u32x2 w; w.x = cvt_pk_bf16(acc[0] * sc, acc[1] * sc); w.y = cvt_pk_bf16(acc[2] * sc, acc[3] * sc); *(u32x2*)(KM + (size_t)row * 256 + col) = w; }
        else { const int b = row >> 8, key = row & 255;
#pragma unroll
            for (int i = 0; i < 4; ++i) { const int c = col - 256 + i, hm = c >> 6, d = c & 63; VMT[((size_t)(b * 4 + hm) * 64 + d) * 256 + key] = (bf16_t)(cvt_pk_bf16(acc[i] * sc, 0.f) & 0xffffu); } }
    }
}

constexpr int SCS = 4128;
constexpr int SEL_MW_OFF = 16 * SCS * 2;
__device__ __forceinline__ float relu_i(float x) { const int b = __builtin_bit_cast(int, x); return __builtin_bit_cast(float, b > 0 ? b : 0); }
__device__ __forceinline__ unsigned sortable16(unsigned h) { return (h & 0x8000u) ? (~h & 0xffffu) : (h | 0x8000u); }
#define SEQ64(M) M(0) M(1) M(2) M(3) M(4) M(5) M(6) M(7) M(8) M(9) M(10) M(11) M(12) M(13) M(14) M(15) M(16) M(17) M(18) M(19) M(20) M(21) M(22) M(23) M(24) M(25) M(26) M(27) M(28) M(29) M(30) M(31) M(32) M(33) M(34) M(35) M(36) M(37) M(38) M(39) M(40) M(41) M(42) M(43) M(44) M(45) M(46) M(47) M(48) M(49) M(50) M(51) M(52) M(53) M(54) M(55) M(56) M(57) M(58) M(59) M(60) M(61) M(62) M(63)
#define SEQ32(M) M(0) M(1) M(2) M(3) M(4) M(5) M(6) M(7) M(8) M(9) M(10) M(11) M(12) M(13) M(14) M(15) M(16) M(17) M(18) M(19) M(20) M(21) M(22) M(23) M(24) M(25) M(26) M(27) M(28) M(29) M(30) M(31)
#define WLANE(dst, val, L) asm("s_nop 1\n\tv_writelane_b32 %0, %1, " #L : "+v"(dst) : "s"(val))
#define SEL_CNT8(cnt, cand, K, o) asm volatile( \
    "s_nop 1\n\tv_cmp_ge_u32_e64 s[36:37], %1, %9\n\tv_cmp_ge_u32_e64 s[38:39], %2, %9\n\tv_cmp_ge_u32_e64 s[40:41], %3, %9\n\tv_cmp_ge_u32_e64 s[42:43], %4, %9\n\t" \
    "v_cmp_ge_u32_e64 s[44:45], %5, %9\n\tv_cmp_ge_u32_e64 s[46:47], %6, %9\n\tv_cmp_ge_u32_e64 s[48:49], %7, %9\n\tv_cmp_ge_u32_e64 s[50:51], %8, %9\n\t" \
    "s_bcnt1_i32_b64 s36, s[36:37]\n\ts_bcnt1_i32_b64 s38, s[38:39]\n\ts_bcnt1_i32_b64 s40, s[40:41]\n\ts_bcnt1_i32_b64 s42, s[42:43]\n\t" \
    "s_bcnt1_i32_b64 s44, s[44:45]\n\ts_bcnt1_i32_b64 s46, s[46:47]\n\ts_bcnt1_i32_b64 s48, s[48:49]\n\ts_bcnt1_i32_b64 s50, s[50:51]\n\t" \
    "s_add_i32 s36, s36, s38\n\ts_add_i32 s40, s40, s42\n\ts_add_i32 s44, s44, s46\n\ts_add_i32 s48, s48, s50\n\t" \
    "s_add_i32 s36, s36, s40\n\ts_add_i32 s44, s44, s48\n\ts_add_i32 s36, s36, s44\n\ts_add_i32 %0, %0, s36" \
    : "+s"(cnt) : "v"(K[o]), "v"(K[o + 1]), "v"(K[o + 2]), "v"(K[o + 3]), "v"(K[o + 4]), "v"(K[o + 5]), "v"(K[o + 6]), "v"(K[o + 7]), "s"(cand) \
    : "s36", "s37", "s38", "s39", "s40", "s41", "s42", "s43", "s44", "s45", "s46", "s47", "s48", "s49", "s50", "s51", "scc")
template <bool CONV = true> __device__ __forceinline__ void p2_select(Frame& F) {
    LAS unsigned short* SC = (LAS unsigned short*)F.lds;
    LAS unsigned long long* MW = (LAS unsigned long long*)(F.lds + SEL_MW_OFF);
    const unsigned short* IQ = (const unsigned short*)(F.ws + WS_IQ); const unsigned short* IK = (const unsigned short*)(F.ws + WS_IK); const float* IW = (const float*)(F.ws + WS_IW);
    unsigned long long* MT = (unsigned long long*)(F.ws + WS_MASKT);
    const int wave = F.wave;
    const int cgw = F.vcu * NWAVES + F.wave, cNGW = F.G * NWAVES; int convq = 0;
#ifdef DBG_SELT
    unsigned tacc = 0, tlast = (unsigned)__builtin_amdgcn_s_memrealtime();
#define tacc0 0
#define tacc1 1
#define tacc2 2
#define SEL_T(x) do { const unsigned n_ = (unsigned)__builtin_amdgcn_s_memrealtime(); if ((x) == DBG_SELT) tacc += n_ - tlast; tlast = n_; } while (0)
#else
#define SEL_T(x) do {} while (0)
#endif
    for (int item = F.vcu; item < 256; item += F.G) {
    const int b = item >> 6, jj = item & 63;
    half8 af[4][4]; f32x4 wv[4][4];
    int lane = F.lane; asm volatile("" : "+v"(lane));
    int r = lane & 31, hi = lane >> 5;
    int ql = 2 * ((r >> 2) & 1) + (r >> 4), head = (r & 3) + 4 * ((r >> 3) & 1);
#define SEL_LOAD_AW(T0) do { _Pragma("unroll") for (int rt = 0; rt < 4; ++rt) { const size_t qrow = (size_t)b * SEQ + (T0) + 4 * rt + ql; \
        _Pragma("unroll") for (int kk = 0; kk < 4; ++kk) af[rt][kk] = *(const half8*)(IQ + qrow * 512 + head * 64 + 16 * kk + 8 * hi); } } while (0)
#define SEL_LOAD_W(T0) do { _Pragma("unroll") for (int rt = 0; rt < 4; ++rt) { const float* wp = IW + ((size_t)b * SEQ + (T0) + 4 * rt + 2 * hi) * 8; \
        _Pragma("unroll") for (int i = 0; i < 4; ++i) wv[rt][i] = *(const f32x4*)(wp + 4 * i); } } while (0)
    SEL_LOAD_AW(jj * 32);
    for (int step = 0; step < 4; ++step) {
        const int half = step >> 1, grp = step & 1;
        const int sg = half ? 127 - jj : jj;
        const int t0 = sg * 32 + grp * 16;
        const int KT = (t0 + 16 + 31) >> 5;
        const int KT4 = (KT + 3) & ~3, RV = KT4 >> 2;
        {
            asm volatile("" : "+v"(lane)); r = lane & 31; hi = lane >> 5; ql = 2 * ((r >> 2) & 1) + (r >> 4); head = (r & 3) + 4 * ((r >> 3) & 1);
            const unsigned short* kbase = IK + ((size_t)b * SEQ + r) * 64 + 8 * hi;
#define SEL_LOAD_B(dst, tile) do { const int tl_ = (tile) < 128 ? (tile) : 127; const unsigned short* kp_ = kbase + (size_t)tl_ * 32 * 64; \
        _Pragma("unroll") for (int kk = 0; kk < 4; ++kk) dst[kk] = *(const half8*)(kp_ + 16 * kk); } while (0)
#ifndef SEL_SCHED_BAR
#define SEL_SCHED_BAR do { if (rt & 1) __builtin_amdgcn_sched_barrier(0); } while (0)
#endif
#define SEL_TILE(bf_, tile) do { const int tl_ = (tile); const int key_ = 32 * tl_ + r; \
        const int pos_ = (tl_ >> 2) * 128 + (((tl_ & 1) * 32 + r) << 1) + ((tl_ >> 1) & 1);        \
        const bool diag_ = tl_ >= KT - 1;                                                            \
        _Pragma("unroll") for (int rt = 0; rt < 4; ++rt) { f32x16 acc = f32x16{}; \
            _Pragma("unroll") for (int kk = 0; kk < 4; ++kk) acc = __builtin_amdgcn_mfma_f32_32x32x16_f16(af[rt][kk], bf_[kk], acc, 0, 0, 0); \
            float s0 = 0.f, s1 = 0.f; \
            _Pragma("unroll") for (int g = 0; g < 8; ++g) { s0 += wv[rt][g >> 2][g & 3] * relu_i(acc[g]); s1 += wv[rt][2 + (g >> 2)][g & 3] * relu_i(acc[8 + g]); } \
            const unsigned pk_ = __builtin_bit_cast(unsigned, __builtin_amdgcn_cvt_pkrtz(s0, s1)); \
            const s16x2_t sg_ = __builtin_bit_cast(s16x2_t, pk_) >> 15; \
            unsigned k2_ = pk_ ^ (__builtin_bit_cast(unsigned, sg_) | 0x80008000u);                    \
            if (diag_) { const int q0_ = t0 + 4 * rt + 2 * hi; k2_ = (key_ <= q0_ ? k2_ & 0xffffu : 0u) | (key_ <= q0_ + 1 ? k2_ & 0xffff0000u : 0u); }     \
            SC[(4 * rt + 2 * hi) * SCS + pos_] = (unsigned short)k2_; SC[(4 * rt + 2 * hi + 1) * SCS + pos_] = (unsigned short)(k2_ >> 16); \
            SEL_SCHED_BAR; } } while (0)
            half8 bA[4], bB[4], bC[4], bD[4];
            SEL_LOAD_W(t0);
            SEL_LOAD_B(bA, wave); SEL_LOAD_B(bB, wave + 8); SEL_LOAD_B(bC, wave + 16); SEL_LOAD_B(bD, wave + 24);
            for (int tile = wave; tile < KT4; tile += 32) {
                SEL_TILE(bA, tile); SEL_LOAD_B(bA, tile + 32);
                if (tile + 8 < KT4) { SEL_TILE(bB, tile + 8); SEL_LOAD_B(bB, tile + 40); }
                if (tile + 16 < KT4) { SEL_TILE(bC, tile + 16); SEL_LOAD_B(bC, tile + 48); }
                if (tile + 24 < KT4) { SEL_TILE(bD, tile + 24); SEL_LOAD_B(bD, tile + 56); }
            }
        }
        if (step < 3) { const int nh = (step + 1) >> 1, ng = (step + 1) & 1; SEL_LOAD_AW((nh ? 127 - jj : jj) * 32 + ng * 16); }
        __syncthreads();
        SEL_T(tacc0);
#pragma nounroll
        for (int qq = 0; qq < 2; ++qq) {
            if (CONV && wave < 4) { conv_expert_items3(F, convq * 3 * cNGW + cgw, cNGW, lane); ++convq; }
            const int qi = wave + 8 * qq, t = t0 + qi;
            unsigned kk[32];
            {   const LAS unsigned* row = (const LAS unsigned*)(SC + qi * SCS) + lane;
#pragma unroll
                for (int blk = 0; blk < 4; ++blk) {
                    if (blk * 8 < RV) {
#pragma unroll
                        for (int i = 0; i < 8; ++i) { const int rr = blk * 8 + i; const unsigned v_ = row[rr * 64]; kk[rr] = rr < RV ? v_ : 0u; }
                    } else {
#pragma unroll
                        for (int i = 0; i < 8; ++i) kk[blk * 8 + i] = 0u;
                    }
                }
            }
            unsigned wlo = 0u, whi = 0u;
            if (t + 1 <= 256) {
                const int rem = t + 1 - lane * 64; const unsigned long long w = rem >= 64 ? ~0ull : (rem <= 0 ? 0ull : ((1ull << rem) - 1ull));
                wlo = (unsigned)w; whi = (unsigned)(w >> 32);
            } else {
                unsigned prefix = 0u; int cntp = 0;
                const int nblk = (RV + 7) >> 3;
                for (int bit = 15; bit >= 0; --bit) {
                    const unsigned cand = (unsigned)__builtin_amdgcn_readfirstlane((int)(prefix | (1u << bit)));
                    const unsigned c2 = cand * 0x10001u, c1 = c2 - 0x10001u;
                    unsigned a1 = 0u, a0 = 0u;
#define SAD8(o) { _Pragma("unroll") for (int i = 0; i < 8; ++i) { a1 = __builtin_amdgcn_sad_u16(kk[(o) + i], c2, a1); a0 = __builtin_amdgcn_sad_u16(kk[(o) + i], c1, a0); } }
                    SAD8(0)
                    if (nblk > 1) SAD8(8)
                    if (nblk > 2) SAD8(16)
                    if (nblk > 3) SAD8(24)
#undef SAD8
                    const int cnt = (nblk * 1024 - wave_sum_i((int)(a1 - a0))) >> 1;
                    if (cnt >= 256) { prefix = cand; cntp = cnt; if (cnt == 256) break; }
                }
                prefix = (unsigned)__builtin_amdgcn_readfirstlane((int)prefix); asm volatile("" : "+s"(prefix));
                int excess = __builtin_amdgcn_readfirstlane(cntp - 256);
                unsigned pv = prefix; asm volatile("" : "+v"(pv));
#define M(rr) { unsigned long long w_; asm volatile("v_cmp_ge_u16_e64 %0, %1, %2" : "=s"(w_) : "v"(kk[rr]), "s"(prefix)); { const unsigned l_ = (unsigned)w_, h_ = (unsigned)(w_ >> 32); WLANE(wlo, l_, 2 * (rr)); WLANE(whi, h_, 2 * (rr)); } \
                asm volatile("v_cmp_ge_u16_sdwa %0, %1, %2 src0_sel:WORD_1 src1_sel:WORD_0" : "=s"(w_) : "v"(kk[rr]), "v"(pv)); { const unsigned l_ = (unsigned)w_, h_ = (unsigned)(w_ >> 32); WLANE(wlo, l_, 2 * (rr) + 1); WLANE(whi, h_, 2 * (rr) + 1); } }
                SEQ32(M)
#undef M
                if (excess > 0) {
#define FIXW(rr, HALF, CMPGE, CMPEQ) if (excess > 0) { unsigned long long eq_; asm volatile(CMPEQ : "=s"(eq_) : "v"(kk[rr]), "s"(prefix), "v"(pv)); \
                        if (eq_ != 0ull) { unsigned long long rem_ = 0ull; while (excess > 0 && eq_ != 0ull) { const unsigned long long hb_ = 1ull << (63 - __builtin_clzll(eq_)); rem_ |= hb_; eq_ ^= hb_; --excess; } \
                            unsigned long long w_; asm volatile(CMPGE : "=s"(w_) : "v"(kk[rr]), "s"(prefix), "v"(pv)); w_ &= ~rem_; const unsigned l_ = (unsigned)w_, h_ = (unsigned)(w_ >> 32); WLANE(wlo, l_, 2 * (rr) + (HALF)); WLANE(whi, h_, 2 * (rr) + (HALF)); } }
#define M(i) { FIXW(31 - (i), 1, "v_cmp_ge_u16_sdwa %0, %1, %3 src0_sel:WORD_1 src1_sel:WORD_0", "v_cmp_eq_u16_sdwa %0, %1, %3 src0_sel:WORD_1 src1_sel:WORD_0") \
               FIXW(31 - (i), 0, "v_cmp_ge_u16_e64 %0, %1, %2", "v_cmp_eq_u16_e64 %0, %1, %2") }
                    SEQ32(M)
#undef M
#undef FIXW
                }
            }
            MW[(grp * 16 + qi) * 64 + lane] = (unsigned long long)wlo | ((unsigned long long)whi << 32);
            if (CONV && wave >= 4) { conv_expert_items3(F, convq * 3 * cNGW + cgw, cNGW, lane); ++convq; }
        }
        __syncthreads();
        SEL_T(tacc1);
        if (grp == 1) {
#ifdef DBG_LAST
            const int NT64 = 64;
#else
            const int NT64 = 4 * (sg >> 3) + 4;
#endif
            for (int T = wave; T < NT64; T += 8) {
                const unsigned long long w = MW[r * 64 + T] >> (4 * hi);
                const unsigned lo = (unsigned)w, hi32 = (unsigned)(w >> 32);
                unsigned olo = 0u, ohi = 0u;
#define M(i) { constexpr int r16_ = (i) & 15, bitc_ = (r16_ & 3) + 8 * (r16_ >> 2); const unsigned src_ = ((i) >> 4) ? hi32 : lo; \
                    const unsigned long long bal_ = __ballot(((src_ >> bitc_) & 1u) != 0u); const unsigned l_ = (unsigned)bal_, h_ = (unsigned)(bal_ >> 32); WLANE(olo, l_, i); WLANE(ohi, h_, i); }
                SEQ32(M)
#undef M
                if (lane < 32) MT[((size_t)(b * 128 + sg) * 64 + T) * 32 + lane] = (unsigned long long)olo | ((unsigned long long)ohi << 32);
            }
            __syncthreads();
            SEL_T(tacc2);
        }
    }
    }
    if (CONV) for (int cid = convq * 3 * cNGW + cgw; cid < NCONV; cid += 3 * cNGW) conv_expert_items3(F, cid, cNGW, F.lane);
#ifdef DBG_SELT
    if (blockIdx.x == 0 && F.tid == 0) { unsigned long long* t = (unsigned long long*)(F.ctl + 16384); t[20] = 0; t[21] = tacc; }
#endif
}

template <int G> __device__ __forceinline__ void p2_pool_unit(Frame& F, int tb) {
    const bf16_t* U = (const bf16_t*)(F.ws + WS_U); const bf16_t* WGT = (const bf16_t*)(F.ws + WS_WGT); bf16_t* YP = (bf16_t*)(F.ws + WS_YCAT) + 512;
    constexpr int w = 2 << G;
    const int lane = F.lane, r = lane & 31, hi = lane >> 5;
    const int tok = tb * 32 + r, t = tok & (SEQ - 1), cnt = (t + 1 < w) ? t + 1 : w;
    const float inv = 1.f / (float)cnt;
    f32x16 acc[2]; acc[0] = f32x16{}; acc[1] = f32x16{};
#pragma unroll
    for (int kk = 0; kk < 4; ++kk) {
        const int c0 = G * 64 + 16 * kk + 8 * hi;
        constexpr int CH = (w < 8) ? w : 8;
        float s[8], own[8];
#pragma unroll
        for (int j = 0; j < 8; ++j) s[j] = 0.f;
#pragma nounroll
        for (int i0 = 0; i0 < w; i0 += CH) {
            u32x4 v[CH];
#pragma unroll
            for (int i = 0; i < CH; ++i) { const int back = (i0 + i < cnt) ? i0 + i : 0; v[i] = *(const u32x4*)(U + (size_t)(tok - back) * 256 + c0); }
#pragma unroll
            for (int i = 0; i < CH; ++i) { const float m = (i0 + i < cnt) ? 1.f : 0.f;
                s[0] += m * bflo(v[i].x); s[1] += m * bfhi(v[i].x); s[2] += m * bflo(v[i].y); s[3] += m * bfhi(v[i].y); s[4] += m * bflo(v[i].z); s[5] += m * bfhi(v[i].z); s[6] += m * bflo(v[i].w); s[7] += m * bfhi(v[i].w); }
            if (i0 == 0) { own[0] = bflo(v[0].x); own[1] = bfhi(v[0].x); own[2] = bflo(v[0].y); own[3] = bfhi(v[0].y); own[4] = bflo(v[0].z); own[5] = bfhi(v[0].z); own[6] = bflo(v[0].w); own[7] = bfhi(v[0].w); }
        }
        u32x4 pb; pb.x = cvt_pk_bf16(s[0] * inv - own[0], s[1] * inv - own[1]); pb.y = cvt_pk_bf16(s[2] * inv - own[2], s[3] * inv - own[3]);
        pb.z = cvt_pk_bf16(s[4] * inv - own[4], s[5] * inv - own[5]); pb.w = cvt_pk_bf16(s[6] * inv - own[6], s[7] * inv - own[7]);
#pragma unroll
        for (int dh = 0; dh < 2; ++dh) { const bf16x8 a = *(const bf16x8*)(WGT + ((size_t)(G * 64 + 32 * dh + r)) * 64 + 16 * kk + 8 * hi);
            acc[dh] = __builtin_amdgcn_mfma_f32_32x32x16_bf16(a, __builtin_bit_cast(bf16x8, pb), acc[dh], 0, 0, 0); }
        __builtin_amdgcn_sched_barrier(0);
    }
    const float* sc = F.in[10];
#pragma unroll
    for (int dh = 0; dh < 2; ++dh)
#pragma unroll
        for (int q4 = 0; q4 < 4; ++q4) { const int d = G * 64 + 32 * dh + 8 * q4 + 4 * hi; const f32x4 s4 = *(const f32x4*)(sc + d);
            u32x2 o; o.x = cvt_pk_bf16(acc[dh][4 * q4] * s4[0], acc[dh][4 * q4 + 1] * s4[1]); o.y = cvt_pk_bf16(acc[dh][4 * q4 + 2] * s4[2], acc[dh][4 * q4 + 3] * s4[3]);
            *(u32x2*)(YP + (size_t)tok * 1024 + d) = o; }
}
constexpr int MEM_KROW = 144, MEM_VROW = 528;
constexpr int MEM_K_OFF = 0, MEM_V_OFF = 256 * MEM_KROW;
__device__ __forceinline__ void p2_mem_item(Frame& F, int item) {
    const bf16_t* QM = (const bf16_t*)(F.ws + WS_QM); const bf16_t* KM = (const bf16_t*)(F.ws + WS_KM); const bf16_t* VMT = (const bf16_t*)(F.ws + WS_VMT); bf16_t* YM = (bf16_t*)(F.ws + WS_YCAT) + 768;
    const int lane = F.lane, wave = F.wave, r = lane & 31, hi = lane >> 5, tid = F.tid;
    const int bhm = item >> 4, b = bhm >> 2, hm = bhm & 3;
    LAS unsigned char* lk = F.lds + MEM_K_OFF; LAS unsigned char* lv = F.lds + MEM_V_OFF;
#pragma unroll
    for (int i = 0; i < 4; ++i) { const int idx = tid + 512 * i, key = idx >> 3, ch = idx & 7;
        *(LAS u32x4*)(lk + key * MEM_KROW + ch * 16) = *(const u32x4*)(KM + (size_t)(b * 256 + key) * 256 + hm * 64 + ch * 8); }
#pragma unroll
    for (int i = 0; i < 4; ++i) { const int idx = tid + 512 * i, d = idx >> 5, ch = idx & 31;
        *(LAS u32x4*)(lv + d * MEM_VROW + ch * 16) = *(const u32x4*)(VMT + ((size_t)(b * 4 + hm) * 64 + d) * 256 + ch * 8); }
    __syncthreads();
    const int tok = b * SEQ + (item & 15) * 256 + wave * 32 + r;
    bf16x8 qf[4];
#pragma unroll
    for (int kk = 0; kk < 4; ++kk) qf[kk] = *(const bf16x8*)(QM + (size_t)tok * 256 + hm * 64 + 16 * kk + 8 * hi);
    f32x16 sc[8];
#pragma unroll
    for (int kb = 0; kb < 8; ++kb) { sc[kb] = f32x16{};
#pragma unroll
        for (int kk = 0; kk < 4; ++kk) { const bf16x8 a = *(const LAS bf16x8*)(lk + (kb * 32 + r) * MEM_KROW + (16 * kk + 8 * hi) * 2);
            sc[kb] = __builtin_amdgcn_mfma_f32_32x32x16_bf16(a, qf[kk], sc[kb], 0, 0, 0); } }
    float mx = -INFINITY;
#pragma unroll
    for (int kb = 0; kb < 8; ++kb)
#pragma unroll
        for (int i = 0; i < 16; ++i) mx = fmaxf(mx, sc[kb][i]);
    mx = fmaxf(mx, __shfl_xor(mx, 32));
    float l = 0.f;
#pragma unroll
    for (int kb = 0; kb < 8; ++kb)
#pragma unroll
        for (int i = 0; i < 16; ++i) { const float p = __builtin_amdgcn_exp2f(sc[kb][i] - mx); sc[kb][i] = p; l += p; }
    l += __shfl_xor(l, 32);
    f32x16 o[2]; o[0] = f32x16{}; o[1] = f32x16{};
#pragma unroll
    for (int kb = 0; kb < 8; ++kb)
#pragma unroll
        for (int s = 0; s < 2; ++s) {
            u32x4 pw; pw.x = cvt_pk_bf16(sc[kb][8 * s], sc[kb][8 * s + 1]); pw.y = cvt_pk_bf16(sc[kb][8 * s + 2], sc[kb][8 * s + 3]); pw.z = cvt_pk_bf16(sc[kb][8 * s + 4], sc[kb][8 * s + 5]); pw.w = cvt_pk_bf16(sc[kb][8 * s + 6], sc[kb][8 * s + 7]);
#pragma unroll
            for (int dh = 0; dh < 2; ++dh) {
                const LAS unsigned char* vp = lv + (32 * dh + r) * MEM_VROW + (32 * kb + 16 * s + 4 * hi) * 2;
                const u32x2 a0 = *(const LAS u32x2*)vp, a1 = *(const LAS u32x2*)(vp + 16);
                const u32x4 av = (u32x4){a0.x, a0.y, a1.x, a1.y};
                o[dh] = __builtin_amdgcn_mfma_f32_32x32x16_bf16(__builtin_bit_cast(bf16x8, av), __builtin_bit_cast(bf16x8, pw), o[dh], 0, 0, 0); }
            __builtin_amdgcn_sched_barrier(0);
        }
    const float il = 1.f / l;
#pragma unroll
    for (int dh = 0; dh < 2; ++dh)
#pragma unroll
        for (int q4 = 0; q4 < 4; ++q4) { const int d = hm * 64 + 32 * dh + 8 * q4 + 4 * hi;
            u32x2 ov; ov.x = cvt_pk_bf16(o[dh][4 * q4] * il, o[dh][4 * q4 + 1] * il); ov.y = cvt_pk_bf16(o[dh][4 * q4 + 2] * il, o[dh][4 * q4 + 3] * il);
            *(u32x2*)(YM + (size_t)tok * 1024 + d) = ov; }
    __syncthreads();
}
__device__ __forceinline__ void p6_router(Frame& F) {
    const float* H1 = F.out; const bf16_t* WRH = (const bf16_t*)(F.ws + WS_WRH); const bf16_t* WRL = (const bf16_t*)(F.ws + WS_WRL);
    int* RE = (int*)(F.ws + WS_RE); int* RR = (int*)(F.ws + WS_RR); float* RG = (float*)(F.ws + WS_RG); float* RSTD = (float*)(F.ws + WS_RSTD);
    LAS float* RED = (LAS float*)F.lds;
    LAS float* SSQ = (LAS float*)(F.lds + 2 * 4 * 32 * 33 * 4);
    volatile LAS unsigned* LCNT = (volatile LAS unsigned*)(F.lds + 2 * 4 * 32 * 33 * 4 + 2 * 4 * 64 * 4);
    const int lane = F.lane, wave = F.wave, r = lane & 31, hi = lane >> 5, tblk = wave >> 2, kq = wave & 3;
    for (int item = F.vcu; item < NTOK / 64; item += F.G) {
        const int tok = item * 64 + tblk * 32 + r;
        f32x16 acc = f32x16{}; float ssq = 0.f;
        const float* hp = H1 + (size_t)tok * 1024 + 256 * kq + 8 * hi;
        const bf16_t* ah = WRH + (size_t)r * 1024 + 256 * kq + 8 * hi; const bf16_t* al = WRL + (size_t)r * 1024 + 256 * kq + 8 * hi;
#pragma unroll 8
        for (int ks = 0; ks < 16; ++ks) {
            const f32x4 x0 = *(const f32x4*)(hp + 16 * ks), x1 = *(const f32x4*)(hp + 16 * ks + 4);
            ssq += (x0[0] * x0[0] + x0[1] * x0[1]) + (x0[2] * x0[2] + x0[3] * x0[3]) + (x1[0] * x1[0] + x1[1] * x1[1]) + (x1[2] * x1[2] + x1[3] * x1[3]);
            u32x4 bh; bh.x = cvt_pk_bf16_s(x0[0], x0[1]); bh.y = cvt_pk_bf16_s(x0[2], x0[3]); bh.z = cvt_pk_bf16_s(x1[0], x1[1]); bh.w = cvt_pk_bf16_s(x1[2], x1[3]);
            u32x4 bl; bl.x = cvt_pk_bf16_s(x0[0] - bflo(bh.x), x0[1] - bfhi(bh.x)); bl.y = cvt_pk_bf16_s(x0[2] - bflo(bh.y), x0[3] - bfhi(bh.y));
            bl.z = cvt_pk_bf16_s(x1[0] - bflo(bh.z), x1[1] - bfhi(bh.z)); bl.w = cvt_pk_bf16_s(x1[2] - bflo(bh.w), x1[3] - bfhi(bh.w));
            const bf16x8 Ah = *(const bf16x8*)(ah + 16 * ks), Al = *(const bf16x8*)(al + 16 * ks);
            acc = __builtin_amdgcn_mfma_f32_32x32x16_bf16(Ah, __builtin_bit_cast(bf16x8, bh), acc, 0, 0, 0);
            acc = __builtin_amdgcn_mfma_f32_32x32x16_bf16(Ah, __builtin_bit_cast(bf16x8, bl), acc, 0, 0, 0);
            acc = __builtin_amdgcn_mfma_f32_32x32x16_bf16(Al, __builtin_bit_cast(bf16x8, bh), acc, 0, 0, 0);
        }
#pragma unroll
        for (int g = 0; g < 16; ++g) RED[((tblk * 4 + kq) * 32 + attn_body::crow(g, hi)) * 33 + r] = acc[g];
        SSQ[(tblk * 4 + kq) * 64 + lane] = ssq;
        __syncthreads();
        if (F.tid < 64) {
            const int tb2 = F.tid >> 5, rr = F.tid & 31, tk = item * 64 + F.tid;
            float sq = 0.f;
#pragma unroll
            for (int q = 0; q < 4; ++q) sq += SSQ[(tb2 * 4 + q) * 64 + rr] + SSQ[(tb2 * 4 + q) * 64 + 32 + rr];
            const float rstd = 1.f / sqrtf(sq * (1.f / 1024.f) + EPS);
            float lg[32];
#pragma unroll
            for (int e = 0; e < 32; ++e) { float s = 0.f;
#pragma unroll
                for (int q = 0; q < 4; ++q) s += RED[((tb2 * 4 + q) * 32 + e) * 33 + rr];
                lg[e] = s * rstd + F.in[16][e]; }
            float tv[4]; int ti[4];
#pragma unroll
            for (int p = 0; p < 4; ++p) { float best = -INFINITY; int bi = 0;
#pragma unroll
                for (int e = 0; e < 32; ++e) if (lg[e] > best) { best = lg[e]; bi = e; }
                tv[p] = best; ti[p] = bi;
#pragma unroll
                for (int e = 0; e < 32; ++e) lg[e] = (e == bi) ? -INFINITY : lg[e]; }
            float ex[4], den = 0.f;
#pragma unroll
            for (int p = 0; p < 4; ++p) { ex[p] = __expf(tv[p] - tv[0]); den += ex[p]; }
            const float id = 1.f / den;
#pragma unroll
            for (int p = 0; p < 4; ++p) { RE[tk * 4 + p] = ti[p]; RG[tk * 4 + p] = ex[p] * id; }
            if (F.tid < 32) LCNT[F.tid] = 0u;
            int rk[4];
#pragma unroll
            for (int p = 0; p < 4; ++p) rk[p] = (int)__hip_atomic_fetch_add((LAS unsigned*)&LCNT[ti[p]], 1u, __ATOMIC_RELAXED, __HIP_MEMORY_SCOPE_WORKGROUP);
            if (F.tid < 32) { const unsigned c = LCNT[F.tid]; LCNT[32 + F.tid] = c ? __hip_atomic_fetch_add(F.ctl + CW_CNT + 64 * F.tid, c, __ATOMIC_RELAXED, __HIP_MEMORY_SCOPE_AGENT) : 0u; }
#pragma unroll
            for (int p = 0; p < 4; ++p) RR[tk * 4 + p] = rk[p] + (int)LCNT[32 + ti[p]];
            RSTD[tk] = rstd;
        }
        __syncthreads();
    }
}
__device__ __forceinline__ int moe_row_offset(Frame& F) {
    const int lane = F.lane; const unsigned c = (lane < 32) ? __hip_atomic_load(F.ctl + CW_CNT + 64 * lane, __ATOMIC_RELAXED, __HIP_MEMORY_SCOPE_AGENT) : 0u;
    const int pad = (int)((c + 255u) & ~255u); int inc = pad;
#pragma unroll
    for (int o = 1; o < 32; o <<= 1) { const int v = __shfl_up(inc, o); if ((lane & 31) >= o) inc += v; }
    return inc - pad;
}
__device__ __forceinline__ void p7_scatter(Frame& F) {
    const float* H1 = F.out; const int* RE = (const int*)(F.ws + WS_RE); const int* RR = (const int*)(F.ws + WS_RR); const float* RSTD = (const float*)(F.ws + WS_RSTD);
    int* SLOT = (int*)(F.ws + WS_SLOT); unsigned char* XG = (unsigned char*)(F.ws + WS_XG);
    const int lane = F.lane, gw = F.vcu * NWAVES + F.wave, NGW = F.G * NWAVES;
    const int off = moe_row_offset(F);
    const f32x4* gr = (const f32x4*)F.in[14] + lane;
    f32x4 gg[4];
#pragma unroll
    for (int j = 0; j < 4; ++j) gg[j] = gr[64 * j];
    for (int tok = gw; tok < NTOK; tok += NGW) {
        const float rstd = RSTD[tok];
        const f32x4* xr = (const f32x4*)(H1 + (size_t)tok * 1024) + lane;
        unsigned w[4];
#pragma unroll
        for (int j = 0; j < 4; ++j) { const f32x4 v = xr[64 * j]; w[j] = cvt_pk_fp8x4(v.x * rstd * gg[j].x, v.y * rstd * gg[j].y, v.z * rstd * gg[j].z, v.w * rstd * gg[j].w); }
#pragma unroll
        for (int p = 0; p < 4; ++p) { const int e = RE[tok * 4 + p], rk = RR[tok * 4 + p]; const int slot = __shfl(off, e) + rk;
            unsigned* o4 = (unsigned*)(XG + (size_t)slot * 1024) + lane;
#pragma unroll
            for (int j = 0; j < 4; ++j) o4[64 * j] = w[j];
            if (lane == 0) SLOT[tok * 4 + p] = slot; }
    }
}
__device__ __forceinline__ void moe_tile_table(Frame& F) {
    if (F.wave == 0) { const int off = moe_row_offset(F); const unsigned c = (F.lane < 32) ? __hip_atomic_load(F.ctl + CW_CNT + 64 * F.lane, __ATOMIC_RELAXED, __HIP_MEMORY_SCOPE_AGENT) : 0u;
        if (F.lane < 32) F.MISC[32 + F.lane] = (unsigned)(off >> 8);
        if (F.lane == 31) F.MISC[64] = (unsigned)((off >> 8) + (int)((c + 255u) >> 8)); }
    __syncthreads();
}
__device__ __forceinline__ void p10_final(Frame& F) {
    float* H1 = F.out; const int* SLOT = (const int*)(F.ws + WS_SLOT); const float* RG = (const float*)(F.ws + WS_RG); const unsigned char* Y = (const unsigned char*)(F.ws + WS_XG);
    const int lane = F.lane, gw = F.vcu * NWAVES + F.wave, NGW = F.G * NWAVES;
    const f32x4* gr = (const f32x4*)F.in[21] + lane;
    f32x4 gg[4];
#pragma unroll
    for (int j = 0; j < 4; ++j) gg[j] = gr[64 * j];
    for (int tok = gw; tok < NTOK; tok += NGW) {
        f32x4* xr = (f32x4*)(H1 + (size_t)tok * 1024) + lane;
        f32x4 v[4];
#pragma unroll
        for (int j = 0; j < 4; ++j) v[j] = xr[64 * j];
#pragma unroll
        for (int p = 0; p < 4; ++p) { const int slot = SLOT[tok * 4 + p]; const float gate = RG[tok * 4 + p] * 0.125f;
            const unsigned* yr = (const unsigned*)(Y + (size_t)slot * 1024) + lane;
#pragma unroll
            for (int j = 0; j < 4; ++j) { const unsigned y = yr[64 * j]; const f32x2 lo = __builtin_amdgcn_cvt_pk_f32_fp8((int)y, false), hi = __builtin_amdgcn_cvt_pk_f32_fp8((int)y, true);
                v[j].x += gate * lo[0]; v[j].y += gate * lo[1]; v[j].z += gate * hi[0]; v[j].w += gate * hi[1]; } }
        float s = 0.f;
#pragma unroll
        for (int j = 0; j < 4; ++j) s += (v[j].x * v[j].x + v[j].y * v[j].y) + (v[j].z * v[j].z + v[j].w * v[j].w);
        const float rstd = 1.f / sqrtf(wave_sum(s) * (1.f / 1024.f) + EPS);
#pragma unroll
        for (int j = 0; j < 4; ++j) xr[64 * j] = (f32x4){v[j].x * rstd * gg[j].x, v[j].y * rstd * gg[j].y, v[j].z * rstd * gg[j].z, v[j].w * rstd * gg[j].w};
    }
#ifdef DBG_STAMP
    if (gw == 0 && lane == 0) { const unsigned long long* t = (const unsigned long long*)(F.ctl + 16384); H1[0] = floorf((float)(t[DBG_STAMP_HI] - t[DBG_STAMP_LO]) * 0.01f / DBG_STAMP_Q) * DBG_STAMP_Q; }
#endif
}

#ifndef MK_N_LAUNCHES
#define MK_N_LAUNCHES 1
#endif
constexpr int N_PHASES = 11;
constexpr int N_LAUNCHES = MK_N_LAUNCHES;
struct Args { const float* in[22]; float* out; unsigned char* ws; int ph_lo, ph_hi, li, pad; };
__global__ void __launch_bounds__(NWAVES * 64, 2) fwd_kernel(Args args) {
    extern __shared__ __attribute__((aligned(16))) unsigned char lds[];
    Frame F;
    F.lds = (LAS unsigned char*)lds; F.MISC = (volatile LAS unsigned*)(F.lds + MISC_OFF);
    F.tid = threadIdx.x; F.lane = F.tid & 63; F.wave = __builtin_amdgcn_readfirstlane(F.tid >> 6);
    F.G = gridDim.x; { const int bx = blockIdx.x; F.vcu = (F.G % 8 == 0) ? (bx % 8) * (F.G / 8) + bx / 8 : bx; }
    F.ws = args.ws; F.ctl = (unsigned*)(args.ws + WS_CTL); F.out = args.out;
    F.in = (const float* const __attribute__((address_space(4)))*)__builtin_amdgcn_kernarg_segment_ptr();
    static_assert(__builtin_offsetof(Args, in) == 0, "Frame::in reads the input pointers at the start of the kernarg segment");
    unsigned char* ws = args.ws;
#define WS_FRESH() do { ws = args.ws; asm volatile("" : "+s"(ws)); F.ws = ws; } while (0)
    for (int u = F.tid; u < 256; u += NWAVES * 64) F.MISC[u] = 0u;
    __syncthreads();
    XcdBarrier bar; bar.bar = F.ctl + CW_BAR; bar.x = 0; bar.st = nullptr;
    if (N_LAUNCHES == 1) bar = xcd_barrier_post(F.ctl + CW_BAR, F.MISC + 8, F.tid == 0);
#define GRID_BAR() do { if (N_LAUNCHES == 1) xcd_barrier(bar, F.wave == 0 && lane_id() == 0); } while (0)
    const int lo = args.ph_lo, hi = args.ph_hi;
#ifndef PH_MASK
#define PH_MASK 0x7ff
#endif
#ifdef DBG_LAST
#define IN(k) ((k) <= DBG_LAST && (((PH_MASK) >> (k)) & 1) && lo <= (k) && (k) < hi)
#else
#define IN(k) ((((PH_MASK) >> (k)) & 1) && lo <= (k) && (k) < hi)
#endif
#define BOTH(k) (IN(k) && IN((k) + 1))

#define IN_FRESH() do { F.in = (const float* const __attribute__((address_space(4)))*)__builtin_amdgcn_kernarg_segment_ptr(); asm volatile("" : "+s"(F.in)); } while (0)
#define REFRESH_F() do { int l_ = lane_id(); asm volatile("" : "+v"(l_)); F.lane = l_; F.tid = F.wave * 64 + l_; } while (0)
#ifdef DBG_PHSTAMP
#define STAMP(k) do { if (blockIdx.x == 0 && F.tid == 0) ((unsigned long long*)(F.ctl + 16384))[k] = __builtin_amdgcn_s_memrealtime(); } while (0)
#else
#define STAMP(k) do {} while (0)
#endif
    STAMP(0);
    if (IN(0)) { IN_FRESH(); REFRESH_F(); p0_prologue(F); if (BOTH(0)) GRID_BAR(); }
    STAMP(1);

    if (IN(1)) { IN_FRESH();
        Sched1 S{(const char*)(ws + WS_XN), (const char*)(ws + WS_W1T), (const char*)(ws + WS_MEMN), (const char*)(ws + WS_WKV), F.G, (int)blockIdx.x};
        EpiP1 E{(bf16_t*)(ws + WS_Q), (bf16_t*)(ws + WS_K), (bf16_t*)(ws + WS_V), (bf16_t*)(ws + WS_U), (bf16_t*)(ws + WS_QM), (bf16_t*)(ws + WS_G), (bf16_t*)(ws + WS_KM), (bf16_t*)(ws + WS_VMT),
                (unsigned short*)(ws + WS_IQ), (unsigned short*)(ws + WS_IK), (float*)(ws + WS_IW), F.in[5], (const float*)(ws + WS_ROPE), 1.f / 64.f};
        { SchedU SU{(const char*)(ws + WS_XNB), (const char*)(ws + WS_WU), F.G, (int)blockIdx.x}; EpiP1 EU = E; EU.accscale = 1.f;
          pg8::gemm_phase<EpiP1, SchedU, K_ALIGN, K_SP2>(F.wave, F.lds, 1024, SU, EU); }
        pg8::gemm_phase<EpiP1, Sched1, K_ALIGN, K_SP2, pg8::NoHook, 1>(F.wave, F.lds, 1024, S, E);
        REFRESH_F(); p1_memkv(F);
        if (BOTH(1)) GRID_BAR();
    }

    STAMP(2);
    if (IN(2)) { IN_FRESH();
        F.lane = lane_id(); F.tid = F.wave * 64 + F.lane;
        p2_select(F);
        REFRESH_F();
        STAMP(12);
        if (BOTH(2)) GRID_BAR();
    }

    STAMP(3);
    if (IN(3)) { IN_FRESH();
        for (int v = F.vcu; v < 256; v += F.G) {
            const int bh = v >> 3, s = v & 7;
#pragma unroll 1
            for (int i = 0; i < 2; ++i) attn_body::attn_unit<8>(F.wave, bh >> 3, bh & 7, i == 0 ? s : 15 - s, (const attn_body::bf16*)(ws + WS_Q), (const attn_body::bf16*)(ws + WS_K), (const attn_body::bf16*)(ws + WS_V),
                                                                 (attn_body::bf16*)(ws + WS_YCAT), (const unsigned long long*)(ws + WS_MASKT), (char*)lds);
        }
        __syncthreads(); REFRESH_F();
        const int gw = F.vcu * NWAVES + F.wave, NGW = F.G * NWAVES;
#ifndef NO_POOL
        for (int u = gw; u < 2048; u += NGW) { const int tb = u >> 2; switch (u & 3) { case 0: p2_pool_unit<0>(F, tb); break; case 1: p2_pool_unit<1>(F, tb); break; case 2: p2_pool_unit<2>(F, tb); break; default: p2_pool_unit<3>(F, tb); break; } }
#endif
#ifndef NO_MEM
        for (int it = F.vcu; it < 256; it += F.G) p2_mem_item(F, it);
#endif
        if (BOTH(3)) GRID_BAR();
    }

    STAMP(4);
    if (IN(4)) { IN_FRESH();
        SchedSimple S{(const char*)(ws + WS_YCAT), (const char*)(ws + WS_WCAT), 64, 4, F.G, (int)blockIdx.x, (size_t)256 * 1024 * 2};
        EpiGate<0> E{(const bf16_t*)(ws + WS_G), nullptr, (bf16_t*)(ws + WS_MERGED), 2}; GateRatioHook H{(const bf16_t*)(ws + WS_G)};
        pg8::gemm_phase<EpiGate<0>, SchedSimple, K_ALIGN, K_SP2, GateRatioHook>(F.wave, F.lds, 1024, S, E, 0, H);
        if (BOTH(4)) GRID_BAR();
    }
    STAMP(5);
    if (IN(5)) { IN_FRESH();
        SchedSimple S{(const char*)(ws + WS_MERGED), (const char*)(ws + WS_WOUT), 64, 4, F.G, (int)blockIdx.x, (size_t)256 * 1024 * 2};
        EpiRes E{F.in[0], F.out}; pg8::gemm_phase<EpiRes, SchedSimple, K_ALIGN, K_SP2>(F.wave, F.lds, 1024, S, E);
        if (BOTH(5)) GRID_BAR();
    }

    STAMP(6);
    if (IN(6)) { IN_FRESH(); REFRESH_F(); p6_router(F); if (BOTH(6)) GRID_BAR(); }
    STAMP(7);
    if (IN(7)) { IN_FRESH(); REFRESH_F(); p7_scatter(F); if (BOTH(7)) GRID_BAR(); }

    STAMP(8);
    if (IN(8)) { IN_FRESH();
        REFRESH_F();
        if (F.wave == 0) { const int l = lane_id(); const unsigned c = (l < 16) ? xb_ld(&bar.bar[XB_XCNT(l)]) : 0u;
            const unsigned long long nz = __ballot(c > 0u), okm = __ballot(l >= 16 || c == 0u || c == (unsigned)(F.G >> 3));
            const bool nice = (N_LAUNCHES == 1) && BOTH(8) && ((F.G & 63) == 0) && (__builtin_popcountll(nz) == 8) && (okm == ~0ull);
            if (l == 0) { F.MISC[12] = nice ? 1u : 0u; F.MISC[13] = (unsigned)__builtin_popcountll(nz & ((1ull << bar.x) - 1ull)); } }
        moe_tile_table(F);
        const bool merged = __builtin_amdgcn_readfirstlane((int)F.MISC[12]) != 0; const int hx = merged ? __builtin_amdgcn_readfirstlane((int)F.MISC[13]) : -1, hs = __builtin_amdgcn_readfirstlane((int)F.MISC[10]);
        SchedMoe S{(const char*)(ws + WS_XG), (const char*)(ws + WS_WUP), (const volatile LAS int*)(F.MISC + 32), 8, F.G, (int)blockIdx.x, 1024, hx, hs};
        EpiSwiglu E{F.in[18], (unsigned char*)(ws + WS_ACT), merged ? F.ctl + CW_UPDONE : nullptr}; pg8::gemm_phase<EpiSwiglu, SchedMoe, K_ALIGN, K_SP2, pg8::NoHook, 1>(F.wave, F.lds, 1024, S, E);
        if (BOTH(8) && !merged) GRID_BAR();
    }
    STAMP(9);
    if (IN(9)) { IN_FRESH();
        REFRESH_F(); moe_tile_table(F);
        const bool merged = BOTH(8) && __builtin_amdgcn_readfirstlane((int)F.MISC[12]) != 0; const int hx = merged ? __builtin_amdgcn_readfirstlane((int)F.MISC[13]) : -1, hs = __builtin_amdgcn_readfirstlane((int)F.MISC[10]);
        SchedMoe S{(const char*)(ws + WS_ACT), (const char*)(ws + WS_WDN), (const volatile LAS int*)(F.MISC + 32), 4, F.G, (int)blockIdx.x, 1024, hx, hs, merged ? F.ctl + CW_UPDONE : nullptr, merged ? (F.G >> 4) : 0};
        EpiDown E{F.in[20], (unsigned char*)(ws + WS_XG)}; pg8::gemm_phase<EpiDown, SchedMoe, K_ALIGN, K_SP2, pg8::NoHook, 1>(F.wave, F.lds, 1024, S, E);
        if (BOTH(9)) GRID_BAR();
    }
    STAMP(10);
    if (IN(10)) { IN_FRESH(); REFRESH_F(); p10_final(F); }
    STAMP(11);
#if defined(DBG_LAST) && defined(DBG_SCAN)
    {
        if (N_LAUNCHES == 1) xcd_barrier(bar, F.wave == 0 && lane_id() == 0);
        const unsigned short* base = (const unsigned short*)(ws + DBG_SCAN_OFF);
        const size_t gt = (size_t)blockIdx.x * 512 + threadIdx.x, NGT = (size_t)gridDim.x * 512;
        for (size_t j = gt; j < (size_t)NTOK * DM; j += NGT) { float r = 0.f;
            for (size_t q = j; q < (size_t)DBG_SCAN_ELEMS; q += (size_t)NTOK * DM) { const unsigned v = base[q]; const unsigned e = (v >> 7) & 0xffu, m = v & 0x7fu;
                if (DBG_SCAN == 1 ? (e == 0xffu) : (e == 0u && m != 0u)) r = __builtin_nanf(""); }
            F.out[j] = r; }
    }
#endif
#if defined(DBG_LAST) && defined(DBG_REGIONS)
    {
        if (N_LAUNCHES == 1) xcd_barrier(bar, F.wave == 0 && lane_id() == 0);
        const size_t offs[] = {DBG_REGIONS}; const size_t nreg = sizeof(offs) / sizeof(offs[0]) / 2;
        const size_t gt = (size_t)blockIdx.x * 512 + threadIdx.x, NGT = (size_t)gridDim.x * 512;
        for (size_t j = gt; j < (size_t)NTOK * DM; j += NGT) { float acc = 0.f;
            for (size_t q = 0; q < nreg; ++q) { const unsigned short* base = (const unsigned short*)(ws + offs[2 * q]);
#ifdef DBG_LOWBYTE
                acc += (float)(base[j % (offs[2 * q + 1] / 2)] & 0xffu); }
#else
                acc += (float)base[j % (offs[2 * q + 1] / 2)]; }
#endif
#ifdef DBG_NOISE
            acc += (float)(DBG_NOISE) * (float)((__builtin_amdgcn_s_memrealtime() >> 4) & 1ull) * (float)((j * 2654435761ull >> 13) & 1ull);
#endif
            F.out[j] = acc; }
    }
#endif
#undef IN
#undef BOTH
}

extern "C" void kernel_launch(void* const* d_in, const int* in_sizes, int n_in, void* d_out, int out_size, void* d_ws, size_t ws_size, hipStream_t stream) {
    static int grid = 0;
    if (grid == 0) {
        if (n_in != 22 || in_sizes[0] != NTOK * DM || out_size != NTOK * DM || ws_size < WS_END) { fprintf(stderr, "kernel_launch: unexpected problem shape / workspace (n_in %d, ws %zu < %zu); nothing launched\n", n_in, ws_size, (size_t)WS_END); grid = -1; return; }
        int dev = 0, cus = 0, per_cu = 0;
        if (hipGetDevice(&dev) != hipSuccess || hipDeviceGetAttribute(&cus, hipDeviceAttributeMultiprocessorCount, dev) != hipSuccess) { grid = -1; return; }
        if (hipFuncSetAttribute((const void*)fwd_kernel, hipFuncAttributeMaxDynamicSharedMemorySize, LDS_BYTES) != hipSuccess) { fprintf(stderr, "kernel_launch: hipFuncSetAttribute failed\n"); grid = -1; return; }
        if (hipOccupancyMaxActiveBlocksPerMultiprocessor(&per_cu, (const void*)fwd_kernel, NWAVES * 64, LDS_BYTES) != hipSuccess || per_cu < 1) fprintf(stderr, "kernel_launch: occupancy query reports %d\n", per_cu);
        (void)hipGetLastError();
        grid = cus;
    }
    if (grid < 0) return;
    if (hipMemsetAsync((char*)d_ws + WS_CTL, 0, CTL_ZERO_BYTES, stream) != hipSuccess) return;
    Args a{};
    for (int i = 0; i < 22; ++i) a.in[i] = (const float*)d_in[i];
    a.out = (float*)d_out; a.ws = (unsigned char*)d_ws;
    for (int li = 0; li < N_LAUNCHES; ++li) {
        a.ph_lo = (N_LAUNCHES == 1) ? 0 : li; a.ph_hi = (N_LAUNCHES == 1) ? N_PHASES : li + 1; a.li = li;
        hipLaunchKernelGGL(fwd_kernel, dim3(grid), dim3(NWAVES * 64), LDS_BYTES, stream, a);
        if (hipPeekAtLastError() != hipSuccess) { fprintf(stderr, "kernel_launch: launch %d failed\n", li); break; }
    }
}
```

```cpp
#include <hip/hip_runtime.h>
#include <hip/hip_bf16.h>
#include <cstdio>
#include <cstdint>

#define GAS __attribute__((address_space(1)))
#define LAS __attribute__((address_space(3)))
typedef unsigned short bf16_t;
typedef short bf16x8 __attribute__((ext_vector_type(8)));
typedef _Float16 half8 __attribute__((ext_vector_type(8)));
typedef float f32x4 __attribute__((ext_vector_type(4)));
typedef float f32x2 __attribute__((ext_vector_type(2)));
typedef float f32x16 __attribute__((ext_vector_type(16)));
typedef unsigned u32x4 __attribute__((ext_vector_type(4)));
typedef unsigned u32x2 __attribute__((ext_vector_type(2)));
typedef GAS unsigned gu32;

constexpr int NB = 4, SEQ = 4096, NTOK = NB * SEQ, DM = 1024;
constexpr int NE = 32, TOPK = 4;
constexpr int N1 = 5888;
constexpr int N1_IN = 2816;
constexpr int MOE_ROWS = 73728;
constexpr float EPS = 1e-6f;
constexpr float C2 = 0.125f * 1.4426950408889634f;

constexpr size_t MiB = 1u << 20;
constexpr size_t WS_CTL = 0, CTL_ZERO_BYTES = 1 * MiB;
constexpr size_t WS_ROPE = 1 * MiB;
constexpr size_t WS_WGT = WS_ROPE + 256 * 1024;
constexpr size_t WS_WRH = WS_WGT + 32 * 1024;
constexpr size_t WS_WRL = WS_WRH + 64 * 1024;
constexpr size_t WS_W1T = 2 * MiB;
constexpr size_t WS_WPA = 14 * MiB, WS_WPP = 15 * MiB, WS_WPM = 15 * MiB + 512 * 1024, WS_WOUT = 16 * MiB, WS_WKV = 18 * MiB;
constexpr size_t WS_MEMN = 19 * MiB, WS_KM = 21 * MiB, WS_VMT = 21 * MiB + 512 * 1024;
constexpr size_t WS_IW = 22 * MiB, WS_IK = 23 * MiB;
constexpr size_t WS_RE = 25 * MiB, WS_RR = WS_RE + 256 * 1024, WS_RG = WS_RR + 256 * 1024, WS_SLOT = WS_RG + 256 * 1024, WS_RSTD = WS_SLOT + 256 * 1024;
constexpr size_t WS_WUP = 32 * MiB, WS_WDN = 160 * MiB, WS_XN = 224 * MiB;
constexpr size_t WS_Q = 256 * MiB, WS_K = 272 * MiB, WS_V = 288 * MiB, WS_IQ = 304 * MiB, WS_U = 320 * MiB, WS_QM = 328 * MiB;
constexpr size_t WS_YPOOL = 336 * MiB, WS_YMEM = 344 * MiB, WS_MASKT = 352 * MiB, WS_MERGED = 360 * MiB, WS_G = 392 * MiB;
constexpr size_t WS_XG = 488 * MiB, WS_ACT = 632 * MiB, WS_END = 776 * MiB;
constexpr size_t WS_XNB = WS_MERGED;
constexpr size_t WS_WU = 18 * MiB + 512 * 1024;
constexpr size_t WS_YCAT = WS_XN;
constexpr size_t WS_WCAT = WS_WPA;

constexpr int CW_TMO = 0;
constexpr int CW_CNT = 1024;
constexpr int CW_BAR = 4096;
constexpr int CW_UPDONE = 8192;

constexpr int RING_BYTES = 131072;
constexpr int LDS_BYTES = 155648;
constexpr int MISC_OFF = LDS_BYTES - 1024;

#define LDS_WAIT() asm volatile("s_waitcnt lgkmcnt(0)" ::: "memory")
#define VM_WAIT() asm volatile("s_waitcnt vmcnt(0)" ::: "memory")

typedef __bf16 bf16x2_cv __attribute__((ext_vector_type(2)));
__device__ __forceinline__ unsigned cvt_pk_bf16(float lo, float hi) { f32x2 v = {lo, hi}; bf16x2_cv b = __builtin_convertvector(v, bf16x2_cv); return __builtin_bit_cast(unsigned, b); }
__device__ __forceinline__ unsigned cvt_pk_fp8x4(float a, float b, float c, float d) { int w = 0; w = __builtin_amdgcn_cvt_pk_fp8_f32(a, b, w, false); w = __builtin_amdgcn_cvt_pk_fp8_f32(c, d, w, true); return (unsigned)w; }
__device__ __forceinline__ unsigned cvt_pk_bf16_s(float lo, float hi) { return cvt_pk_bf16(lo, hi); }
typedef _Float16 h2_t __attribute__((ext_vector_type(2)));
__device__ __forceinline__ unsigned cvt_pk_f16(float lo, float hi) { h2_t v = {(_Float16)lo, (_Float16)hi}; return __builtin_bit_cast(unsigned, v); }
__device__ __forceinline__ float bf2f(unsigned short b) { return __builtin_bit_cast(float, (unsigned)b << 16); }
__device__ __forceinline__ float bflo(unsigned w) { return __builtin_bit_cast(float, w << 16); }
__device__ __forceinline__ float bfhi(unsigned w) { return __builtin_bit_cast(float, w & 0xffff0000u); }
__device__ __forceinline__ int lane_id() { int l; asm volatile("v_mbcnt_lo_u32_b32 %0, -1, 0\n\tv_mbcnt_hi_u32_b32 %0, -1, %0" : "=v"(l)); return l; }
__device__ __forceinline__ float wave_sum(float v) {
#pragma unroll
    for (int o = 1; o < 64; o <<= 1) v += __shfl_xor(v, o);
    return v;
}
typedef short s16x2_t __attribute__((ext_vector_type(2)));
__device__ __forceinline__ int wave_sum_i(int v) {
    v += __builtin_amdgcn_update_dpp(0, v, 0xB1, 0xf, 0xf, false);
    v += __builtin_amdgcn_update_dpp(0, v, 0x4E, 0xf, 0xf, false);
    v += __builtin_amdgcn_update_dpp(0, v, 0x141, 0xf, 0xf, false);
    v += __builtin_amdgcn_update_dpp(0, v, 0x140, 0xf, 0xf, false);
    return __builtin_amdgcn_readlane(v, 0) + __builtin_amdgcn_readlane(v, 16) + __builtin_amdgcn_readlane(v, 32) + __builtin_amdgcn_readlane(v, 48);
}
__device__ __forceinline__ float sigmoidf_fast(float x) { return __builtin_amdgcn_rcpf(1.f + __builtin_amdgcn_exp2f(-1.4426950408889634f * x)); }

#ifndef PG8_DMA_AUX
#define PG8_DMA_AUX 0
#endif
namespace pg8 {
constexpr int BM = 256, BK = 64, HALF = 128, HTB = HALF * BK * 2, STAGE_BYTES = 8 * HTB, NXCD = 8, WGM = 8;
__host__ __device__ __forceinline__ int lds_byte(int r, int c) { const int st = (r >> 4) * 2 + (c >> 5), rr = r & 15, cc = c & 31, ob = rr * 64 + cc * 2; return st * 1024 + (ob ^ (((ob >> 9) & 1) << 5)); }
__host__ __device__ __forceinline__ void stage_rc(int b, int& R, int& C) { const int st = b / 1024, sb = b % 1024, swz = sb ^ (((sb >> 9) & 1) << 5); R = (st >> 1) * 16 + swz / 64; C = (st & 1) * 32 + (swz % 64) / 2; }
__host__ __device__ __forceinline__ int perm32(int rho) { const int n = rho >> 4, i = rho & 15; return 8 * (i >> 2) + 4 * n + (i & 3); }

struct Unit { int pm, pn, kind, c0; const char* a; const char* b; };

__device__ __forceinline__ void tile_order(int L, int nM, int nN, int& pm, int& pn) {
    const int nwg = nM * nN; int wgid = L;
    { const int q = nwg / NXCD, r = nwg % NXCD, xcd = wgid % NXCD, off = wgid / NXCD; wgid = (xcd < r ? xcd * (q + 1) : r * (q + 1) + (xcd - r) * q) + off; }
    const int nig = WGM * nN, gid = wgid / nig, fm = gid * WGM, gsz = (nM - fm) < WGM ? (nM - fm) : WGM;
    pm = fm + ((wgid % nig) % gsz); pn = (wgid % nig) / gsz;
}

struct NoHook { template <class A> __device__ __forceinline__ void operator()(A&, const Unit&, int, int, int, int, int) const {} };
typedef int v8i_t __attribute__((ext_vector_type(8)));
template <class Epi, class Sched, bool ALIGN_EPI = false, bool SP2 = false, class Hook = NoHook, int ESZ = 2>
__device__ __forceinline__ void gemm_phase(const int wid, LAS unsigned char* lds, const int K, const Sched& S, const Epi& E, const int ktiles = 0, const Hook& H = Hook()) {
    int lane = lane_id(); asm volatile("" : "+v"(lane));
    const int tid = wid * 64 + lane, wr = wid >> 2, wc = wid & 3, fr = lane & 15, fq = lane >> 4;
    const int nt = ktiles ? ktiles : K * ESZ / 128;
    unsigned voffA[2], voffB[2];
#pragma unroll
    for (int i = 0; i < 2; ++i) { int R, C; stage_rc(tid * 16 + i * 8192, R, C); const int Rb = Epi::PERM ? ((R & ~31) + perm32(R & 31)) : R;
        voffA[i] = (unsigned)(R * K * ESZ + C * 2); voffB[i] = (unsigned)(Rb * K * ESZ + C * 2); }
    const size_t kstep = (size_t)(BK * 2);
    const size_t hstep = (size_t)HALF * K * ESZ;
    const unsigned ldsw = (unsigned)wid * 1024u;
#ifndef FP8_FRAG_CONTIG
    const int aoff0 = lds_byte(wr * 64 + fr, fq * 8), aoff1 = lds_byte(wr * 64 + fr, fq * 8 + 32);
    const int boff0 = lds_byte(wc * 32 + fr, fq * 8), boff1 = lds_byte(wc * 32 + fr, fq * 8 + 32);
#else
    const int aoff0 = lds_byte(wr * 64 + fr, ESZ == 2 ? fq * 8 : fq * 16), aoff1 = lds_byte(wr * 64 + fr, ESZ == 2 ? fq * 8 + 32 : fq * 16 + 8);
    const int boff0 = lds_byte(wc * 32 + fr, ESZ == 2 ? fq * 8 : fq * 16), boff1 = lds_byte(wc * 32 + fr, ESZ == 2 ? fq * 8 + 32 : fq * 16 + 8);
#endif
#define PG8_SA(b, h) (((b) * 2 + (h)) * HTB)
#define PG8_SB(b, h) ((4 + (b) * 2 + (h)) * HTB)
    const unsigned lds0 = (unsigned)(uintptr_t)lds;
#define PG8_STAGE(bufoff, gbase, voff) do { _Pragma("unroll") for (int _i = 0; _i < 2; ++_i) { unsigned keep_; \
        asm volatile("s_mov_b32 %0, m0\n\ts_mov_b32 m0, %3\n\ts_nop 2\n\tglobal_load_lds_dwordx4 %1, %2\n\ts_mov_b32 m0, %0" : "=&s"(keep_) : "v"((voff)[_i]), "s"((const char*)(gbase)), "s"(lds0 + (unsigned)(bufoff) + ldsw + (unsigned)_i * 8192u) : "memory"); } } while (0)
#define PG8_LDA(dst, b, h) do { _Pragma("unroll") for (int m = 0; m < 4; ++m) { dst[m][0] = *(const LAS bf16x8*)(lds + PG8_SA(b, h) + aoff0 + m * 2048); dst[m][1] = *(const LAS bf16x8*)(lds + PG8_SA(b, h) + aoff1 + m * 2048); } } while (0)
#define PG8_LDB(dst, b, h) do { _Pragma("unroll") for (int n = 0; n < 2; ++n) { dst[n][0] = *(const LAS bf16x8*)(lds + PG8_SB(b, h) + boff0 + n * 2048); dst[n][1] = *(const LAS bf16x8*)(lds + PG8_SB(b, h) + boff1 + n * 2048); } } while (0)
#define PG8_CAT(x) __builtin_shufflevector(__builtin_bit_cast(u32x4, (x)[0]), __builtin_bit_cast(u32x4, (x)[1]), 0, 1, 2, 3, 4, 5, 6, 7)
#define PG8_MMA(ai, bj, At, Bt) do { __builtin_amdgcn_s_setprio(1); _Pragma("unroll") for (int m = 0; m < 4; ++m) _Pragma("unroll") for (int n = 0; n < 2; ++n) { \
        if constexpr (ESZ == 2) { _Pragma("unroll") for (int k = 0; k < 2; ++k) acc[ai][bj][m][n] = __builtin_amdgcn_mfma_f32_16x16x32_bf16(Bt[n][k], At[m][k], acc[ai][bj][m][n], 0, 0, 0); } \
        else acc[ai][bj][m][n] = __builtin_amdgcn_mfma_scale_f32_16x16x128_f8f6f4(__builtin_bit_cast(v8i_t, PG8_CAT(Bt[n])), __builtin_bit_cast(v8i_t, PG8_CAT(At[m])), acc[ai][bj][m][n], 0, 0, 0, 0, 0, 0); }        \
        __builtin_amdgcn_s_setprio(0); } while (0)
#define PG8_WAIT_V(n) asm volatile("s_waitcnt vmcnt(" #n ")" ::: "memory")
#define PG8_WAIT_L(n) asm volatile("s_waitcnt lgkmcnt(" #n ")" ::: "memory")
#define PG8_BAR __builtin_amdgcn_s_barrier()
#define PG8_SCHED __builtin_amdgcn_sched_barrier(0)
    Unit cur, nxt; int ui = 0;
    if (!S.next(0, cur)) return;
    f32x4 acc[2][2][4][2];
#pragma unroll
    for (int a = 0; a < 2; ++a)
#pragma unroll
        for (int b = 0; b < 2; ++b)
#pragma unroll
            for (int m = 0; m < 4; ++m)
#pragma unroll
                for (int n = 0; n < 2; ++n) acc[a][b][m][n] = (f32x4){0.f, 0.f, 0.f, 0.f};
    bf16x8 At[4][2], B0[2][2], B1[2][2];
#define PG8_UNI(p) ((const char*)(((unsigned long long)(unsigned)__builtin_amdgcn_readfirstlane((int)(unsigned)((unsigned long long)(p) >> 32)) << 32) | (unsigned)__builtin_amdgcn_readfirstlane((int)(unsigned)(unsigned long long)(p))))
    const char* cA = PG8_UNI(cur.a); const char* cB = PG8_UNI(cur.b);
    if constexpr (SP2) {
        PG8_STAGE(PG8_SB(0, 0), cB, voffB); PG8_STAGE(PG8_SB(0, 1), cB + hstep, voffB); PG8_STAGE(PG8_SA(0, 0), cA, voffA); PG8_STAGE(PG8_SA(0, 1), cA + hstep, voffA);
        if (wr == 1) PG8_BAR;
        PG8_WAIT_V(2); PG8_BAR;
        PG8_STAGE(PG8_SB(1, 0), cB + kstep, voffB); PG8_STAGE(PG8_SA(1, 0), cA + kstep, voffA); PG8_STAGE(PG8_SB(1, 1), cB + hstep + kstep, voffB);
        PG8_WAIT_V(6); PG8_BAR;
    } else {
        PG8_STAGE(PG8_SB(0, 0), cB, voffB); PG8_STAGE(PG8_SA(0, 0), cA, voffA); PG8_STAGE(PG8_SB(0, 1), cB + hstep, voffB); PG8_STAGE(PG8_SA(0, 1), cA + hstep, voffA);
        if (wr == 1) PG8_BAR;
        PG8_WAIT_V(4); PG8_BAR;
        PG8_STAGE(PG8_SB(1, 0), cB + kstep, voffB); PG8_STAGE(PG8_SA(1, 0), cA + kstep, voffA); PG8_STAGE(PG8_SB(1, 1), cB + hstep + kstep, voffB);
        PG8_WAIT_V(6); PG8_BAR;
    }
    for (;;) {
        const bool has_next = S.next(ui + 1, nxt);
        const char* nA = PG8_UNI(has_next ? nxt.a : cA); const char* nB = PG8_UNI(has_next ? nxt.b : cB);
#pragma nounroll
        for (int t = 0; t < nt; t += 2) {
            const bool last = (t == nt - 2);
            H(acc, cur, t, wr, wc, fr, fq);
            const char* a1 = cA + (size_t)(t + 1) * kstep;
            const char* a2 = last ? nA : cA + (size_t)(t + 2) * kstep; const char* b2 = last ? nB : cB + (size_t)(t + 2) * kstep;
            const char* a3 = a2 + kstep; const char* b3 = b2 + kstep;
            if constexpr (SP2) {
            PG8_LDB(B0, 0, 0); PG8_LDB(B1, 0, 1); PG8_SCHED; PG8_LDA(At, 0, 0); PG8_STAGE(PG8_SA(1, 1), a1 + hstep, voffA);
            PG8_WAIT_V(8); PG8_WAIT_L(0); PG8_BAR; PG8_MMA(0, 0, At, B0); PG8_MMA(0, 1, At, B1); PG8_BAR; PG8_SCHED;
            PG8_LDA(At, 0, 1); PG8_STAGE(PG8_SB(0, 0), b2, voffB); PG8_STAGE(PG8_SB(0, 1), b2 + hstep, voffB); PG8_STAGE(PG8_SA(0, 0), a2, voffA);
            PG8_WAIT_V(8); PG8_WAIT_L(0); PG8_BAR; PG8_MMA(1, 0, At, B0); PG8_MMA(1, 1, At, B1); PG8_BAR; PG8_SCHED;
            PG8_LDB(B0, 1, 0); PG8_LDB(B1, 1, 1); PG8_SCHED; PG8_LDA(At, 1, 0); PG8_STAGE(PG8_SA(0, 1), a2 + hstep, voffA);
            PG8_WAIT_V(8); PG8_WAIT_L(0); PG8_BAR; PG8_MMA(0, 0, At, B0); PG8_MMA(0, 1, At, B1); PG8_BAR; PG8_SCHED;
            PG8_LDA(At, 1, 1); PG8_STAGE(PG8_SB(1, 0), b3, voffB); PG8_STAGE(PG8_SB(1, 1), b3 + hstep, voffB); PG8_STAGE(PG8_SA(1, 0), a3, voffA);
            PG8_WAIT_V(8); PG8_WAIT_L(0); PG8_BAR; PG8_MMA(1, 0, At, B0); PG8_MMA(1, 1, At, B1); PG8_BAR; PG8_SCHED;
            } else {
            PG8_LDB(B0, 0, 0); PG8_SCHED; PG8_LDA(At, 0, 0); PG8_STAGE(PG8_SA(1, 1), a1 + hstep, voffA);
            PG8_WAIT_L(8); PG8_BAR; PG8_WAIT_L(0); PG8_MMA(0, 0, At, B0); PG8_BAR; PG8_SCHED;
            PG8_LDB(B1, 0, 1); PG8_STAGE(PG8_SB(0, 0), b2, voffB);
            PG8_BAR; PG8_WAIT_L(0); PG8_MMA(0, 1, At, B1); PG8_BAR;
            PG8_LDA(At, 0, 1); PG8_STAGE(PG8_SA(0, 0), a2, voffA);
            PG8_BAR; PG8_WAIT_L(0); PG8_MMA(1, 0, At, B0); PG8_BAR; PG8_SCHED;
            PG8_STAGE(PG8_SB(0, 1), b2 + hstep, voffB);
            PG8_WAIT_V(6); PG8_BAR; PG8_MMA(1, 1, At, B1); PG8_BAR;
            PG8_LDB(B0, 1, 0); PG8_SCHED; PG8_LDA(At, 1, 0); PG8_STAGE(PG8_SA(0, 1), a2 + hstep, voffA);
            PG8_WAIT_L(8); PG8_BAR; PG8_WAIT_L(0); PG8_MMA(0, 0, At, B0); PG8_BAR; PG8_SCHED;
            PG8_LDB(B1, 1, 1); PG8_STAGE(PG8_SB(1, 0), b3, voffB);
            PG8_BAR; PG8_WAIT_L(0); PG8_MMA(0, 1, At, B1); PG8_BAR;
            PG8_LDA(At, 1, 1); PG8_STAGE(PG8_SA(1, 0), a3, voffA);
            PG8_BAR; PG8_WAIT_L(0); PG8_MMA(1, 0, At, B0); PG8_BAR; PG8_SCHED;
            PG8_STAGE(PG8_SB(1, 1), b3 + hstep, voffB);
            PG8_WAIT_V(6); PG8_BAR; PG8_MMA(1, 1, At, B1); PG8_BAR;
            }
        }
        if constexpr (ALIGN_EPI) { if (wr == 0) PG8_BAR; }
        { int l2 = lane_id(); asm volatile("" : "+v"(l2)); E(acc, cur, wr, wc, l2 & 15, l2 >> 4); }
        if (!has_next) break;
#pragma unroll
        for (int a = 0; a < 2; ++a)
#pragma unroll
            for (int b = 0; b < 2; ++b)
#pragma unroll
                for (int m = 0; m < 4; ++m)
#pragma unroll
                    for (int n = 0; n < 2; ++n) acc[a][b][m][n] = (f32x4){0.f, 0.f, 0.f, 0.f};
        cur = nxt; cA = nA; cB = nB; ++ui;
        if constexpr (ALIGN_EPI) { if (wr == 1) PG8_BAR; }
    }
    PG8_WAIT_V(0);
    if constexpr (!ALIGN_EPI) { if (wr == 0) PG8_BAR; }
    PG8_BAR;
#undef PG8_SA
#undef PG8_SB
#undef PG8_STAGE
#undef PG8_LDA
#undef PG8_LDB
#undef PG8_MMA
#undef PG8_CAT
#undef PG8_UNI
#undef PG8_WAIT_V
#undef PG8_WAIT_L
#undef PG8_BAR
#undef PG8_SCHED
}
}
using pg8::Unit;
constexpr bool K_ALIGN = true, K_SP2 = true;
#ifndef P4_ALIGN
#define P4_ALIGN true
#endif
#ifndef P4_SP2
#define P4_SP2 true
#endif

enum { KQ = 0, KK = 1, KV = 2, KIQ = 3, KU = 4, KQM = 5, KIKW = 6, KG = 7, KKM = 8, KVMT = 9 };
struct EpiP1 {
    static constexpr bool PERM = true;
    bf16_t *Q, *K, *V, *U, *QM, *G, *KM, *VMT; unsigned short *IQ, *IK; float* IW; const float* bgate; const float* rope; float accscale;
    __device__ __forceinline__ static void rope4(f32x4& v, const f32x4 cs) {
        const float a1 = v[0] * cs[0] - v[1] * cs[1], a2 = v[1] * cs[0] + v[0] * cs[1];
        const float b1 = v[2] * cs[2] - v[3] * cs[3], b2 = v[3] * cs[2] + v[2] * cs[3];
        v = (f32x4){a1, a2, b1, b2};
    }
    template <int KIND> __device__ __forceinline__ void run(const f32x4 (&acc)[2][2][4][2], const Unit& u, int wr, int wc, int fr, int fq) const {
        const int row0 = u.pm * 256 + wr * 64 + fr;
        constexpr bool ROPE = (KIND == KQ || KIND == KK || KIND == KIQ || KIND == KIKW);
        f32x4 gb0[2], gb1[2];
        if constexpr (KIND == KG) {
#pragma unroll
            for (int bj = 0; bj < 2; ++bj) { const float* bp = bgate + u.c0 + bj * 128 + wc * 32 + 8 * fq; gb0[bj] = *(const f32x4*)bp; gb1[bj] = *(const f32x4*)(bp + 4); } }
        const bool ropelane = ROPE && ((wc & 1) == 0) && (fq < 2);
#pragma unroll
        for (int ai = 0; ai < 2; ++ai) {
            f32x4 csa[4], csb[4];
#pragma unroll
            for (int m = 0; m < 4; ++m) { csa[m] = (f32x4){1.f, 0.f, 1.f, 0.f}; csb[m] = csa[m];
                if (ROPE) { if (ropelane) { const float* rp = rope + (size_t)((row0 + ai * 128 + m * 16) & (SEQ - 1)) * 16 + 8 * fq; csa[m] = *(const f32x4*)rp; csb[m] = *(const f32x4*)(rp + 4); } } }
#pragma unroll
            for (int m = 0; m < 4; ++m) {
                const int row = row0 + ai * 128 + m * 16;
                const f32x4 cs0 = csa[m], cs1 = csb[m];
#pragma unroll
                for (int bj = 0; bj < 2; ++bj) {
                    f32x4 v0 = acc[ai][bj][m][0] * accscale, v1 = acc[ai][bj][m][1] * accscale;
                    const int lc = bj * 128 + wc * 32 + 8 * fq;
                    if constexpr (KIND == KQ || KIND == KK || KIND == KIQ) { if (ropelane) { rope4(v0, cs0); rope4(v1, cs1); } }
                    if constexpr (KIND == KIKW) { if (ropelane && bj == 0 && wc == 0) { rope4(v0, cs0); rope4(v1, cs1); } }
                    if constexpr (KIND == KQ || KIND == KQM) { v0 = v0 * C2; v1 = v1 * C2; }
                    if constexpr (KIND == KIQ) { v0 = v0 * 0.125f; v1 = v1 * 0.125f; }
                    if constexpr (KIND == KG) {
#pragma unroll
                        for (int i = 0; i < 4; ++i) { v0[i] = sigmoidf_fast(v0[i] + gb0[bj][i]); v1[i] = sigmoidf_fast(v1[i] + gb1[bj][i]); }
                    }
                    if constexpr (KIND == KIQ) {
                        u32x4 w; w.x = cvt_pk_f16(v0[0], v0[1]); w.y = cvt_pk_f16(v0[2], v0[3]); w.z = cvt_pk_f16(v1[0], v1[1]); w.w = cvt_pk_f16(v1[2], v1[3]);
                        *(u32x4*)(IQ + (size_t)row * 512 + u.c0 + lc) = w;
                    } else if constexpr (KIND == KIKW) {
                        if (lc < 64) { u32x4 w; w.x = cvt_pk_f16(v0[0], v0[1]); w.y = cvt_pk_f16(v0[2], v0[3]); w.z = cvt_pk_f16(v1[0], v1[1]); w.w = cvt_pk_f16(v1[2], v1[3]);
                            *(u32x4*)(IK + (size_t)row * 64 + lc) = w; }
                        else if (lc == 64) { const float s = 0.35355339059327373f; float* p = IW + (size_t)row * 8; *(f32x4*)p = v0 * s; *(f32x4*)(p + 4) = v1 * s; }
                    } else if constexpr (KIND == KVMT) {
                        const int b = row >> 8, key = row & 255;
                        const float vv[8] = {v0[0], v0[1], v0[2], v0[3], v1[0], v1[1], v1[2], v1[3]};
#pragma unroll
                        for (int i = 0; i < 8; ++i) { const int c = lc + i, hm = c >> 6, d = c & 63; VMT[((size_t)(b * 4 + hm) * 64 + d) * 256 + key] = (bf16_t)(cvt_pk_bf16(vv[i], 0.f) & 0xffffu); }
                    } else {
                        u32x4 w; w.x = cvt_pk_bf16(v0[0], v0[1]); w.y = cvt_pk_bf16(v0[2], v0[3]); w.z = cvt_pk_bf16(v1[0], v1[1]); w.w = cvt_pk_bf16(v1[2], v1[3]);
                        bf16_t* dst;
                        if constexpr (KIND == KQ) dst = Q + (size_t)row * 512;
                        else if constexpr (KIND == KK) dst = K + (size_t)row * 512;
                        else if constexpr (KIND == KV) dst = V + (size_t)row * 512;
                        else if constexpr (KIND == KU) dst = U + (size_t)row * 256;
                        else if constexpr (KIND == KQM) dst = QM + (size_t)row * 256;
                        else if constexpr (KIND == KG) dst = G + (size_t)row * 3072;
                        else dst = KM + (size_t)row * 256;
                        *(u32x4*)(dst + u.c0 + lc) = w;
                    }
                }
            }
        }
    }
    __device__ __forceinline__ void operator()(const f32x4 (&acc)[2][2][4][2], const Unit& u, int wr, int wc, int fr, int fq) const {
        switch (u.kind) {
            case KQ: run<KQ>(acc, u, wr, wc, fr, fq); break;
            case KK: run<KK>(acc, u, wr, wc, fr, fq); break;
            case KV: run<KV>(acc, u, wr, wc, fr, fq); break;
            case KIQ: run<KIQ>(acc, u, wr, wc, fr, fq); break;
            case KU: run<KU>(acc, u, wr, wc, fr, fq); break;
            case KQM: run<KQM>(acc, u, wr, wc, fr, fq); break;
            case KIKW: run<KIKW>(acc, u, wr, wc, fr, fq); break;
            case KG: run<KG>(acc, u, wr, wc, fr, fq); break;
            case KKM: run<KKM>(acc, u, wr, wc, fr, fq); break;
            default: run<KVMT>(acc, u, wr, wc, fr, fq); break;
        }
    }
};
struct SchedU {
    const char *XNB, *WU; int G, c;
    __device__ __forceinline__ bool next(int i, Unit& u) const {
        const int j = G - 1 - c; if (i != 0 || j < 0 || j >= 64) return false;
        u.pm = j; u.pn = 8; u.kind = KU; u.c0 = 0; u.a = XNB + (size_t)j * 256 * 2048; u.b = WU; return true;
    }
};
struct Sched1 {
    const char *XN, *W1T, *MEMN, *WKV; int G, c;
    __device__ __forceinline__ bool next(int i, Unit& u) const {
        int L = i * G + c;
        if (G == 256) {
            if (i < 4) L = i * 256 + c; else if (i < 6) { if (c >= 192) return false; L = 1024 + (i - 4) * 192 + c; } else return false;
        }
        if (L < 64 * 22) {
            pg8::tile_order(L, 64, 22, u.pm, u.pn); if (u.pn >= 8) ++u.pn;
            u.a = XN + (size_t)u.pm * 256 * 1024; u.b = W1T + (size_t)u.pn * 256 * 1024;
            const int pn = u.pn;
            if (pn < 2) { u.kind = KQ; u.c0 = pn * 256; } else if (pn < 4) { u.kind = KK; u.c0 = (pn - 2) * 256; } else if (pn < 6) { u.kind = KV; u.c0 = (pn - 4) * 256; }
            else if (pn < 8) { u.kind = KIQ; u.c0 = (pn - 6) * 256; } else if (pn == 8) { u.kind = KU; u.c0 = 0; } else if (pn == 9) { u.kind = KQM; u.c0 = 0; }
            else if (pn == 10) { u.kind = KIKW; u.c0 = 0; } else { u.kind = KG; u.c0 = (pn - 11) * 256; }
            return true;
        }
        return false;
    }
};
template <int MODE> struct EpiGate {
    static constexpr bool PERM = true;
    const bf16_t* G; const bf16_t* PREV; bf16_t* OUT; int br;
    __device__ __forceinline__ void operator()(const f32x4 (&acc)[2][2][4][2], const Unit& u, int wr, int wc, int fr, int fq) const {
        const int row0 = u.pm * 256 + wr * 64 + fr, col0 = u.pn * 256 + wc * 32 + 8 * fq;
#pragma unroll
        for (int b0 = 0; b0 < 16; b0 += 8) {
            u32x4 gv[8], pv[MODE != 0 ? 8 : 1];
#pragma unroll
            for (int q = 0; q < 8; ++q) { const int st = b0 + q, ai = st >> 3, m = (st >> 1) & 3, bj = st & 1; const int row = row0 + ai * 128 + m * 16, col = col0 + bj * 128;
                gv[q] = *(const u32x4*)(G + (size_t)row * 3072 + br * 1024 + col);
                if constexpr (MODE != 0) pv[q] = *(const u32x4*)(PREV + (size_t)row * 1024 + col); }
#pragma unroll
            for (int q = 0; q < 8; ++q) { const int st = b0 + q, ai = st >> 3, m = (st >> 1) & 3, bj = st & 1; const int row = row0 + ai * 128 + m * 16, col = col0 + bj * 128;
                const u32x4 g = gv[q];
                const f32x4 v0 = acc[ai][bj][m][0], v1 = acc[ai][bj][m][1];
                float o[8] = {v0[0] * bflo(g.x), v0[1] * bfhi(g.x), v0[2] * bflo(g.y), v0[3] * bfhi(g.y), v1[0] * bflo(g.z), v1[1] * bfhi(g.z), v1[2] * bflo(g.w), v1[3] * bfhi(g.w)};
#ifdef ABL_ZERO_BR
                if (br == ABL_ZERO_BR) {
#pragma unroll
                    for (int i = 0; i < 8; ++i) o[i] = 0.f; }
#endif
                if constexpr (MODE != 0) { const u32x4 p = pv[q];
                    o[0] += bflo(p.x); o[1] += bfhi(p.x); o[2] += bflo(p.y); o[3] += bfhi(p.y); o[4] += bflo(p.z); o[5] += bfhi(p.z); o[6] += bflo(p.w); o[7] += bfhi(p.w); }
                u32x4 w; w.x = cvt_pk_bf16(o[0], o[1]); w.y = cvt_pk_bf16(o[2], o[3]); w.z = cvt_pk_bf16(o[4], o[5]); w.w = cvt_pk_bf16(o[6], o[7]);
                *(u32x4*)(OUT + (size_t)row * 1024 + col) = w;
            }
        }
    }
};
struct GateRatioHook {
    const bf16_t* G;
    __device__ __forceinline__ void operator()(f32x4 (&acc)[2][2][4][2], const Unit& u, int t, int wr, int wc, int fr, int fq) const {
        if (t != 8 && t != 12) return;
        const int bra = (t == 8) ? 0 : 1;
        int row0 = u.pm * 256 + wr * 64 + fr, col0 = u.pn * 256 + wc * 32 + 8 * fq;
        asm volatile("" : "+v"(row0), "+v"(col0));
#ifndef HOOK_BATCH
#define HOOK_BATCH 8
#endif
#pragma unroll
        for (int b0 = 0; b0 < 16; b0 += HOOK_BATCH) {
            u32x4 ga[HOOK_BATCH], gb[HOOK_BATCH];
#pragma unroll
            for (int q = 0; q < HOOK_BATCH; ++q) { const int st = b0 + q, ai = st >> 3, m = (st >> 1) & 3, bj = st & 1;
                const bf16_t* gp = G + (size_t)(row0 + ai * 128 + m * 16) * 3072 + bra * 1024 + col0 + bj * 128; ga[q] = *(const u32x4*)gp; gb[q] = *(const u32x4*)(gp + 1024); }
#pragma unroll
            for (int q = 0; q < HOOK_BATCH; ++q) { const int st = b0 + q, ai = st >> 3, m = (st >> 1) & 3, bj = st & 1;
                const float na[8] = {bflo(ga[q].x), bfhi(ga[q].x), bflo(ga[q].y), bfhi(ga[q].y), bflo(ga[q].z), bfhi(ga[q].z), bflo(ga[q].w), bfhi(ga[q].w)};
                const float nb[8] = {bflo(gb[q].x), bfhi(gb[q].x), bflo(gb[q].y), bfhi(gb[q].y), bflo(gb[q].z), bfhi(gb[q].z), bflo(gb[q].w), bfhi(gb[q].w)};
#pragma unroll
                for (int i = 0; i < 8; ++i) { const float rt = na[i] * __builtin_amdgcn_rcpf(fmaxf(nb[i], 1e-30f)); acc[ai][bj][m][i >> 2][i & 3] *= rt; } }
            __builtin_amdgcn_sched_barrier(0);
        }
    }
};
struct SchedSimple {
    const char *A, *B; int nM, nN, G, c; size_t tstep;
    __device__ __forceinline__ bool next(int i, Unit& u) const {
        const int L = i * G + c; if (L >= nM * nN) return false;
        pg8::tile_order(L, nM, nN, u.pm, u.pn); u.a = A + (size_t)u.pm * tstep; u.b = B + (size_t)u.pn * tstep; u.kind = 0; u.c0 = 0; return true;
    }
};
struct EpiRes {
    static constexpr bool PERM = false;
    const float* X; float* H;
    __device__ __forceinline__ void operator()(const f32x4 (&acc)[2][2][4][2], const Unit& u, int wr, int wc, int fr, int fq) const {
        const int row0 = u.pm * 256 + wr * 64 + fr, col0 = u.pn * 256 + wc * 32 + 4 * fq;
#pragma unroll
        for (int ai = 0; ai < 2; ++ai)
#pragma unroll
            for (int m = 0; m < 4; ++m) { const size_t off = (size_t)(row0 + ai * 128 + m * 16) * 1024 + col0;
#pragma unroll
                for (int bj = 0; bj < 2; ++bj)
#pragma unroll
                    for (int n = 0; n < 2; ++n) { const size_t o = off + bj * 128 + n * 16; *(f32x4*)(H + o) = *(const f32x4*)(X + o) + acc[ai][bj][m][n];
#ifdef DBG_DRAIN_ST
                        asm volatile("s_waitcnt vmcnt(0)" ::: "memory");
#endif
                    } }
    }
};
struct SchedMoe {
    const char *A, *W; const volatile LAS int* tpre0; int npn, G, c, rowb; int hx = -1, hs = 0; unsigned* wait_ctr = nullptr; int srot = 0;
    __device__ __forceinline__ bool next(int i, Unit& u) const {
        unsigned toff = (unsigned)(uintptr_t)tpre0; asm volatile("" : "+s"(toff)); const volatile LAS int* tpre = (const volatile LAS int*)(uintptr_t)toff;
        const int TT = __builtin_amdgcn_readfirstlane(tpre[32]); int T, pn;
        if ((G & 7) == 0 && (G >> 3) % npn == 0) { const int per = G >> 3, xcd = hx >= 0 ? hx : (c & 7), s0_ = hx >= 0 ? hs : (c >> 3), s = srot ? per - 1 - s0_ : s0_, mt = per / npn, chunk = (TT + 7) >> 3, tl = i * mt + s / npn;
            pn = s % npn; if (tl >= chunk) return false; T = xcd * chunk + tl; }
        else { const int L = i * G + c; T = L / npn; pn = L - T * npn; }
        if (T >= TT) return false;
        int e = 0;
#pragma unroll
        for (int j = 1; j < 32; ++j) e += (tpre[j] <= T) ? 1 : 0;
        e = __builtin_amdgcn_readfirstlane(e);
        if (wait_ctr) { unsigned sp_ = 0u; while (__hip_atomic_load(wait_ctr + T, __ATOMIC_RELAXED, __HIP_MEMORY_SCOPE_AGENT) < 64u) { __builtin_amdgcn_s_sleep(2); if (++sp_ > (1u << 22)) break; } }
        u.pm = T; u.pn = pn; u.kind = e; u.c0 = 0; u.a = A + (size_t)T * 256 * rowb; u.b = W + ((size_t)e * npn + pn) * 256 * rowb; return true;
    }
};
struct EpiSwiglu {
    static constexpr bool PERM = true;
    const float* bup; unsigned char* ACT; unsigned* done_ctr = nullptr;
    __device__ __forceinline__ void operator()(const f32x4 (&acc)[2][2][4][2], const Unit& u, int wr, int wc, int fr, int fq) const {
        const int row0 = u.pm * 256 + wr * 64 + fr, e = u.kind, jc = u.pn * 128 + wc * 32 + 8 * fq;
        const float* bg = bup + (size_t)e * 2048 + jc; const float* bl = bg + 1024;
        const f32x4 bg0 = *(const f32x4*)bg, bg1 = *(const f32x4*)(bg + 4), bl0 = *(const f32x4*)bl, bl1 = *(const f32x4*)(bl + 4);
#pragma unroll
        for (int ai = 0; ai < 2; ++ai)
#pragma unroll
            for (int m = 0; m < 4; ++m) {
                const int row = row0 + ai * 128 + m * 16;
                float o[8];
#pragma unroll
                for (int n = 0; n < 2; ++n) { const f32x4 gv = acc[ai][0][m][n] * (1.f / 64.f) + (n ? bg1 : bg0), lv = acc[ai][1][m][n] * (1.f / 64.f) + (n ? bl1 : bl0);
#pragma unroll
                    for (int i = 0; i < 4; ++i) { const float g = fminf(gv[i], 7.f), l = fminf(fmaxf(lv[i], -7.f), 7.f); o[n * 4 + i] = g * sigmoidf_fast(1.702f * g) * (l + 1.f); } }
                u32x2 w; w.x = cvt_pk_fp8x4(o[0], o[1], o[2], o[3]); w.y = cvt_pk_fp8x4(o[4], o[5], o[6], o[7]);
                *(u32x2*)(ACT + (size_t)row * 1024 + jc) = w;
            }
        if (done_ctr) { asm volatile("s_waitcnt vmcnt(0)" ::: "memory"); if (lane_id() == 0) __hip_atomic_fetch_add(done_ctr + u.pm, 1u, __ATOMIC_RELAXED, __HIP_MEMORY_SCOPE_AGENT); }
    }
};
struct EpiDown {
    static constexpr bool PERM = true;
    const float* bdn; unsigned char* Y;
    __device__ __forceinline__ void operator()(const f32x4 (&acc)[2][2][4][2], const Unit& u, int wr, int wc, int fr, int fq) const {
        const int row0 = u.pm * 256 + wr * 64 + fr, e = u.kind, col0 = u.pn * 256 + wc * 32 + 8 * fq;
        f32x4 bb0[2], bb1[2];
#pragma unroll
        for (int bj = 0; bj < 2; ++bj) { const float* bp = bdn + (size_t)e * 1024 + col0 + bj * 128; bb0[bj] = *(const f32x4*)bp; bb1[bj] = *(const f32x4*)(bp + 4); }
#pragma unroll
        for (int bj = 0; bj < 2; ++bj) { const f32x4 b0 = bb0[bj], b1 = bb1[bj];
#pragma unroll
            for (int ai = 0; ai < 2; ++ai)
#pragma unroll
                for (int m = 0; m < 4; ++m) { const int row = row0 + ai * 128 + m * 16; const f32x4 v0 = acc[ai][bj][m][0] * (1.f / 64.f) + b0, v1 = acc[ai][bj][m][1] * (1.f / 64.f) + b1;
                    float o[8];
#pragma unroll
                    for (int i = 0; i < 4; ++i) { o[i] = fminf(fmaxf(v0[i], -48.f), 48.f) * 8.f; o[4 + i] = fminf(fmaxf(v1[i], -48.f), 48.f) * 8.f; }
                    u32x2 w; w.x = cvt_pk_fp8x4(o[0], o[1], o[2], o[3]); w.y = cvt_pk_fp8x4(o[4], o[5], o[6], o[7]);
                    *(u32x2*)(Y + (size_t)row * 1024 + col0 + bj * 128) = w; } }
    }
};

namespace attn_body {
using bf16 = __hip_bfloat16;
using s16x4 = __attribute__((ext_vector_type(4))) short;
constexpr int BATCH = 4, NHEAD = 8, ASEQ = 4096, D = 64, ADM = NHEAD * D;
constexpr int NW = 8, QBLK = 32, QB = QBLK * NW, KVBLK = 64, NQB = ASEQ / QB;
constexpr int OPITCH = 1024;
__device__ __forceinline__ int crow(int r, int hi) { return (r & 3) + 8 * (r >> 2) + 4 * hi; }
#define SBAR() __builtin_amdgcn_sched_barrier(0)
constexpr int NSLOT = 3, SLOTB = 8192;
constexpr int LDS_K = 0, LDS_V = NSLOT * SLOTB, LDS_WS = 2 * NSLOT * SLOTB, LDS_OST = LDS_WS + NW * 64 * 4, LDS_BYTES_A = LDS_OST + NW * 4096;
__device__ __forceinline__ void glds16(const void* gsrc, unsigned lds_dst) { unsigned keep;
  asm volatile("s_mov_b32 %0, m0\n\ts_mov_b32 m0, %2\n\ts_nop 0\n\tglobal_load_lds_dwordx4 %1, off\n\ts_mov_b32 m0, %0" : "=&s"(keep) : "v"(gsrc), "s"(lds_dst) : "memory"); }
__device__ __forceinline__ float max3f(float a, float b, float c) { float r; asm("v_max3_f32 %0, %1, %2, %3" : "=v"(r) : "v"(a), "v"(b), "v"(c)); return r; }
__device__ __forceinline__ float max2f(float a, float b) { float r; asm("v_max_f32_e32 %0, %1, %2" : "=v"(r) : "v"(a), "v"(b)); return r; }
__device__ __forceinline__ float fadd_s(float a, float b) { float r; asm("v_add_f32_e32 %0, %1, %2" : "=v"(r) : "v"(a), "v"(b)); return r; }
__device__ __forceinline__ float fsub_s(float a, float b) { float r; asm("v_sub_f32_e32 %0, %1, %2" : "=v"(r) : "v"(a), "v"(b)); return r; }
typedef float f32x2_t __attribute__((ext_vector_type(2))); typedef __bf16 bf16x2_t __attribute__((ext_vector_type(2)));
__device__ __forceinline__ unsigned cvtpk_s(float lo, float hi) { f32x2_t v = {lo, hi}; bf16x2_t b = __builtin_convertvector(v, bf16x2_t); return __builtin_bit_cast(unsigned, b); }
#define WAIT_BAR(N) asm volatile("s_waitcnt vmcnt(" #N ") lgkmcnt(0)\n\ts_barrier" ::: "memory")
__device__ __forceinline__ void qkt(f32x16& p0, f32x16& p1, const char* Kslot, const bf16x8* qr, const f32x16& negm, int r32, int hi) {
  const char* kb = Kslot + hi * 1024 + r32 * 16;
  #pragma unroll
  for (int d0 = 0; d0 < 4; ++d0) {
    const bf16x8 b0 = *reinterpret_cast<const bf16x8*>(kb + d0 * 2048);
    const bf16x8 b1 = *reinterpret_cast<const bf16x8*>(kb + d0 * 2048 + 512);
    if (d0 == 0) { p0 = __builtin_amdgcn_mfma_f32_32x32x16_bf16(b0, qr[0], negm, 0, 0, 0); p1 = __builtin_amdgcn_mfma_f32_32x32x16_bf16(b1, qr[0], negm, 0, 0, 0); }
    else { p0 = __builtin_amdgcn_mfma_f32_32x32x16_bf16(b0, qr[d0], p0, 0, 0, 0); p1 = __builtin_amdgcn_mfma_f32_32x32x16_bf16(b1, qr[d0], p1, 0, 0, 0); } }
}
typedef __attribute__((address_space(3))) const char* lds_cptr;
typedef short v4i16_t __attribute__((ext_vector_type(4)));
__device__ __forceinline__ void kload8(bf16x8* kf, lds_cptr kp) {
  kf[0] = *(const LAS bf16x8*)(kp);        kf[1] = *(const LAS bf16x8*)(kp + 512);
  kf[2] = *(const LAS bf16x8*)(kp + 2048); kf[3] = *(const LAS bf16x8*)(kp + 2560);
  kf[4] = *(const LAS bf16x8*)(kp + 4096); kf[5] = *(const LAS bf16x8*)(kp + 4608);
  kf[6] = *(const LAS bf16x8*)(kp + 6144); kf[7] = *(const LAS bf16x8*)(kp + 6656);
}
__device__ __forceinline__ void kload2(bf16x8* kf, lds_cptr kp, int j) { kf[2 * j] = *(const LAS bf16x8*)(kp + j * 2048); kf[2 * j + 1] = *(const LAS bf16x8*)(kp + j * 2048 + 512); }
__device__ __forceinline__ s16x4 vtr(lds_cptr p) { return __builtin_bit_cast(s16x4, __builtin_amdgcn_ds_read_tr16_b64_v4i16((LAS v4i16_t*)p)); }
__device__ __forceinline__ float rowmax(const f32x16& p0, const f32x16& p1) {
  float a = max3f(p0[0], p0[1], p1[0]), b = max3f(p0[2], p0[3], p1[1]); a = max3f(a, p1[2], p1[3]);
  #pragma unroll
  for (int r = 4; r < 16; r += 4) { a = max3f(a, p0[r], p0[r + 1]); b = max3f(b, p0[r + 2], p0[r + 3]); a = max3f(a, p1[r], p1[r + 1]); b = max3f(b, p1[r + 2], p1[r + 3]); }
  const float m = max2f(a, b);
  auto rr = __builtin_amdgcn_permlane32_swap(__float_as_uint(m), __float_as_uint(m), false, false);
  return max2f(__uint_as_float(rr[0]), __uint_as_float(rr[1]));
}
__device__ __forceinline__ void pv(f32x16* o, int vb, bf16x8 pa0, bf16x8 pa1, bf16x8 pa2, bf16x8 pa3) {
  #pragma unroll
  for (int d0 = 0; d0 < 2; ++d0) { s16x4 lo[4], hi[4];
    #pragma unroll
    for (int ks = 0; ks < 4; ++ks) {
      asm volatile("ds_read_b64_tr_b16 %0,%1 offset:%c2" : "=&v"(lo[ks]) : "v"(vb), "i"(d0 * 4096 + ks * 1024) : "memory");
      asm volatile("ds_read_b64_tr_b16 %0,%1 offset:%c2" : "=&v"(hi[ks]) : "v"(vb), "i"(d0 * 4096 + ks * 1024 + 512) : "memory"); }
    asm volatile("s_waitcnt lgkmcnt(0)" ::: "memory"); SBAR();
    #define PK(k) (bf16x8){lo[k][0], lo[k][1], lo[k][2], lo[k][3], hi[k][0], hi[k][1], hi[k][2], hi[k][3]}
    o[d0] = __builtin_amdgcn_mfma_f32_32x32x16_bf16(pa0, PK(0), o[d0], 0, 0, 0);
    o[d0] = __builtin_amdgcn_mfma_f32_32x32x16_bf16(pa1, PK(1), o[d0], 0, 0, 0);
    o[d0] = __builtin_amdgcn_mfma_f32_32x32x16_bf16(pa2, PK(2), o[d0], 0, 0, 0);
    o[d0] = __builtin_amdgcn_mfma_f32_32x32x16_bf16(pa3, PK(3), o[d0], 0, 0, 0);
    #undef PK
  }
}
typedef const __attribute__((address_space(4))) unsigned long long* mask_cptr;
#define ATTN_STORE16(p, v) (*(u32x4*)(p) = (v))
template <int THRL> __device__ __forceinline__ void attn_unit(int wid_in, int b, int h, int qb, const bf16* Q, const bf16* __restrict__ K, const bf16* __restrict__ V, bf16* O, const unsigned long long* MT, char* shm) {
  int lane = lane_id(); asm volatile("" : "+v"(lane));
  const int r32 = lane & 31, hi = lane >> 5; const int wid = wid_in; const int tid = wid * 64 + lane; (void)tid;
  const long rowbase = (long)b * ASEQ; const int q0 = qb * QB;
  const bf16* Qw = Q + (rowbase + q0 + wid * QBLK) * ADM + h * D;
  const bf16 *Kh = K + rowbase * ADM + h * D, *Vh = V + rowbase * ADM + h * D;
  const unsigned long long mb_ = (unsigned long long)(MT + (size_t)__builtin_amdgcn_readfirstlane((b * 128 + qb * 8 + wid) * 64) * 32);
  const mask_cptr mbase = (mask_cptr)(((unsigned long long)(unsigned)__builtin_amdgcn_readfirstlane((int)(unsigned)(mb_ >> 32)) << 32) | (unsigned)__builtin_amdgcn_readfirstlane((int)(unsigned)mb_));
  const unsigned lds0 = (unsigned)(uintptr_t)shm;
  float* wsf = (float*)(shm + LDS_WS) + wid * 64;
  const bf16* ksrc = Kh + (long)lane * ADM + wid * 8;
  const bf16* vsrc = Vh + (long)(16 * (wid & 3) + (lane >> 2)) * ADM + (wid >> 2) * 32 + (lane & 3) * 8;
  const unsigned kdst = lds0 + LDS_K + wid * 1024, vdst = lds0 + LDS_V + wid * 1024;
  #define DMA_K(t, slot) glds16(ksrc + (long)(t) * KVBLK * ADM, (unsigned)__builtin_amdgcn_readfirstlane(kdst + (slot)))
  #define DMA_V(t, slot) glds16(vsrc + (long)(t) * KVBLK * ADM, (unsigned)__builtin_amdgcn_readfirstlane(vdst + (slot)))
  const int vb0 = (int)(lds0 + LDS_V) + ((lane >> 4) & 1) * 32 + (lane & 3) * 8 + (4 * hi + ((lane & 15) >> 2)) * 64;
  const char* Kbase = shm + LDS_K; bf16x8 kf[8];
  const lds_cptr shm3 = (lds_cptr)shm; const lds_cptr kp0 = shm3 + LDS_K + hi * 1024 + r32 * 16; const lds_cptr vp0 = shm3 + LDS_V + ((lane >> 4) & 1) * 32 + (lane & 3) * 8 + (4 * hi + ((lane & 15) >> 2)) * 64;
  const int NT = (q0 + QB) / KVBLK;
  DMA_K(0, 0); DMA_V(0, 0); DMA_K(1, SLOTB);
  bf16x8 qr[4];
  #pragma unroll
  for (int d0 = 0; d0 < 4; ++d0) qr[d0] = *reinterpret_cast<const bf16x8*>(&Qw[(long)r32 * ADM + d0 * 16 + hi * 8]);
  float mhat = 0.f, l_reg = 0.f; f32x16 o[2]; o[0] = f32x16{}; o[1] = f32x16{}; f32x16 negm = f32x16{}; asm volatile("" : "+v"(negm));
  float NEGV = -INFINITY; asm volatile("" : "+v"(NEGV));
  typedef unsigned long long u64x8_t __attribute__((ext_vector_type(8)));
  typedef const __attribute__((address_space(4))) u64x8_t* mask8_cptr;
  #define MLOAD(t) const mask8_cptr mp8_ = (mask8_cptr)(mbase + (size_t)(t) * 32); const u64x8_t mk0_ = mp8_[0], mk1_ = mp8_[1], mk2_ = mp8_[2], mk3_ = mp8_[3]
  #define CMASK(P0, P1) do { \
    asm volatile("s_nop 15\n\ts_nop 7" : "+v"(P0), "+v"(P1)); \
    _Pragma("unroll") for (int r_ = 0; r_ < 8; ++r_) { const unsigned long long a_ = mk0_[r_], b_ = mk1_[r_], c_ = mk2_[r_], d_ = mk3_[r_]; \
      asm("v_cndmask_b32_e64 %0, %1, %0, %2" : "+v"(P0[r_]) : "v"(NEGV), "s"(a_)); \
      asm("v_cndmask_b32_e64 %0, %1, %0, %2" : "+v"(P0[8 + r_]) : "v"(NEGV), "s"(b_)); \
      asm("v_cndmask_b32_e64 %0, %1, %0, %2" : "+v"(P1[r_]) : "v"(NEGV), "s"(c_)); \
      asm("v_cndmask_b32_e64 %0, %1, %0, %2" : "+v"(P1[8 + r_]) : "v"(NEGV), "s"(d_)); } } while (0)
  bool resc = false;
  #define START(P0, P1) do { const float rm = rowmax(P0, P1); resc = false; \
    { const float dl = (rm == -INFINITY) ? 0.f : rm; mhat = fadd_s(mhat, dl); \
      _Pragma("unroll") for (int r = 0; r < 16; ++r) { P0[r] = fsub_s(P0[r], dl); P1[r] = fsub_s(P1[r], dl); } \
      _Pragma("unroll") for (int r = 0; r < 16; ++r) negm[r] = -mhat; asm volatile("" : "+v"(negm)); } \
    _Pragma("unroll") for (int r = 0; r < 16; ++r) P0[r] = __builtin_amdgcn_exp2f(P0[r]); } while (0)
  #define RESC() do { if (resc) { asm volatile("s_waitcnt lgkmcnt(0)" ::: "memory"); \
      _Pragma("unroll") for (int d_ = 0; d_ < 2; ++d_) _Pragma("unroll") for (int r = 0; r < 16; ++r) o[d_][r] *= wsf[crow(r, hi)]; } } while (0)
  f32x16 pA0, pA1, pB0, pB1;
  int sl_prev = 0, sl_cur = 0, sl_next = SLOTB;
  #define ROT() do { sl_prev = sl_cur; sl_cur = sl_next; sl_next = (sl_next == (NSLOT - 1) * SLOTB) ? 0 : sl_next + SLOTB; } while (0)
  DMA_K(2, 2 * SLOTB);
  WAIT_BAR(3);
  { MLOAD(0); qkt(pA0, pA1, Kbase, qr, negm, r32, hi); CMASK(pA0, pA1); }
  START(pA0, pA1);
  _Pragma("unroll") for (int r = 0; r < 16; ++r) pA1[r] = __builtin_amdgcn_exp2f(pA1[r]);
  WAIT_BAR(0);
  DMA_K(3, 0); DMA_V(1, SLOTB);
  ROT();
  kload8(kf, kp0 + sl_cur);
  WAIT_BAR(2);
  s16x4 vlo[8], vhi[8]; u32x4 pw0, pw1, pw2, pw3;
  #define PKW(P, B) cvtpk_s(P[B], P[B + 1])
  #define PAF(k) __builtin_bit_cast(bf16x8, pw##k)
  #define VFR(i) (bf16x8){vlo[i][0], vlo[i][1], vlo[i][2], vlo[i][3], vhi[i][0], vhi[i][1], vhi[i][2], vhi[i][3]}
  #define PIN(x) asm volatile("" : "+v"(x))
  #define MX3(a, b, c) __builtin_fmaxf(__builtin_fmaxf((a), (b)), (c))
  #define GAPA(MF, A0, A1, A2, A3, W0, W1, PW) do { MF; sacc += A0; sacc += A1; sacc += A2; sacc += A3; PIN(sacc); W0; W1; PIN(PW); SBAR(); } while (0)
  #define EX(v) __builtin_amdgcn_exp2f(v)
  #define GAPB(MF, X, B) do { MF; X[B] = EX(X[B]); X[B + 1] = EX(X[B + 1]); X[B + 2] = EX(X[B + 2]); X[B + 3] = EX(X[B + 3]); PIN(X); SBAR(); } while (0)
  #define VRD(i) do { vlo[i] = vtr(vp_ + (((i) >> 2) * 4096 + ((i) & 3) * 1024)); vhi[i] = vtr(vp_ + (((i) >> 2) * 4096 + ((i) & 3) * 1024 + 512)); } while (0)
  #define KRD(G, j) do { if (G) { kload2(kf, kp0 + sl_next, j); SBAR(); } } while (0)
  #define STEP(C0, C1, P0, P1, t, GK, GV, GL) do { MLOAD(t); SBAR(); \
    const lds_cptr vp_ = vp0 + sl_prev; \
    VRD(0); SBAR(); float sacc = (P0[0] + P0[1]); \
    GAPA(C0 = __builtin_amdgcn_mfma_f32_32x32x16_bf16(kf[0], qr[0], negm, 0, 0, 0), P0[2], P0[3], P0[4], P0[5],     pw0[0] = PKW(P0, 0), pw0[1] = PKW(P0, 2), pw0); \
    VRD(4); SBAR(); GAPA(C1 = __builtin_amdgcn_mfma_f32_32x32x16_bf16(kf[1], qr[0], negm, 0, 0, 0), P0[6], P0[7], P0[8], P0[9],     pw0[2] = PKW(P0, 4), pw0[3] = PKW(P0, 6), pw0); \
    VRD(1); SBAR(); GAPA(C0 = __builtin_amdgcn_mfma_f32_32x32x16_bf16(kf[2], qr[1], C0, 0, 0, 0),   P0[10], P0[11], P0[12], P0[13], pw1[0] = PKW(P0, 8), pw1[1] = PKW(P0, 10), pw1); \
    VRD(5); SBAR(); GAPA(C1 = __builtin_amdgcn_mfma_f32_32x32x16_bf16(kf[3], qr[1], C1, 0, 0, 0),   P0[14], P0[15], P1[0], P1[1],   pw1[2] = PKW(P0, 12), pw1[3] = PKW(P0, 14), pw1); \
    VRD(2); SBAR(); GAPA(C0 = __builtin_amdgcn_mfma_f32_32x32x16_bf16(kf[4], qr[2], C0, 0, 0, 0),   P1[2], P1[3], P1[4], P1[5],     pw2[0] = PKW(P1, 0), pw2[1] = PKW(P1, 2), pw2); \
    VRD(6); SBAR(); GAPA(C1 = __builtin_amdgcn_mfma_f32_32x32x16_bf16(kf[5], qr[2], C1, 0, 0, 0),   P1[6], P1[7], P1[8], P1[9],     pw2[2] = PKW(P1, 4), pw2[3] = PKW(P1, 6), pw2); \
    VRD(3); SBAR(); GAPA(C0 = __builtin_amdgcn_mfma_f32_32x32x16_bf16(kf[6], qr[3], C0, 0, 0, 0),   P1[10], P1[11], P1[12], P1[13], pw3[0] = PKW(P1, 8), pw3[1] = PKW(P1, 10), pw3); \
    VRD(7); SBAR(); GAPA(C1 = __builtin_amdgcn_mfma_f32_32x32x16_bf16(kf[7], qr[3], C1, 0, 0, 0),   P1[14], P1[15], 0.f, 0.f,       pw3[2] = PKW(P1, 12), pw3[3] = PKW(P1, 14), pw3); \
    l_reg += sacc; \
    if (GK) { DMA_K((t) + 3, sl_cur); } if (GV) { DMA_V((t) + 1, sl_next); } \
    CMASK(C0, C1); \
    { float a = MX3(C0[0], C0[1], C1[0]), b = MX3(C0[2], C0[3], C1[1]); a = MX3(a, C1[2], C1[3]); \
      _Pragma("unroll") for (int r = 4; r < 16; r += 4) { a = MX3(a, C0[r], C0[r + 1]); b = MX3(b, C0[r + 2], C0[r + 3]); a = MX3(a, C1[r], C1[r + 1]); b = MX3(b, C1[r + 2], C1[r + 3]); } \
      float rm = __builtin_fmaxf(a, b); { auto rr = __builtin_amdgcn_permlane32_swap(__float_as_uint(rm), __float_as_uint(rm), false, false); rm = __builtin_fmaxf(__uint_as_float(rr[0]), __uint_as_float(rr[1])); } \
      resc = false; \
      if (__builtin_expect(__any(rm > (float)THRL), 0)) { const float dl = __builtin_fmaxf(rm, 0.f); mhat += dl; \
        _Pragma("unroll") for (int r = 0; r < 16; ++r) { C0[r] -= dl; C1[r] -= dl; } \
        _Pragma("unroll") for (int r = 0; r < 16; ++r) negm[r] = -mhat; asm volatile("" : "+v"(negm)); \
        const float f = __builtin_amdgcn_exp2f(-dl); l_reg *= f; if (hi == 0) wsf[r32] = f; resc = true; } } \
    SBAR(); \
    GAPB(o[0] = __builtin_amdgcn_mfma_f32_32x32x16_bf16(PAF(0), VFR(0), o[0], 0, 0, 0), C0, 0); \
    GAPB(o[1] = __builtin_amdgcn_mfma_f32_32x32x16_bf16(PAF(0), VFR(4), o[1], 0, 0, 0), C0, 4); \
    KRD(GL, 0); GAPB(o[0] = __builtin_amdgcn_mfma_f32_32x32x16_bf16(PAF(1), VFR(1), o[0], 0, 0, 0), C0, 8); \
    KRD(GL, 1); GAPB(o[1] = __builtin_amdgcn_mfma_f32_32x32x16_bf16(PAF(1), VFR(5), o[1], 0, 0, 0), C0, 12); \
    KRD(GL, 2); GAPB(o[0] = __builtin_amdgcn_mfma_f32_32x32x16_bf16(PAF(2), VFR(2), o[0], 0, 0, 0), C1, 0); \
    KRD(GL, 3); GAPB(o[1] = __builtin_amdgcn_mfma_f32_32x32x16_bf16(PAF(2), VFR(6), o[1], 0, 0, 0), C1, 4); \
    GAPB(o[0] = __builtin_amdgcn_mfma_f32_32x32x16_bf16(PAF(3), VFR(3), o[0], 0, 0, 0), C1, 8); \
    GAPB(o[1] = __builtin_amdgcn_mfma_f32_32x32x16_bf16(PAF(3), VFR(7), o[1], 0, 0, 0), C1, 12); \
    } while (0)
  int t = 1;
  for (; t + 5 < NT; t += 2) {
    STEP(pB0, pB1, pA0, pA1, t, true, true, true);     WAIT_BAR(2); RESC(); ROT();
    STEP(pA0, pA1, pB0, pB1, t + 1, true, true, true); WAIT_BAR(2); RESC(); ROT();
  }
  #define ENDW(tt) do { if ((tt) + 3 < NT) { WAIT_BAR(2); } else if ((tt) + 2 < NT) { WAIT_BAR(1); } else { WAIT_BAR(0); } } while (0)
  for (; t + 1 < NT; t += 2) {
    STEP(pB0, pB1, pA0, pA1, t, (t + 3 < NT), (t + 1 < NT), (t + 1 < NT));         ENDW(t);     RESC(); ROT();
    STEP(pA0, pA1, pB0, pB1, t + 1, (t + 4 < NT), (t + 2 < NT), (t + 2 < NT));     ENDW(t + 1); RESC(); ROT();
  }
  STEP(pB0, pB1, pA0, pA1, NT - 1, false, false, false); RESC();
  { float sacc = pB0[0] + pB0[1]; _Pragma("unroll") for (int r = 2; r < 16; ++r) sacc += pB0[r]; _Pragma("unroll") for (int r = 0; r < 16; ++r) sacc += pB1[r]; l_reg += sacc;
    pw0 = (u32x4){PKW(pB0, 0), PKW(pB0, 2), PKW(pB0, 4), PKW(pB0, 6)}; pw1 = (u32x4){PKW(pB0, 8), PKW(pB0, 10), PKW(pB0, 12), PKW(pB0, 14)}; pw2 = (u32x4){PKW(pB1, 0), PKW(pB1, 2), PKW(pB1, 4), PKW(pB1, 6)}; pw3 = (u32x4){PKW(pB1, 8), PKW(pB1, 10), PKW(pB1, 12), PKW(pB1, 14)};
    SBAR(); pv(o, vb0 + sl_cur, PAF(0), PAF(1), PAF(2), PAF(3)); }
  #undef PKW
  #undef PAF
  #undef VFR
  #undef PIN
  #undef MX3
  #undef GAPA
  #undef GAPB
  #undef EX
  #undef VRD
  #undef KRD
  #undef STEP
  #undef ENDW
  { auto rr = __builtin_amdgcn_permlane32_swap(__float_as_uint(l_reg), __float_as_uint(l_reg), false, false); l_reg = __uint_as_float(rr[0]) + __uint_as_float(rr[1]); }
  if (hi == 0) wsf[32 + r32] = l_reg; asm volatile("s_waitcnt lgkmcnt(0)" ::: "memory");
  float rli[16];
  #pragma unroll
  for (int r = 0; r < 16; ++r) rli[r] = __builtin_amdgcn_rcpf(wsf[32 + crow(r, hi)]);
  bf16* Ow = O + (rowbase + q0 + wid * QBLK) * OPITCH + h * D;
  { bf16* stg = (bf16*)(shm + LDS_OST) + wid * 2048;
    #pragma unroll
    for (int r = 0; r < 16; ++r) { const int orow = crow(r, hi);
      #pragma unroll
      for (int d0 = 0; d0 < 2; ++d0) stg[orow * 64 + d0 * 32 + r32] = __float2bfloat16(o[d0][r] * rli[r]); }
    asm volatile("s_waitcnt lgkmcnt(0)" ::: "memory");
    #pragma unroll
    for (int i = 0; i < 4; ++i) { const int row = i * 8 + (lane >> 3), ch = lane & 7; const u32x4 v = *(const u32x4*)(stg + row * 64 + ch * 8); ATTN_STORE16(Ow + (long)row * OPITCH + ch * 8, v); } }
  asm volatile("s_waitcnt lgkmcnt(0)\n\ts_barrier" ::: "memory");
  #undef DMA_K
  #undef DMA_V
  #undef CMASK
  #undef START
  #undef RESC
  #undef ROT
}
#undef SBAR
#undef WAIT_BAR
}

#define XB_TMO      128
#define XB_XCNT(j)  (256  + 64 * (j))
#define XB_XSUB(j)  (1280 + 64 * (j))
#define XB_XGEN(j)  (2304 + 64 * (j))
#define XB_TOP      3328
#define XB_TOPGEN   3392
#define XCD_BAR_WORDS 3456
#define XB_SPIN_CAP (1u << 18)
__device__ __forceinline__ unsigned xb_ld(unsigned* p)              { return __hip_atomic_load(p, __ATOMIC_RELAXED, __HIP_MEMORY_SCOPE_AGENT); }
__device__ __forceinline__ unsigned xb_add(unsigned* p, unsigned v) { return __hip_atomic_fetch_add(p, v, __ATOMIC_RELAXED, __HIP_MEMORY_SCOPE_AGENT); }
__device__ __forceinline__ unsigned xb_xcc_id() { return (unsigned)__builtin_amdgcn_s_getreg((3 << 11) | 20) & 0xFu; }
#define XB_SPIN(cond, bar) do { unsigned _sp = 0; while (cond) { __builtin_amdgcn_s_sleep(1); \
    if ((++_sp & 255u) == 0u) { if (xb_ld(&(bar)[XB_TMO])) break; if (_sp > XB_SPIN_CAP) { atomicAdd(&(bar)[XB_TMO], 1u); break; } } } } while (0)
struct XcdBarrier { unsigned* bar; unsigned x; volatile LAS unsigned* st; };
__device__ __forceinline__ XcdBarrier xcd_barrier_post(unsigned* bar, volatile LAS unsigned* st, bool leader) {
    XcdBarrier b; b.bar = bar; b.x = xb_xcc_id(); b.st = st;
    if (leader) st[2] = xb_add(&bar[XB_XCNT(b.x)], 1u);
    return b;
}
__device__ __forceinline__ void xcd_barrier_complete(unsigned* bar, unsigned x, unsigned& nloc, unsigned& nx) {
    const unsigned G = gridDim.x * gridDim.y * gridDim.z;
    unsigned sum, cnt, mine, sp = 0u;
    for (;;) {
        sum = 0u; cnt = 0u; mine = 0u;
#pragma unroll
        for (unsigned j = 0; j < 16; ++j) { const unsigned c = xb_ld(&bar[XB_XCNT(j)]); sum += c; cnt += (c > 0u) ? 1u : 0u; mine = (j == x) ? c : mine; }
        if (sum == G) break;
        __builtin_amdgcn_s_sleep(1);
        if ((++sp & 255u) == 0u) { if (xb_ld(&bar[XB_TMO])) break; if (sp > XB_SPIN_CAP) { atomicAdd(&bar[XB_TMO], 1u); break; } }
    }
    nloc = mine > 0u ? mine : 1u; nx = cnt > 0u ? cnt : 1u;
}
__device__ __forceinline__ void xcd_barrier(const XcdBarrier& b, bool leader) {
    asm volatile("s_waitcnt vmcnt(0)" ::: "memory");
    __syncthreads();
    if (leader) {
        unsigned* bar = b.bar;
        __builtin_amdgcn_s_waitcnt(0);
        unsigned nloc = b.st[0], nx = b.st[1];
        if (nloc == 0u) { xcd_barrier_complete(bar, b.x, nloc, nx); b.st[0] = nloc; b.st[1] = nx; }
#ifdef DBG_WG_RELEASE
        __builtin_amdgcn_fence(__ATOMIC_RELEASE, "agent"); asm volatile("s_waitcnt vmcnt(0)" ::: "memory");
#endif
        const unsigned old = xb_add(&bar[XB_XSUB(b.x)], 1u);
        const unsigned gen = old / nloc;
        if (old + 1u == (gen + 1u) * nloc) {
            __builtin_amdgcn_fence(__ATOMIC_RELEASE, "agent");
            asm volatile("s_waitcnt vmcnt(0)" ::: "memory");
            const unsigned og = xb_add(&bar[XB_TOP], 1u);
            const unsigned tg = og / nx;
            if (og + 1u == (tg + 1u) * nx) xb_add(&bar[XB_TOPGEN], 1u);
            else XB_SPIN(xb_ld(&bar[XB_TOPGEN]) == tg, bar);
            __builtin_amdgcn_fence(__ATOMIC_ACQUIRE, "agent");
            xb_add(&bar[XB_XGEN(b.x)], 1u);
            asm volatile("s_waitcnt vmcnt(0)" ::: "memory");
        } else {
            XB_SPIN(xb_ld(&bar[XB_XGEN(b.x)]) == gen, bar);
            __builtin_amdgcn_fence(__ATOMIC_ACQUIRE, "agent");
            asm volatile("s_waitcnt vmcnt(0)" ::: "memory");
        }
    }
    __syncthreads();
}

struct Frame {
    LAS unsigned char* lds; volatile LAS unsigned* MISC; unsigned* ctl; unsigned char* ws;
    int tid, lane, wave, vcu, G;
    const float* const __attribute__((address_space(4)))* in; float* out;
};
constexpr int NWAVES = 8;

__device__ __forceinline__ void transpose_item(const float* W, int ldw, bf16_t* WT, int K, LAS float* scr, int k0, int n0, int src, int lane, int dk0 = 0) {
    float v[32];
    const float* wp = W + (size_t)(k0 + (lane >> 5)) * ldw + (src >= 0 ? src : 0);
#pragma unroll
    for (int i = 0; i < 32; ++i) v[i] = wp[(size_t)(2 * i) * ldw];
#pragma unroll
    for (int i = 0; i < 32; ++i) { const int kk = 2 * i + (lane >> 5); scr[kk * 33 + (lane & 31)] = (src >= 0) ? v[i] : 0.f; }
    LDS_WAIT(); asm volatile("" ::: "memory");
    const int c = lane & 7;
#pragma unroll
    for (int j = 0; j < 4; ++j) { const int n = (lane >> 3) + 8 * j; const LAS float* s = scr + (8 * c) * 33 + n;
        u32x4 o; o.x = cvt_pk_bf16(s[0 * 33], s[1 * 33]); o.y = cvt_pk_bf16(s[2 * 33], s[3 * 33]); o.z = cvt_pk_bf16(s[4 * 33], s[5 * 33]); o.w = cvt_pk_bf16(s[6 * 33], s[7 * 33]);
        *(u32x4*)(WT + (size_t)(n0 + n) * K + dk0 + k0 + 8 * c) = o; }
    LDS_WAIT(); asm volatile("" ::: "memory");
}
__device__ __forceinline__ void transpose_item8(const float* W, int ldw, unsigned char* WT, int K, LAS float* scr, int k0, int n0, int src, int lane) {
    float v[32];
    const float* wp = W + (size_t)(k0 + (lane >> 5)) * ldw + (src >= 0 ? src : 0);
#pragma unroll
    for (int i = 0; i < 32; ++i) v[i] = wp[(size_t)(2 * i) * ldw];
#pragma unroll
    for (int i = 0; i < 32; ++i) { const int kk = 2 * i + (lane >> 5); scr[kk * 33 + (lane & 31)] = (src >= 0) ? v[i] * 64.f : 0.f; }
    LDS_WAIT(); asm volatile("" ::: "memory");
    const int c = lane & 3;
#pragma unroll
    for (int j = 0; j < 2; ++j) { const int n = (lane >> 2) + 16 * j; const LAS float* s = scr + (16 * c) * 33 + n;
        u32x4 o;
#pragma unroll
        for (int d = 0; d < 4; ++d) o[d] = cvt_pk_fp8x4(s[(4 * d) * 33], s[(4 * d + 1) * 33], s[(4 * d + 2) * 33], s[(4 * d + 3) * 33]);
        *(u32x4*)(WT + (size_t)(n0 + n) * K + k0 + 16 * c) = o; }
    LDS_WAIT(); asm volatile("" ::: "memory");
}
__device__ __forceinline__ int rope_perm(int p) { return (p < 16) ? ((p >> 1) + 8 * (p & 1)) : p; }
__device__ __forceinline__ int w1_src(int n) {
    if (n < 2048) { const int seg = n >> 9, o = n & 511, h = o >> 6; int p = o & 63; if (seg != 2) p = rope_perm(p); return seg * 512 + h * 64 + p; }
    if (n < 2304) return 2120 + (n - 2048);
    if (n < 2560) return 2376 + (n - 2304);
    const int o = n - 2560;
    if (o < 64) return 2048 + rope_perm(o);
    if (o < 72) return 2112 + (o - 64);
    return -1;
}
struct ConvItem { const float* wp; int ldw; unsigned char* op8; unsigned ldoff, stoff; };
constexpr int I_UP = 32 * 8 * 128, I_DN = 32 * 8 * 64, NCONV = I_UP + I_DN;
__device__ __forceinline__ ConvItem conv_expert_decode(Frame& F, int r_in, int lane) {
    const int r0 = __builtin_amdgcn_readfirstlane(r_in); const int h = lane >> 4, n = lane & 15; ConvItem c;
    if (r0 < I_UP) { const int e = r0 >> 10, q = r0 & 1023, kb = q >> 7, nb = q & 127, nn0 = nb * 16, tile = nn0 >> 8, o0 = nn0 & 255;
        const int src0 = (o0 < 128) ? tile * 128 + o0 : 1024 + tile * 128 + (o0 - 128);
        c.ldw = 2048; c.wp = F.in[17] + (size_t)e * 1024 * 2048 + (size_t)(kb * 128) * 2048 + src0;
        c.op8 = (unsigned char*)(F.ws + WS_WUP) + (size_t)e * 2048 * 1024 + (size_t)(nb * 16) * 1024 + kb * 128; }
    else { const int r = r0 - I_UP, e = r >> 9, q = r & 511, kb = q >> 6, nb = q & 63;
        c.ldw = 1024; c.wp = F.in[19] + (size_t)e * 1024 * 1024 + (size_t)(kb * 128) * 1024 + nb * 16;
        c.op8 = (unsigned char*)(F.ws + WS_WDN) + (size_t)e * 1024 * 1024 + (size_t)(nb * 16) * 1024 + kb * 128; }
    c.ldoff = (unsigned)(32 * h * c.ldw + n); c.stoff = (unsigned)(n * 1024 + 32 * h);
    return c;
}
__device__ __forceinline__ void conv_load(const ConvItem& c, float (&v)[32], int lane) {
#pragma unroll
    for (int i = 0; i < 32; ++i) { const float* rowp = c.wp + (size_t)(i * c.ldw); v[i] = rowp[c.ldoff]; }
}
__device__ __forceinline__ void conv_store(const ConvItem& c, const float (&v)[32], int lane) {
    u32x4 o0, o1;
#pragma unroll
    for (int d = 0; d < 4; ++d) { o0[d] = cvt_pk_fp8x4(v[4 * d] * 64.f, v[4 * d + 1] * 64.f, v[4 * d + 2] * 64.f, v[4 * d + 3] * 64.f);
                                  o1[d] = cvt_pk_fp8x4(v[16 + 4 * d] * 64.f, v[17 + 4 * d] * 64.f, v[18 + 4 * d] * 64.f, v[19 + 4 * d] * 64.f); }
    unsigned char* op = c.op8 + c.stoff;
    *(u32x4*)op = o0; *(u32x4*)(op + 16) = o1;
}
__device__ __forceinline__ void conv_expert_items3(Frame& F, int cid0, int stride, int lane) {
    float v0[32], v1[32], v2[32]; ConvItem c0, c1, c2;
    const bool h0 = cid0 < NCONV, h1 = cid0 + stride < NCONV, h2 = cid0 + 2 * stride < NCONV;
    if (h0) { c0 = conv_expert_decode(F, cid0, lane); conv_load(c0, v0, lane); }
    if (h1) { c1 = conv_expert_decode(F, cid0 + stride, lane); conv_load(c1, v1, lane); }
    if (h2) { c2 = conv_expert_decode(F, cid0 + 2 * stride, lane); conv_load(c2, v2, lane); }
    if (h0) conv_store(c0, v0, lane);
    if (h1) conv_store(c1, v1, lane);
    if (h2) conv_store(c2, v2, lane);
}
__device__ __forceinline__ void rms_row_to_fp8(const float* xrow, const float* g, unsigned char* orow, int lane, bf16_t* orow16 = nullptr) {
    const f32x4* xr = (const f32x4*)xrow + lane; const f32x4* gr = (const f32x4*)g + lane;
    f32x4 v[4]; float s = 0.f;
#pragma unroll
    for (int j = 0; j < 4; ++j) { v[j] = xr[64 * j]; s += (v[j].x * v[j].x + v[j].y * v[j].y) + (v[j].z * v[j].z + v[j].w * v[j].w); }
    const float rstd = 1.f / sqrtf(wave_sum(s) * (1.f / 1024.f) + EPS);
    unsigned* o4 = (unsigned*)orow + lane;
#pragma unroll
    for (int j = 0; j < 4; ++j) { const f32x4 gg = gr[64 * j]; const float a = v[j].x * rstd * gg.x, b = v[j].y * rstd * gg.y, c = v[j].z * rstd * gg.z, d = v[j].w * rstd * gg.w;
        o4[64 * j] = cvt_pk_fp8x4(a, b, c, d);
        if (orow16) { u32x2 w; w.x = cvt_pk_bf16(a, b); w.y = cvt_pk_bf16(c, d); ((u32x2*)orow16 + lane)[64 * j] = w; } }
}
__device__ __forceinline__ void rms_row_to_bf16(const float* xrow, const float* g, bf16_t* orow, int lane) {
    const f32x4* xr = (const f32x4*)xrow + lane; const f32x4* gr = (const f32x4*)g + lane;
    f32x4 v[4]; float s = 0.f;
#pragma unroll
    for (int j = 0; j < 4; ++j) { v[j] = xr[64 * j]; s += (v[j].x * v[j].x + v[j].y * v[j].y) + (v[j].z * v[j].z + v[j].w * v[j].w); }
    const float rstd = 1.f / sqrtf(wave_sum(s) * (1.f / 1024.f) + EPS);
    u32x2* o8 = (u32x2*)orow + lane;
#pragma unroll
    for (int j = 0; j < 4; ++j) { const f32x4 gg = gr[64 * j]; u32x2 w; w.x = cvt_pk_bf16(v[j].x * rstd * gg.x, v[j].y * rstd * gg.y); w.y = cvt_pk_bf16(v[j].z * rstd * gg.z, v[j].w * rstd * gg.w); o8[64 * j] = w; }
}
__device__ __forceinline__ void p0_prologue(Frame& F) {
    LAS float* scr = (LAS float*)(F.lds + F.wave * 16384);
    const int gw = F.vcu * NWAVES + F.wave, NGW = F.G * NWAVES, lane = F.lane;
    unsigned char* ws = F.ws;
    constexpr int I_IN = 16 * 88, I_GT = 16 * 96, I_PA = 8 * 32, I_PP = 4 * 32, I_PM = 4 * 32, I_OUT = 16 * 32, I_KV = 16 * 16, I_WU = 16 * 8;
    constexpr int NITEMS = I_UP + I_DN + I_IN + I_GT + I_PA + I_PP + I_PM + I_OUT + I_KV + I_WU;
    for (int it = gw + I_UP + I_DN; it < NITEMS; it += NGW) {
        int r = it;
        if (r < I_UP) { const int e = r >> 10, q = r & 1023, kb = q >> 6, nb = q & 63, n = nb * 32 + (lane & 31), tile = n >> 8, o = n & 255;
            const int src = (o < 128) ? tile * 128 + o : 1024 + tile * 128 + (o - 128);
            transpose_item(F.in[17] + (size_t)e * 1024 * 2048, 2048, (bf16_t*)(ws + WS_WUP) + (size_t)e * 2048 * 1024, 1024, scr, kb * 64, nb * 32, src, lane); continue; } r -= I_UP;
        if (r < I_DN) { const int e = r >> 9, q = r & 511, kb = q >> 5, nb = q & 31;
            transpose_item(F.in[19] + (size_t)e * 1024 * 1024, 1024, (bf16_t*)(ws + WS_WDN) + (size_t)e * 1024 * 1024, 1024, scr, kb * 64, nb * 32, nb * 32 + (lane & 31), lane); continue; } r -= I_DN;
        if (r < I_IN) { const int kb = r / 88, nb = r % 88;
            transpose_item8(F.in[3], 2632, (unsigned char*)(ws + WS_W1T), 1024, scr, kb * 64, nb * 32, w1_src(nb * 32 + (lane & 31)), lane); continue; } r -= I_IN;
        if (r < I_GT) { const int kb = r / 96, nb = r % 96;
            transpose_item8(F.in[4], 3072, (unsigned char*)(ws + WS_W1T) + (size_t)N1_IN * 1024, 1024, scr, kb * 64, nb * 32, nb * 32 + (lane & 31), lane); continue; } r -= I_GT;
        if (r < I_PA) { const int kb = r >> 5, nb = r & 31;
            transpose_item(F.in[6], 1024, (bf16_t*)(ws + WS_WCAT), 1024, scr, kb * 64, nb * 32, nb * 32 + (lane & 31), lane, 0); continue; } r -= I_PA;
        if (r < I_PP) { const int kb = r >> 5, nb = r & 31;
            transpose_item(F.in[7], 1024, (bf16_t*)(ws + WS_WCAT), 1024, scr, kb * 64, nb * 32, nb * 32 + (lane & 31), lane, 512); continue; } r -= I_PP;
        if (r < I_PM) { const int kb = r >> 5, nb = r & 31;
            transpose_item(F.in[8], 1024, (bf16_t*)(ws + WS_WCAT), 1024, scr, kb * 64, nb * 32, nb * 32 + (lane & 31), lane, 768); continue; } r -= I_PM;
        if (r < I_OUT) { const int kb = r >> 5, nb = r & 31;
            transpose_item(F.in[13], 1024, (bf16_t*)(ws + WS_WOUT), 1024, scr, kb * 64, nb * 32, nb * 32 + (lane & 31), lane); continue; } r -= I_OUT;
        if (r < I_KV) { const int kb = r >> 4, nb = r & 15;
            transpose_item8(F.in[12], 512, (unsigned char*)(ws + WS_WKV), 1024, scr, kb * 64, nb * 32, nb * 32 + (lane & 31), lane); continue; } r -= I_KV;
        { const int kb = r >> 3, nb = r & 7;
            transpose_item(F.in[3], 2632, (bf16_t*)(ws + WS_WU), 1024, scr, kb * 64, nb * 32, 2120 + nb * 32 + (lane & 31), lane); }
    }
    for (int m = gw; m < NTOK; m += NGW) rms_row_to_fp8(F.in[0] + (size_t)m * 1024, F.in[2], (unsigned char*)(ws + WS_XN) + (size_t)m * 1024, lane, (bf16_t*)(ws + WS_XNB) + (size_t)m * 1024);
    for (int m = gw; m < NB * 256; m += NGW) rms_row_to_fp8(F.in[1] + (size_t)m * 1024, F.in[11], (unsigned char*)(ws + WS_MEMN) + (size_t)m * 1024, lane);
    const int gt = gw * 64 + lane, NGT = NGW * 64;
    for (int i = gt; i < SEQ * 8; i += NGT) { const int pos = i >> 3, j = i & 7; const float inv = powf(500000.0f, -(float)j / 8.0f); const float ang = (float)pos * inv; float s, c; sincosf(ang, &s, &c);
        ((f32x2*)(ws + WS_ROPE))[i] = (f32x2){c, s}; }
    for (int i = gt; i < 4 * 64 * 64; i += NGT) { const int g = i >> 12, d = (i >> 6) & 63, c = i & 63;
        ((bf16_t*)(ws + WS_WGT))[i] = (bf16_t)(cvt_pk_bf16(F.in[9][(g * 64 + c) * 64 + d], 0.f) & 0xffffu); }
    for (int i = gt; i < 32 * 1024; i += NGT) { const int e = i >> 10, k = i & 1023; const float w = F.in[14][k] * F.in[15][k * 32 + e];
        const unsigned hb = cvt_pk_bf16(w, 0.f) & 0xffffu; const float lo = w - bf2f((unsigned short)hb);
        ((bf16_t*)(ws + WS_WRH))[i] = (bf16_t)hb; ((bf16_t*)(ws + WS_WRL))[i] = (bf16_t)(cvt_pk_bf16(lo, 0.f) & 0xffffu); }
}

__device__ __forceinline__ void p1_memkv(Frame& F) {
    const unsigned char* MEMN = (const unsigned char*)(F.ws + WS_MEMN); const unsigned char* WKV = (const unsigned char*)(F.ws + WS_WKV);
    bf16_t* KM = (bf16_t*)(F.ws + WS_KM); bf16_t* VMT = (bf16_t*)(F.ws + WS_VMT);
    const int lane = F.lane, fr = lane & 15, fq = lane >> 4;
    for (int tw = F.vcu * NWAVES + F.wave; tw < 64 * 32; tw += F.G * NWAVES) {
        const int mr = tw >> 5, nc = tw & 31;
        const unsigned char* ap = MEMN + (size_t)(16 * mr + fr) * 1024 + 32 * fq; const unsigned char* bp = WKV + (size_t)(16 * nc + fr) * 1024 + 32 * fq;
        pg8::v8i_t av[8], bv[8];
#pragma unroll
        for (int ks = 0; ks < 8; ++ks) { av[ks] = *(const pg8::v8i_t*)(ap + 128 * ks); bv[ks] = *(const pg8::v8i_t*)(bp + 128 * ks); }
        f32x4 acc = (f32x4){0.f, 0.f, 0.f, 0.f};
#pragma unroll
        for (int ks = 0; ks < 8; ++ks) acc = __builtin_amdgcn_mfma_scale_f32_16x16x128_f8f6f4(bv[ks], av[ks], acc, 0, 0, 0, 0, 0, 0);
        const int row = 16 * mr + fr, col = 16 * nc + 4 * fq; const float sc = 1.f / 64.f;
        if (col < 256) { u32x2 w; w.x = cvt_pk_bf16(acc[0] * sc, acc[1] * sc); w.y = cvt_pk_bf16(acc[2] * sc, acc[3] * sc); *(u32x2*)(KM + (size_t)row * 256 + col) = w; }
        else { const int b = row >> 8, key = row & 255;
#pragma unroll
            for (int i = 0; i < 4; ++i) { const int c = col - 256 + i, hm = c >> 6, d = c & 63; VMT[((size_t)(b * 4 + hm) * 64 + d) * 256 + key] = (bf16_t)(cvt_pk_bf16(acc[i] * sc, 0.f) & 0xffffu); } }
    }
}

constexpr int SCS = 4128;
constexpr int SEL_MW_OFF = 16 * SCS * 2;
__device__ __forceinline__ float relu_i(float x) { const int b = __builtin_bit_cast(int, x); return __builtin_bit_cast(float, b > 0 ? b : 0); }
__device__ __forceinline__ unsigned sortable16(unsigned h) { return (h & 0x8000u) ? (~h & 0xffffu) : (h | 0x8000u); }
#define SEQ64(M) M(0) M(1) M(2) M(3) M(4) M(5) M(6) M(7) M(8) M(9) M(10) M(11) M(12) M(13) M(14) M(15) M(16) M(17) M(18) M(19) M(20) M(21) M(22) M(23) M(24) M(25) M(26) M(27) M(28) M(29) M(30) M(31) M(32) M(33) M(34) M(35) M(36) M(37) M(38) M(39) M(40) M(41) M(42) M(43) M(44) M(45) M(46) M(47) M(48) M(49) M(50) M(51) M(52) M(53) M(54) M(55) M(56) M(57) M(58) M(59) M(60) M(61) M(62) M(63)
#define SEQ32(M) M(0) M(1) M(2) M(3) M(4) M(5) M(6) M(7) M(8) M(9) M(10) M(11) M(12) M(13) M(14) M(15) M(16) M(17) M(18) M(19) M(20) M(21) M(22) M(23) M(24) M(25) M(26) M(27) M(28) M(29) M(30) M(31)
#define WLANE(dst, val, L) asm("s_nop 1\n\tv_writelane_b32 %0, %1, " #L : "+v"(dst) : "s"(val))
#define SEL_CNT8(cnt, cand, K, o) asm volatile( \
    "s_nop 1\n\tv_cmp_ge_u32_e64 s[36:37], %1, %9\n\tv_cmp_ge_u32_e64 s[38:39], %2, %9\n\tv_cmp_ge_u32_e64 s[40:41], %3, %9\n\tv_cmp_ge_u32_e64 s[42:43], %4, %9\n\t" \
    "v_cmp_ge_u32_e64 s[44:45], %5, %9\n\tv_cmp_ge_u32_e64 s[46:47], %6, %9\n\tv_cmp_ge_u32_e64 s[48:49], %7, %9\n\tv_cmp_ge_u32_e64 s[50:51], %8, %9\n\t" \
    "s_bcnt1_i32_b64 s36, s[36:37]\n\ts_bcnt1_i32_b64 s38, s[38:39]\n\ts_bcnt1_i32_b64 s40, s[40:41]\n\ts_bcnt1_i32_b64 s42, s[42:43]\n\t" \
    "s_bcnt1_i32_b64 s44, s[44:45]\n\ts_bcnt1_i32_b64 s46, s[46:47]\n\ts_bcnt1_i32_b64 s48, s[48:49]\n\ts_bcnt1_i32_b64 s50, s[50:51]\n\t" \
    "s_add_i32 s36, s36, s38\n\ts_add_i32 s40, s40, s42\n\ts_add_i32 s44, s44, s46\n\ts_add_i32 s48, s48, s50\n\t" \
    "s_add_i32 s36, s36, s40\n\ts_add_i32 s44, s44, s48\n\ts_add_i32 s36, s36, s44\n\ts_add_i32 %0, %0, s36" \
    : "+s"(cnt) : "v"(K[o]), "v"(K[o + 1]), "v"(K[o + 2]), "v"(K[o + 3]), "v"(K[o + 4]), "v"(K[o + 5]), "v"(K[o + 6]), "v"(K[o + 7]), "s"(cand) \
    : "s36", "s37", "s38", "s39", "s40", "s41", "s42", "s43", "s44", "s45", "s46", "s47", "s48", "s49", "s50", "s51", "scc")
template <bool CONV = true> __device__ __forceinline__ void p2_select(Frame& F) {
    LAS unsigned short* SC = (LAS unsigned short*)F.lds;
    LAS unsigned long long* MW = (LAS unsigned long long*)(F.lds + SEL_MW_OFF);
    const unsigned short* IQ = (const unsigned short*)(F.ws + WS_IQ); const unsigned short* IK = (const unsigned short*)(F.ws + WS_IK); const float* IW = (const float*)(F.ws + WS_IW);
    unsigned long long* MT = (unsigned long long*)(F.ws + WS_MASKT);
    const int wave = F.wave;
    const int cgw = F.vcu * NWAVES + F.wave, cNGW = F.G * NWAVES; int convq = 0;
#ifdef DBG_SELT
    unsigned tacc = 0, tlast = (unsigned)__builtin_amdgcn_s_memrealtime();
#define tacc0 0
#define tacc1 1
#define tacc2 2
#define SEL_T(x) do { const unsigned n_ = (unsigned)__builtin_amdgcn_s_memrealtime(); if ((x) == DBG_SELT) tacc += n_ - tlast; tlast = n_; } while (0)
#else
#define SEL_T(x) do {} while (0)
#endif
    for (int item = F.vcu; item < 256; item += F.G) {
    const int b = item >> 6, jj = item & 63;
    half8 af[4][4]; f32x4 wv[4][4];
    int lane = F.lane; asm volatile("" : "+v"(lane));
    int r = lane & 31, hi = lane >> 5;
    int ql = 2 * ((r >> 2) & 1) + (r >> 4), head = (r & 3) + 4 * ((r >> 3) & 1);
#define SEL_LOAD_AW(T0) do { _Pragma("unroll") for (int rt = 0; rt < 4; ++rt) { const size_t qrow = (size_t)b * SEQ + (T0) + 4 * rt + ql; \
        _Pragma("unroll") for (int kk = 0; kk < 4; ++kk) af[rt][kk] = *(const half8*)(IQ + qrow * 512 + head * 64 + 16 * kk + 8 * hi); } } while (0)
#define SEL_LOAD_W(T0) do { _Pragma("unroll") for (int rt = 0; rt < 4; ++rt) { const float* wp = IW + ((size_t)b * SEQ + (T0) + 4 * rt + 2 * hi) * 8; \
        _Pragma("unroll") for (int i = 0; i < 4; ++i) wv[rt][i] = *(const f32x4*)(wp + 4 * i); } } while (0)
    SEL_LOAD_AW(jj * 32);
    for (int step = 0; step < 4; ++step) {
        const int half = step >> 1, grp = step & 1;
        const int sg = half ? 127 - jj : jj;
        const int t0 = sg * 32 + grp * 16;
        const int KT = (t0 + 16 + 31) >> 5;
        const int KT4 = (KT + 3) & ~3, RV = KT4 >> 2;
        {
            asm volatile("" : "+v"(lane)); r = lane & 31; hi = lane >> 5; ql = 2 * ((r >> 2) & 1) + (r >> 4); head = (r & 3) + 4 * ((r >> 3) & 1);
            const unsigned short* kbase = IK + ((size_t)b * SEQ + r) * 64 + 8 * hi;
#define SEL_LOAD_B(dst, tile) do { const int tl_ = (tile) < 128 ? (tile) : 127; const unsigned short* kp_ = kbase + (size_t)tl_ * 32 * 64; \
        _Pragma("unroll") for (int kk = 0; kk < 4; ++kk) dst[kk] = *(const half8*)(kp_ + 16 * kk); } while (0)
#ifndef SEL_SCHED_BAR
#define SEL_SCHED_BAR do { if (rt & 1) __builtin_amdgcn_sched_barrier(0); } while (0)
#endif
#define SEL_TILE(bf_, tile) do { const int tl_ = (tile); const int key_ = 32 * tl_ + r; \
        const int pos_ = (tl_ >> 2) * 128 + (((tl_ & 1) * 32 + r) << 1) + ((tl_ >> 1) & 1);        \
        const bool diag_ = tl_ >= KT - 1;                                                            \
        _Pragma("unroll") for (int rt = 0; rt < 4; ++rt) { f32x16 acc = f32x16{}; \
            _Pragma("unroll") for (int kk = 0; kk < 4; ++kk) acc = __builtin_amdgcn_mfma_f32_32x32x16_f16(af[rt][kk], bf_[kk], acc, 0, 0, 0); \
            float s0 = 0.f, s1 = 0.f; \
            _Pragma("unroll") for (int g = 0; g < 8; ++g) { s0 += wv[rt][g >> 2][g & 3] * relu_i(acc[g]); s1 += wv[rt][2 + (g >> 2)][g & 3] * relu_i(acc[8 + g]); } \
            const unsigned pk_ = __builtin_bit_cast(unsigned, __builtin_amdgcn_cvt_pkrtz(s0, s1)); \
            const s16x2_t sg_ = __builtin_bit_cast(s16x2_t, pk_) >> 15; \
            unsigned k2_ = pk_ ^ (__builtin_bit_cast(unsigned, sg_) | 0x80008000u);                    \
            if (diag_) { const int q0_ = t0 + 4 * rt + 2 * hi; k2_ = (key_ <= q0_ ? k2_ & 0xffffu : 0u) | (key_ <= q0_ + 1 ? k2_ & 0xffff0000u : 0u); }     \
            SC[(4 * rt + 2 * hi) * SCS + pos_] = (unsigned short)k2_; SC[(4 * rt + 2 * hi + 1) * SCS + pos_] = (unsigned short)(k2_ >> 16); \
            SEL_SCHED_BAR; } } while (0)
            half8 bA[4], bB[4], bC[4], bD[4];
            SEL_LOAD_W(t0);
            SEL_LOAD_B(bA, wave); SEL_LOAD_B(bB, wave + 8); SEL_LOAD_B(bC, wave + 16); SEL_LOAD_B(bD, wave + 24);
            for (int tile = wave; tile < KT4; tile += 32) {
                SEL_TILE(bA, tile); SEL_LOAD_B(bA, tile + 32);
                if (tile + 8 < KT4) { SEL_TILE(bB, tile + 8); SEL_LOAD_B(bB, tile + 40); }
                if (tile + 16 < KT4) { SEL_TILE(bC, tile + 16); SEL_LOAD_B(bC, tile + 48); }
                if (tile + 24 < KT4) { SEL_TILE(bD, tile + 24); SEL_LOAD_B(bD, tile + 56); }
            }
        }
        if (step < 3) { const int nh = (step + 1) >> 1, ng = (step + 1) & 1; SEL_LOAD_AW((nh ? 127 - jj : jj) * 32 + ng * 16); }
        __syncthreads();
        SEL_T(tacc0);
#pragma nounroll
        for (int qq = 0; qq < 2; ++qq) {
            if (CONV && wave < 4) { conv_expert_items3(F, convq * 3 * cNGW + cgw, cNGW, lane); ++convq; }
            const int qi = wave + 8 * qq, t = t0 + qi;
            unsigned kk[32];
            {   const LAS unsigned* row = (const LAS unsigned*)(SC + qi * SCS) + lane;
#pragma unroll
                for (int blk = 0; blk < 4; ++blk) {
                    if (blk * 8 < RV) {
#pragma unroll
                        for (int i = 0; i < 8; ++i) { const int rr = blk * 8 + i; const unsigned v_ = row[rr * 64]; kk[rr] = rr < RV ? v_ : 0u; }
                    } else {
#pragma unroll
                        for (int i = 0; i < 8; ++i) kk[blk * 8 + i] = 0u;
                    }
                }
            }
            unsigned wlo = 0u, whi = 0u;
            if (t + 1 <= 256) {
                const int rem = t + 1 - lane * 64; const unsigned long long w = rem >= 64 ? ~0ull : (rem <= 0 ? 0ull : ((1ull << rem) - 1ull));
                wlo = (unsigned)w; whi = (unsigned)(w >> 32);
            } else {
                unsigned prefix = 0u; int cntp = 0;
                const int nblk = (RV + 7) >> 3;
                for (int bit = 15; bit >= 0; --bit) {
                    const unsigned cand = (unsigned)__builtin_amdgcn_readfirstlane((int)(prefix | (1u << bit)));
                    const unsigned c2 = cand * 0x10001u, c1 = c2 - 0x10001u;
                    unsigned a1 = 0u, a0 = 0u;
#define SAD8(o) { _Pragma("unroll") for (int i = 0; i < 8; ++i) { a1 = __builtin_amdgcn_sad_u16(kk[(o) + i], c2, a1); a0 = __builtin_amdgcn_sad_u16(kk[(o) + i], c1, a0); } }
                    SAD8(0)
                    if (nblk > 1) SAD8(8)
                    if (nblk > 2) SAD8(16)
                    if (nblk > 3) SAD8(24)
#undef SAD8
                    const int cnt = (nblk * 1024 - wave_sum_i((int)(a1 - a0))) >> 1;
                    if (cnt >= 256) { prefix = cand; cntp = cnt; if (cnt == 256) break; }
                }
                prefix = (unsigned)__builtin_amdgcn_readfirstlane((int)prefix); asm volatile("" : "+s"(prefix));
                int excess = __builtin_amdgcn_readfirstlane(cntp - 256);
                unsigned pv = prefix; asm volatile("" : "+v"(pv));
#define M(rr) { unsigned long long w_; asm volatile("v_cmp_ge_u16_e64 %0, %1, %2" : "=s"(w_) : "v"(kk[rr]), "s"(prefix)); { const unsigned l_ = (unsigned)w_, h_ = (unsigned)(w_ >> 32); WLANE(wlo, l_, 2 * (rr)); WLANE(whi, h_, 2 * (rr)); } \
                asm volatile("v_cmp_ge_u16_sdwa %0, %1, %2 src0_sel:WORD_1 src1_sel:WORD_0" : "=s"(w_) : "v"(kk[rr]), "v"(pv)); { const unsigned l_ = (unsigned)w_, h_ = (unsigned)(w_ >> 32); WLANE(wlo, l_, 2 * (rr) + 1); WLANE(whi, h_, 2 * (rr) + 1); } }
                SEQ32(M)
#undef M
                if (excess > 0) {
#define FIXW(rr, HALF, CMPGE, CMPEQ) if (excess > 0) { unsigned long long eq_; asm volatile(CMPEQ : "=s"(eq_) : "v"(kk[rr]), "s"(prefix), "v"(pv)); \
                        if (eq_ != 0ull) { unsigned long long rem_ = 0ull; while (excess > 0 && eq_ != 0ull) { const unsigned long long hb_ = 1ull << (63 - __builtin_clzll(eq_)); rem_ |= hb_; eq_ ^= hb_; --excess; } \
                            unsigned long long w_; asm volatile(CMPGE : "=s"(w_) : "v"(kk[rr]), "s"(prefix), "v"(pv)); w_ &= ~rem_; const unsigned l_ = (unsigned)w_, h_ = (unsigned)(w_ >> 32); WLANE(wlo, l_, 2 * (rr) + (HALF)); WLANE(whi, h_, 2 * (rr) + (HALF)); } }
#define M(i) { FIXW(31 - (i), 1, "v_cmp_ge_u16_sdwa %0, %1, %3 src0_sel:WORD_1 src1_sel:WORD_0", "v_cmp_eq_u16_sdwa %0, %1, %3 src0_sel:WORD_1 src1_sel:WORD_0") \
               FIXW(31 - (i), 0, "v_cmp_ge_u16_e64 %0, %1, %2", "v_cmp_eq_u16_e64 %0, %1, %2") }
                    SEQ32(M)
#undef M
#undef FIXW
                }
            }
            MW[(grp * 16 + qi) * 65 + lane] = (unsigned long long)wlo | ((unsigned long long)whi << 32);
            if (CONV && wave >= 4) { conv_expert_items3(F, convq * 3 * cNGW + cgw, cNGW, lane); ++convq; }
        }
        __syncthreads();
        SEL_T(tacc1);
        if (grp == 1) {
#ifdef DBG_LAST
            const int NT64 = 64;
#else
            const int NT64 = 4 * (sg >> 3) + 4;
#endif
            for (int T = wave; T < NT64; T += 8) {
                const unsigned long long w = MW[r * 65 + T] >> (4 * hi);
                const unsigned lo = (unsigned)w, hi32 = (unsigned)(w >> 32);
                unsigned olo = 0u, ohi = 0u;
#define M(i) { constexpr int r16_ = (i) & 15, bitc_ = (r16_ & 3) + 8 * (r16_ >> 2); const unsigned src_ = ((i) >> 4) ? hi32 : lo; \
                    const unsigned long long bal_ = __ballot(((src_ >> bitc_) & 1u) != 0u); const unsigned l_ = (unsigned)bal_, h_ = (unsigned)(bal_ >> 32); WLANE(olo, l_, i); WLANE(ohi, h_, i); }
                SEQ32(M)
#undef M
                if (lane < 32) MT[((size_t)(b * 128 + sg) * 64 + T) * 32 + lane] = (unsigned long long)olo | ((unsigned long long)ohi << 32);
            }
            __syncthreads();
            SEL_T(tacc2);
        }
    }
    }
    if (CONV) for (int cid = convq * 3 * cNGW + cgw; cid < NCONV; cid += 3 * cNGW) conv_expert_items3(F, cid, cNGW, F.lane);
#ifdef DBG_SELT
    if (blockIdx.x == 0 && F.tid == 0) { unsigned long long* t = (unsigned long long*)(F.ctl + 16384); t[20] = 0; t[21] = tacc; }
#endif
}

template <int G> __device__ __forceinline__ void p2_pool_unit(Frame& F, int tb) {
    const bf16_t* U = (const bf16_t*)(F.ws + WS_U); const bf16_t* WGT = (const bf16_t*)(F.ws + WS_WGT); bf16_t* YP = (bf16_t*)(F.ws + WS_YCAT) + 512;
    constexpr int w = 2 << G;
    const int lane = F.lane, r = lane & 31, hi = lane >> 5;
    const int tok = tb * 32 + r, t = tok & (SEQ - 1), cnt = (t + 1 < w) ? t + 1 : w;
    const float inv = 1.f / (float)cnt;
    f32x16 acc[2]; acc[0] = f32x16{}; acc[1] = f32x16{};
#pragma unroll
    for (int kk = 0; kk < 4; ++kk) {
        const int c0 = G * 64 + 16 * kk + 8 * hi;
        constexpr int CH = (w < 8) ? w : 8;
        float s[8], own[8];
#pragma unroll
        for (int j = 0; j < 8; ++j) s[j] = 0.f;
#pragma nounroll
        for (int i0 = 0; i0 < w; i0 += CH) {
            u32x4 v[CH];
#pragma unroll
            for (int i = 0; i < CH; ++i) { const int back = (i0 + i < cnt) ? i0 + i : 0; v[i] = *(const u32x4*)(U + (size_t)(tok - back) * 256 + c0); }
#pragma unroll
            for (int i = 0; i < CH; ++i) { const float m = (i0 + i < cnt) ? 1.f : 0.f;
                s[0] += m * bflo(v[i].x); s[1] += m * bfhi(v[i].x); s[2] += m * bflo(v[i].y); s[3] += m * bfhi(v[i].y); s[4] += m * bflo(v[i].z); s[5] += m * bfhi(v[i].z); s[6] += m * bflo(v[i].w); s[7] += m * bfhi(v[i].w); }
            if (i0 == 0) { own[0] = bflo(v[0].x); own[1] = bfhi(v[0].x); own[2] = bflo(v[0].y); own[3] = bfhi(v[0].y); own[4] = bflo(v[0].z); own[5] = bfhi(v[0].z); own[6] = bflo(v[0].w); own[7] = bfhi(v[0].w); }
        }
        u32x4 pb; pb.x = cvt_pk_bf16(s[0] * inv - own[0], s[1] * inv - own[1]); pb.y = cvt_pk_bf16(s[2] * inv - own[2], s[3] * inv - own[3]);
        pb.z = cvt_pk_bf16(s[4] * inv - own[4], s[5] * inv - own[5]); pb.w = cvt_pk_bf16(s[6] * inv - own[6], s[7] * inv - own[7]);
#pragma unroll
        for (int dh = 0; dh < 2; ++dh) { const bf16x8 a = *(const bf16x8*)(WGT + ((size_t)(G * 64 + 32 * dh + r)) * 64 + 16 * kk + 8 * hi);
            acc[dh] = __builtin_amdgcn_mfma_f32_32x32x16_bf16(a, __builtin_bit_cast(bf16x8, pb), acc[dh], 0, 0, 0); }
        __builtin_amdgcn_sched_barrier(0);
    }
    const float* sc = F.in[10];
#pragma unroll
    for (int dh = 0; dh < 2; ++dh)
#pragma unroll
        for (int q4 = 0; q4 < 4; ++q4) { const int d = G * 64 + 32 * dh + 8 * q4 + 4 * hi; const f32x4 s4 = *(const f32x4*)(sc + d);
            u32x2 o; o.x = cvt_pk_bf16(acc[dh][4 * q4] * s4[0], acc[dh][4 * q4 + 1] * s4[1]); o.y = cvt_pk_bf16(acc[dh][4 * q4 + 2] * s4[2], acc[dh][4 * q4 + 3] * s4[3]);
            *(u32x2*)(YP + (size_t)tok * 1024 + d) = o; }
}
constexpr int MEM_KROW = 144, MEM_VROW = 528;
constexpr int MEM_K_OFF = 0, MEM_V_OFF = 256 * MEM_KROW;
__device__ __forceinline__ void p2_mem_item(Frame& F, int item) {
    const bf16_t* QM = (const bf16_t*)(F.ws + WS_QM); const bf16_t* KM = (const bf16_t*)(F.ws + WS_KM); const bf16_t* VMT = (const bf16_t*)(F.ws + WS_VMT); bf16_t* YM = (bf16_t*)(F.ws + WS_YCAT) + 768;
    const int lane = F.lane, wave = F.wave, r = lane & 31, hi = lane >> 5, tid = F.tid;
    const int bhm = item >> 4, b = bhm >> 2, hm = bhm & 3;
    LAS unsigned char* lk = F.lds + MEM_K_OFF; LAS unsigned char* lv = F.lds + MEM_V_OFF;
#pragma unroll
    for (int i = 0; i < 4; ++i) { const int idx = tid + 512 * i, key = idx >> 3, ch = idx & 7;
        *(LAS u32x4*)(lk + key * MEM_KROW + ch * 16) = *(const u32x4*)(KM + (size_t)(b * 256 + key) * 256 + hm * 64 + ch * 8); }
#pragma unroll
    for (int i = 0; i < 4; ++i) { const int idx = tid + 512 * i, d = idx >> 5, ch = idx & 31;
        *(LAS u32x4*)(lv + d * MEM_VROW + ch * 16) = *(const u32x4*)(VMT + ((size_t)(b * 4 + hm) * 64 + d) * 256 + ch * 8); }
    __syncthreads();
    const int tok = b * SEQ + (item & 15) * 256 + wave * 32 + r;
    bf16x8 qf[4];
#pragma unroll
    for (int kk = 0; kk < 4; ++kk) qf[kk] = *(const bf16x8*)(QM + (size_t)tok * 256 + hm * 64 + 16 * kk + 8 * hi);
    f32x16 sc[8];
#pragma unroll
    for (int kb = 0; kb < 8; ++kb) { sc[kb] = f32x16{};
#pragma unroll
        for (int kk = 0; kk < 4; ++kk) { const bf16x8 a = *(const LAS bf16x8*)(lk + (kb * 32 + r) * MEM_KROW + (16 * kk + 8 * hi) * 2);
            sc[kb] = __builtin_amdgcn_mfma_f32_32x32x16_bf16(a, qf[kk], sc[kb], 0, 0, 0); } }
    float mx = -INFINITY;
#pragma unroll
    for (int kb = 0; kb < 8; ++kb)
#pragma unroll
        for (int i = 0; i < 16; ++i) mx = fmaxf(mx, sc[kb][i]);
    mx = fmaxf(mx, __shfl_xor(mx, 32));
    float l = 0.f;
#pragma unroll
    for (int kb = 0; kb < 8; ++kb)
#pragma unroll
        for (int i = 0; i < 16; ++i) { const float p = __builtin_amdgcn_exp2f(sc[kb][i] - mx); sc[kb][i] = p; l += p; }
    l += __shfl_xor(l, 32);
    f32x16 o[2]; o[0] = f32x16{}; o[1] = f32x16{};
#pragma unroll
    for (int kb = 0; kb < 8; ++kb)
#pragma unroll
        for (int s = 0; s < 2; ++s) {
            u32x4 pw; pw.x = cvt_pk_bf16(sc[kb][8 * s], sc[kb][8 * s + 1]); pw.y = cvt_pk_bf16(sc[kb][8 * s + 2], sc[kb][8 * s + 3]); pw.z = cvt_pk_bf16(sc[kb][8 * s + 4], sc[kb][8 * s + 5]); pw.w = cvt_pk_bf16(sc[kb][8 * s + 6], sc[kb][8 * s + 7]);
#pragma unroll
            for (int dh = 0; dh < 2; ++dh) {
                const LAS unsigned char* vp = lv + (32 * dh + r) * MEM_VROW + (32 * kb + 16 * s + 4 * hi) * 2;
                const u32x2 a0 = *(const LAS u32x2*)vp, a1 = *(const LAS u32x2*)(vp + 16);
                const u32x4 av = (u32x4){a0.x, a0.y, a1.x, a1.y};
                o[dh] = __builtin_amdgcn_mfma_f32_32x32x16_bf16(__builtin_bit_cast(bf16x8, av), __builtin_bit_cast(bf16x8, pw), o[dh], 0, 0, 0); }
            __builtin_amdgcn_sched_barrier(0);
        }
    const float il = 1.f / l;
#pragma unroll
    for (int dh = 0; dh < 2; ++dh)
#pragma unroll
        for (int q4 = 0; q4 < 4; ++q4) { const int d = hm * 64 + 32 * dh + 8 * q4 + 4 * hi;
            u32x2 ov; ov.x = cvt_pk_bf16(o[dh][4 * q4] * il, o[dh][4 * q4 + 1] * il); ov.y = cvt_pk_bf16(o[dh][4 * q4 + 2] * il, o[dh][4 * q4 + 3] * il);
            *(u32x2*)(YM + (size_t)tok * 1024 + d) = ov; }
    __syncthreads();
}
__device__ __forceinline__ void p6_router(Frame& F) {
    const float* H1 = F.out; const bf16_t* WRH = (const bf16_t*)(F.ws + WS_WRH); const bf16_t* WRL = (const bf16_t*)(F.ws + WS_WRL);
    int* RE = (int*)(F.ws + WS_RE); int* RR = (int*)(F.ws + WS_RR); float* RG = (float*)(F.ws + WS_RG); float* RSTD = (float*)(F.ws + WS_RSTD);
    LAS float* RED = (LAS float*)F.lds;
    LAS float* SSQ = (LAS float*)(F.lds + 2 * 4 * 32 * 33 * 4);
    volatile LAS unsigned* LCNT = (volatile LAS unsigned*)(F.lds + 2 * 4 * 32 * 33 * 4 + 2 * 4 * 64 * 4);
    const int lane = F.lane, wave = F.wave, r = lane & 31, hi = lane >> 5, tblk = wave >> 2, kq = wave & 3;
    for (int item = F.vcu; item < NTOK / 64; item += F.G) {
        const int tok = item * 64 + tblk * 32 + r;
        f32x16 acc = f32x16{}; float ssq = 0.f;
        const float* hp = H1 + (size_t)tok * 1024 + 256 * kq + 8 * hi;
        const bf16_t* ah = WRH + (size_t)r * 1024 + 256 * kq + 8 * hi; const bf16_t* al = WRL + (size_t)r * 1024 + 256 * kq + 8 * hi;
#pragma unroll 8
        for (int ks = 0; ks < 16; ++ks) {
            const f32x4 x0 = *(const f32x4*)(hp + 16 * ks), x1 = *(const f32x4*)(hp + 16 * ks + 4);
            ssq += (x0[0] * x0[0] + x0[1] * x0[1]) + (x0[2] * x0[2] + x0[3] * x0[3]) + (x1[0] * x1[0] + x1[1] * x1[1]) + (x1[2] * x1[2] + x1[3] * x1[3]);
            u32x4 bh; bh.x = cvt_pk_bf16_s(x0[0], x0[1]); bh.y = cvt_pk_bf16_s(x0[2], x0[3]); bh.z = cvt_pk_bf16_s(x1[0], x1[1]); bh.w = cvt_pk_bf16_s(x1[2], x1[3]);
            u32x4 bl; bl.x = cvt_pk_bf16_s(x0[0] - bflo(bh.x), x0[1] - bfhi(bh.x)); bl.y = cvt_pk_bf16_s(x0[2] - bflo(bh.y), x0[3] - bfhi(bh.y));
            bl.z = cvt_pk_bf16_s(x1[0] - bflo(bh.z), x1[1] - bfhi(bh.z)); bl.w = cvt_pk_bf16_s(x1[2] - bflo(bh.w), x1[3] - bfhi(bh.w));
            const bf16x8 Ah = *(const bf16x8*)(ah + 16 * ks), Al = *(const bf16x8*)(al + 16 * ks);
            acc = __builtin_amdgcn_mfma_f32_32x32x16_bf16(Ah, __builtin_bit_cast(bf16x8, bh), acc, 0, 0, 0);
            acc = __builtin_amdgcn_mfma_f32_32x32x16_bf16(Ah, __builtin_bit_cast(bf16x8, bl), acc, 0, 0, 0);
            acc = __builtin_amdgcn_mfma_f32_32x32x16_bf16(Al, __builtin_bit_cast(bf16x8, bh), acc, 0, 0, 0);
        }
#pragma unroll
        for (int g = 0; g < 16; ++g) RED[((tblk * 4 + kq) * 32 + attn_body::crow(g, hi)) * 33 + r] = acc[g];
        SSQ[(tblk * 4 + kq) * 64 + lane] = ssq;
        __syncthreads();
        if (F.tid < 64) {
            const int tb2 = F.tid >> 5, rr = F.tid & 31, tk = item * 64 + F.tid;
            float sq = 0.f;
#pragma unroll
            for (int q = 0; q < 4; ++q) sq += SSQ[(tb2 * 4 + q) * 64 + rr] + SSQ[(tb2 * 4 + q) * 64 + 32 + rr];
            const float rstd = 1.f / sqrtf(sq * (1.f / 1024.f) + EPS);
            float lg[32];
#pragma unroll
            for (int e = 0; e < 32; ++e) { float s = 0.f;
#pragma unroll
                for (int q = 0; q < 4; ++q) s += RED[((tb2 * 4 + q) * 32 + e) * 33 + rr];
                lg[e] = s * rstd + F.in[16][e]; }
            float tv[4]; int ti[4];
#pragma unroll
            for (int p = 0; p < 4; ++p) { float best = -INFINITY; int bi = 0;
#pragma unroll
                for (int e = 0; e < 32; ++e) if (lg[e] > best) { best = lg[e]; bi = e; }
                tv[p] = best; ti[p] = bi;
#pragma unroll
                for (int e = 0; e < 32; ++e) lg[e] = (e == bi) ? -INFINITY : lg[e]; }
            float ex[4], den = 0.f;
#pragma unroll
            for (int p = 0; p < 4; ++p) { ex[p] = __expf(tv[p] - tv[0]); den += ex[p]; }
            const float id = 1.f / den;
#pragma unroll
            for (int p = 0; p < 4; ++p) { RE[tk * 4 + p] = ti[p]; RG[tk * 4 + p] = ex[p] * id; }
            if (F.tid < 32) LCNT[F.tid] = 0u;
            int rk[4];
#pragma unroll
            for (int p = 0; p < 4; ++p) rk[p] = (int)__hip_atomic_fetch_add((LAS unsigned*)&LCNT[ti[p]], 1u, __ATOMIC_RELAXED, __HIP_MEMORY_SCOPE_WORKGROUP);
            if (F.tid < 32) { const unsigned c = LCNT[F.tid]; LCNT[32 + F.tid] = c ? __hip_atomic_fetch_add(F.ctl + CW_CNT + 64 * F.tid, c, __ATOMIC_RELAXED, __HIP_MEMORY_SCOPE_AGENT) : 0u; }
#pragma unroll
            for (int p = 0; p < 4; ++p) RR[tk * 4 + p] = rk[p] + (int)LCNT[32 + ti[p]];
            RSTD[tk] = rstd;
        }
        __syncthreads();
    }
}
__device__ __forceinline__ int moe_row_offset(Frame& F) {
    const int lane = F.lane; const unsigned c = (lane < 32) ? __hip_atomic_load(F.ctl + CW_CNT + 64 * lane, __ATOMIC_RELAXED, __HIP_MEMORY_SCOPE_AGENT) : 0u;
    const int pad = (int)((c + 255u) & ~255u); int inc = pad;
#pragma unroll
    for (int o = 1; o < 32; o <<= 1) { const int v = __shfl_up(inc, o); if ((lane & 31) >= o) inc += v; }
    return inc - pad;
}
__device__ __forceinline__ void p7_scatter(Frame& F) {
    const float* H1 = F.out; const int* RE = (const int*)(F.ws + WS_RE); const int* RR = (const int*)(F.ws + WS_RR); const float* RSTD = (const float*)(F.ws + WS_RSTD);
    int* SLOT = (int*)(F.ws + WS_SLOT); unsigned char* XG = (unsigned char*)(F.ws + WS_XG);
    const int lane = F.lane, gw = F.vcu * NWAVES + F.wave, NGW = F.G * NWAVES;
    const int off = moe_row_offset(F);
    const f32x4* gr = (const f32x4*)F.in[14] + lane;
    f32x4 gg[4];
#pragma unroll
    for (int j = 0; j < 4; ++j) gg[j] = gr[64 * j];
    for (int tok = gw; tok < NTOK; tok += NGW) {
        const float rstd = RSTD[tok];
        const f32x4* xr = (const f32x4*)(H1 + (size_t)tok * 1024) + lane;
        unsigned w[4];
#pragma unroll
        for (int j = 0; j < 4; ++j) { const f32x4 v = xr[64 * j]; w[j] = cvt_pk_fp8x4(v.x * rstd * gg[j].x, v.y * rstd * gg[j].y, v.z * rstd * gg[j].z, v.w * rstd * gg[j].w); }
#pragma unroll
        for (int p = 0; p < 4; ++p) { const int e = RE[tok * 4 + p], rk = RR[tok * 4 + p]; const int slot = __shfl(off, e) + rk;
            unsigned* o4 = (unsigned*)(XG + (size_t)slot * 1024) + lane;
#pragma unroll
            for (int j = 0; j < 4; ++j) o4[64 * j] = w[j];
            if (lane == 0) SLOT[tok * 4 + p] = slot; }
    }
}
__device__ __forceinline__ void moe_tile_table(Frame& F) {
    if (F.wave == 0) { const int off = moe_row_offset(F); const unsigned c = (F.lane < 32) ? __hip_atomic_load(F.ctl + CW_CNT + 64 * F.lane, __ATOMIC_RELAXED, __HIP_MEMORY_SCOPE_AGENT) : 0u;
        if (F.lane < 32) F.MISC[32 + F.lane] = (unsigned)(off >> 8);
        if (F.lane == 31) F.MISC[64] = (unsigned)((off >> 8) + (int)((c + 255u) >> 8)); }
    __syncthreads();
}
__device__ __forceinline__ void p10_final(Frame& F) {
    float* H1 = F.out; const int* SLOT = (const int*)(F.ws + WS_SLOT); const float* RG = (const float*)(F.ws + WS_RG); const unsigned char* Y = (const unsigned char*)(F.ws + WS_XG);
    const int lane = F.lane, gw = F.vcu * NWAVES + F.wave, NGW = F.G * NWAVES;
    const f32x4* gr = (const f32x4*)F.in[21] + lane;
    f32x4 gg[4];
#pragma unroll
    for (int j = 0; j < 4; ++j) gg[j] = gr[64 * j];
    for (int tok = gw; tok < NTOK; tok += NGW) {
        f32x4* xr = (f32x4*)(H1 + (size_t)tok * 1024) + lane;
        f32x4 v[4];
#pragma unroll
        for (int j = 0; j < 4; ++j) v[j] = xr[64 * j];
#pragma unroll
        for (int p = 0; p < 4; ++p) { const int slot = SLOT[tok * 4 + p]; const float gate = RG[tok * 4 + p] * 0.125f;
            const unsigned* yr = (const unsigned*)(Y + (size_t)slot * 1024) + lane;
#pragma unroll
            for (int j = 0; j < 4; ++j) { const unsigned y = yr[64 * j]; const f32x2 lo = __builtin_amdgcn_cvt_pk_f32_fp8((int)y, false), hi = __builtin_amdgcn_cvt_pk_f32_fp8((int)y, true);
                v[j].x += gate * lo[0]; v[j].y += gate * lo[1]; v[j].z += gate * hi[0]; v[j].w += gate * hi[1]; } }
        float s = 0.f;
#pragma unroll
        for (int j = 0; j < 4; ++j) s += (v[j].x * v[j].x + v[j].y * v[j].y) + (v[j].z * v[j].z + v[j].w * v[j].w);
        const float rstd = 1.f / sqrtf(wave_sum(s) * (1.f / 1024.f) + EPS);
#pragma unroll
        for (int j = 0; j < 4; ++j) xr[64 * j] = (f32x4){v[j].x * rstd * gg[j].x, v[j].y * rstd * gg[j].y, v[j].z * rstd * gg[j].z, v[j].w * rstd * gg[j].w};
    }
#ifdef DBG_STAMP
    if (gw == 0 && lane == 0) { const unsigned long long* t = (const unsigned long long*)(F.ctl + 16384); H1[0] = floorf((float)(t[DBG_STAMP_HI] - t[DBG_STAMP_LO]) * 0.01f / DBG_STAMP_Q) * DBG_STAMP_Q; }
#endif
}

#ifndef MK_N_LAUNCHES
#define MK_N_LAUNCHES 1
#endif
constexpr int N_PHASES = 11;
constexpr int N_LAUNCHES = MK_N_LAUNCHES;
struct Args { const float* in[22]; float* out; unsigned char* ws; int ph_lo, ph_hi, li, pad; };
__global__ void __launch_bounds__(NWAVES * 64, 2) fwd_kernel(Args args) {
    extern __shared__ __attribute__((aligned(16))) unsigned char lds[];
    Frame F;
    F.lds = (LAS unsigned char*)lds; F.MISC = (volatile LAS unsigned*)(F.lds + MISC_OFF);
    F.tid = threadIdx.x; F.lane = F.tid & 63; F.wave = __builtin_amdgcn_readfirstlane(F.tid >> 6);
    F.G = gridDim.x; { const int bx = blockIdx.x; F.vcu = (F.G % 8 == 0) ? (bx % 8) * (F.G / 8) + bx / 8 : bx; }
    F.ws = args.ws; F.ctl = (unsigned*)(args.ws + WS_CTL); F.out = args.out;
    F.in = (const float* const __attribute__((address_space(4)))*)__builtin_amdgcn_kernarg_segment_ptr();
    static_assert(__builtin_offsetof(Args, in) == 0, "Frame::in reads the input pointers at the start of the kernarg segment");
    unsigned char* ws = args.ws;
#define WS_FRESH() do { ws = args.ws; asm volatile("" : "+s"(ws)); F.ws = ws; } while (0)
    for (int u = F.tid; u < 256; u += NWAVES * 64) F.MISC[u] = 0u;
    __syncthreads();
    XcdBarrier bar; bar.bar = F.ctl + CW_BAR; bar.x = 0; bar.st = nullptr;
    if (N_LAUNCHES == 1) bar = xcd_barrier_post(F.ctl + CW_BAR, F.MISC + 8, F.tid == 0);
#define GRID_BAR() do { if (N_LAUNCHES == 1) xcd_barrier(bar, F.wave == 0 && lane_id() == 0); } while (0)
    const int lo = args.ph_lo, hi = args.ph_hi;
#ifndef PH_MASK
#define PH_MASK 0x7ff
#endif
#ifdef DBG_LAST
#define IN(k) ((k) <= DBG_LAST && (((PH_MASK) >> (k)) & 1) && lo <= (k) && (k) < hi)
#else
#define IN(k) ((((PH_MASK) >> (k)) & 1) && lo <= (k) && (k) < hi)
#endif
#define BOTH(k) (IN(k) && IN((k) + 1))

#define IN_FRESH() do { F.in = (const float* const __attribute__((address_space(4)))*)__builtin_amdgcn_kernarg_segment_ptr(); asm volatile("" : "+s"(F.in)); } while (0)
#define REFRESH_F() do { int l_ = lane_id(); asm volatile("" : "+v"(l_)); F.lane = l_; F.tid = F.wave * 64 + l_; } while (0)
#ifdef DBG_PHSTAMP
#define STAMP(k) do { if (blockIdx.x == 0 && F.tid == 0) ((unsigned long long*)(F.ctl + 16384))[k] = __builtin_amdgcn_s_memrealtime(); } while (0)
#else
#define STAMP(k) do {} while (0)
#endif
    STAMP(0);
    if (IN(0)) { IN_FRESH(); REFRESH_F(); p0_prologue(F); if (BOTH(0)) GRID_BAR(); }
    STAMP(1);

    if (IN(1)) { IN_FRESH();
        Sched1 S{(const char*)(ws + WS_XN), (const char*)(ws + WS_W1T), (const char*)(ws + WS_MEMN), (const char*)(ws + WS_WKV), F.G, (int)blockIdx.x};
        EpiP1 E{(bf16_t*)(ws + WS_Q), (bf16_t*)(ws + WS_K), (bf16_t*)(ws + WS_V), (bf16_t*)(ws + WS_U), (bf16_t*)(ws + WS_QM), (bf16_t*)(ws + WS_G), (bf16_t*)(ws + WS_KM), (bf16_t*)(ws + WS_VMT),
                (unsigned short*)(ws + WS_IQ), (unsigned short*)(ws + WS_IK), (float*)(ws + WS_IW), F.in[5], (const float*)(ws + WS_ROPE), 1.f / 64.f};
        { SchedU SU{(const char*)(ws + WS_XNB), (const char*)(ws + WS_WU), F.G, (int)blockIdx.x}; EpiP1 EU = E; EU.accscale = 1.f;
          pg8::gemm_phase<EpiP1, SchedU, K_ALIGN, K_SP2>(F.wave, F.lds, 1024, SU, EU); }
        pg8::gemm_phase<EpiP1, Sched1, K_ALIGN, K_SP2, pg8::NoHook, 1>(F.wave, F.lds, 1024, S, E);
        REFRESH_F(); p1_memkv(F);
        if (BOTH(1)) GRID_BAR();
    }

    STAMP(2);
    if (IN(2)) { IN_FRESH();
        F.lane = lane_id(); F.tid = F.wave * 64 + F.lane;
        p2_select(F);
        REFRESH_F();
        STAMP(12);
        if (BOTH(2)) GRID_BAR();
    }

    STAMP(3);
    if (IN(3)) { IN_FRESH();
        for (int v = F.vcu; v < 256; v += F.G) {
            const int bh = v >> 3, s = v & 7;
#pragma unroll 1
            for (int i = 0; i < 2; ++i) attn_body::attn_unit<8>(F.wave, bh >> 3, bh & 7, i == 0 ? s : 15 - s, (const attn_body::bf16*)(ws + WS_Q), (const attn_body::bf16*)(ws + WS_K), (const attn_body::bf16*)(ws + WS_V),
                                                                 (attn_body::bf16*)(ws + WS_YCAT), (const unsigned long long*)(ws + WS_MASKT), (char*)lds);
        }
        __syncthreads(); REFRESH_F();
        const int gw = F.vcu * NWAVES + F.wave, NGW = F.G * NWAVES;
#ifndef NO_POOL
        for (int u = gw; u < 2048; u += NGW) { const int tb = u >> 2; switch (u & 3) { case 0: p2_pool_unit<0>(F, tb); break; case 1: p2_pool_unit<1>(F, tb); break; case 2: p2_pool_unit<2>(F, tb); break; default: p2_pool_unit<3>(F, tb); break; } }
#endif
#ifndef NO_MEM
        for (int it = F.vcu; it < 256; it += F.G) p2_mem_item(F, it);
#endif
        if (BOTH(3)) GRID_BAR();
    }

    STAMP(4);
    if (IN(4)) { IN_FRESH();
        SchedSimple S{(const char*)(ws + WS_YCAT), (const char*)(ws + WS_WCAT), 64, 4, F.G, (int)blockIdx.x, (size_t)256 * 1024 * 2};
        EpiGate<0> E{(const bf16_t*)(ws + WS_G), nullptr, (bf16_t*)(ws + WS_MERGED), 2}; GateRatioHook H{(const bf16_t*)(ws + WS_G)};
        pg8::gemm_phase<EpiGate<0>, SchedSimple, K_ALIGN, K_SP2, GateRatioHook>(F.wave, F.lds, 1024, S, E, 0, H);
        if (BOTH(4)) GRID_BAR();
    }
    STAMP(5);
    if (IN(5)) { IN_FRESH();
        SchedSimple S{(const char*)(ws + WS_MERGED), (const char*)(ws + WS_WOUT), 64, 4, F.G, (int)blockIdx.x, (size_t)256 * 1024 * 2};
        EpiRes E{F.in[0], F.out}; pg8::gemm_phase<EpiRes, SchedSimple, K_ALIGN, K_SP2>(F.wave, F.lds, 1024, S, E);
        if (BOTH(5)) GRID_BAR();
    }

    STAMP(6);
    if (IN(6)) { IN_FRESH(); REFRESH_F(); p6_router(F); if (BOTH(6)) GRID_BAR(); }
    STAMP(7);
    if (IN(7)) { IN_FRESH(); REFRESH_F(); p7_scatter(F); if (BOTH(7)) GRID_BAR(); }

    STAMP(8);
    if (IN(8)) { IN_FRESH();
        REFRESH_F();
        if (F.wave == 0) { const int l = lane_id(); const unsigned c = (l < 16) ? xb_ld(&bar.bar[XB_XCNT(l)]) : 0u;
            const unsigned long long nz = __ballot(c > 0u), okm = __ballot(l >= 16 || c == 0u || c == (unsigned)(F.G >> 3));
            const bool nice = (N_LAUNCHES == 1) && BOTH(8) && ((F.G & 63) == 0) && (__builtin_popcountll(nz) == 8) && (okm == ~0ull);
            if (l == 0) { F.MISC[12] = nice ? 1u : 0u; F.MISC[13] = (unsigned)__builtin_popcountll(nz & ((1ull << bar.x) - 1ull)); } }
        moe_tile_table(F);
        const bool merged = __builtin_amdgcn_readfirstlane((int)F.MISC[12]) != 0; const int hx = merged ? __builtin_amdgcn_readfirstlane((int)F.MISC[13]) : -1, hs = __builtin_amdgcn_readfirstlane((int)F.MISC[10]);
        SchedMoe S{(const char*)(ws + WS_XG), (const char*)(ws + WS_WUP), (const volatile LAS int*)(F.MISC + 32), 8, F.G, (int)blockIdx.x, 1024, hx, hs};
        EpiSwiglu E{F.in[18], (unsigned char*)(ws + WS_ACT), merged ? F.ctl + CW_UPDONE : nullptr}; pg8::gemm_phase<EpiSwiglu, SchedMoe, K_ALIGN, K_SP2, pg8::NoHook, 1>(F.wave, F.lds, 1024, S, E);
        if (BOTH(8) && !merged) GRID_BAR();
    }
    STAMP(9);
    if (IN(9)) { IN_FRESH();
        REFRESH_F(); moe_tile_table(F);
        const bool merged = BOTH(8) && __builtin_amdgcn_readfirstlane((int)F.MISC[12]) != 0; const int hx = merged ? __builtin_amdgcn_readfirstlane((int)F.MISC[13]) : -1, hs = __builtin_amdgcn_readfirstlane((int)F.MISC[10]);
        SchedMoe S{(const char*)(ws + WS_ACT), (const char*)(ws + WS_WDN), (const volatile LAS int*)(F.MISC + 32), 4, F.G, (int)blockIdx.x, 1024, hx, hs, merged ? F.ctl + CW_UPDONE : nullptr, merged ? (F.G >> 4) : 0};
        EpiDown E{F.in[20], (unsigned char*)(ws + WS_XG)}; pg8::gemm_phase<EpiDown, SchedMoe, K_ALIGN, K_SP2, pg8::NoHook, 1>(F.wave, F.lds, 1024, S, E);
        if (BOTH(9)) GRID_BAR();
    }
    STAMP(10);
    if (IN(10)) { IN_FRESH(); REFRESH_F(); p10_final(F); }
    STAMP(11);
#if defined(DBG_LAST) && defined(DBG_SCAN)
    {
        if (N_LAUNCHES == 1) xcd_barrier(bar, F.wave == 0 && lane_id() == 0);
        const unsigned short* base = (const unsigned short*)(ws + DBG_SCAN_OFF);
        const size_t gt = (size_t)blockIdx.x * 512 + threadIdx.x, NGT = (size_t)gridDim.x * 512;
        for (size_t j = gt; j < (size_t)NTOK * DM; j += NGT) { float r = 0.f;
            for (size_t q = j; q < (size_t)DBG_SCAN_ELEMS; q += (size_t)NTOK * DM) { const unsigned v = base[q]; const unsigned e = (v >> 7) & 0xffu, m = v & 0x7fu;
                if (DBG_SCAN == 1 ? (e == 0xffu) : (e == 0u && m != 0u)) r = __builtin_nanf(""); }
            F.out[j] = r; }
    }
#endif
#if defined(DBG_LAST) && defined(DBG_REGIONS)
    {
        if (N_LAUNCHES == 1) xcd_barrier(bar, F.wave == 0 && lane_id() == 0);
        const size_t offs[] = {DBG_REGIONS}; const size_t nreg = sizeof(offs) / sizeof(offs[0]) / 2;
        const size_t gt = (size_t)blockIdx.x * 512 + threadIdx.x, NGT = (size_t)gridDim.x * 512;
        for (size_t j = gt; j < (size_t)NTOK * DM; j += NGT) { float acc = 0.f;
            for (size_t q = 0; q < nreg; ++q) { const unsigned short* base = (const unsigned short*)(ws + offs[2 * q]);
#ifdef DBG_LOWBYTE
                acc += (float)(base[j % (offs[2 * q + 1] / 2)] & 0xffu); }
#else
                acc += (float)base[j % (offs[2 * q + 1] / 2)]; }
#endif
#ifdef DBG_NOISE
            acc += (float)(DBG_NOISE) * (float)((__builtin_amdgcn_s_memrealtime() >> 4) & 1ull) * (float)((j * 2654435761ull >> 13) & 1ull);
#endif
            F.out[j] = acc; }
    }
#endif
#undef IN
#undef BOTH
}

extern "C" void kernel_launch(void* const* d_in, const int* in_sizes, int n_in, void* d_out, int out_size, void* d_ws, size_t ws_size, hipStream_t stream) {
    static int grid = 0;
    if (grid == 0) {
        if (n_in != 22 || in_sizes[0] != NTOK * DM || out_size != NTOK * DM || ws_size < WS_END) { fprintf(stderr, "kernel_launch: unexpected problem shape / workspace (n_in %d, ws %zu < %zu); nothing launched\n", n_in, ws_size, (size_t)WS_END); grid = -1; return; }
        int dev = 0, cus = 0, per_cu = 0;
        if (hipGetDevice(&dev) != hipSuccess || hipDeviceGetAttribute(&cus, hipDeviceAttributeMultiprocessorCount, dev) != hipSuccess) { grid = -1; return; }
        if (hipFuncSetAttribute((const void*)fwd_kernel, hipFuncAttributeMaxDynamicSharedMemorySize, LDS_BYTES) != hipSuccess) { fprintf(stderr, "kernel_launch: hipFuncSetAttribute failed\n"); grid = -1; return; }
        if (hipOccupancyMaxActiveBlocksPerMultiprocessor(&per_cu, (const void*)fwd_kernel, NWAVES * 64, LDS_BYTES) != hipSuccess || per_cu < 1) fprintf(stderr, "kernel_launch: occupancy query reports %d\n", per_cu);
        (void)hipGetLastError();
        grid = cus;
    }
    if (grid < 0) return;
    if (hipMemsetAsync((char*)d_ws + WS_CTL, 0, CTL_ZERO_BYTES, stream) != hipSuccess) return;
    Args a{};
    for (int i = 0; i < 22; ++i) a.in[i] = (const float*)d_in[i];
    a.out = (float*)d_out; a.ws = (unsigned char*)d_ws;
    for (int li = 0; li < N_LAUNCHES; ++li) {
        a.ph_lo = (N_LAUNCHES == 1) ? 0 : li; a.ph_hi = (N_LAUNCHES == 1) ? N_PHASES : li + 1; a.li = li;
        hipLaunchKernelGGL(fwd_kernel, dim3(grid), dim3(NWAVES * 64), LDS_BYTES, stream, a);
        if (hipPeekAtLastError() != hipSuccess) { fprintf(stderr, "kernel_launch: launch %d failed\n", li); break; }
    }
}
```
